# Optimizing an MI355X kernel written in HIP

```python
import math
import jax, jax.numpy as jnp
from jax import lax
import numpy as np

D_MODEL = 1024
BATCH = 32
SEQ = 2048
DEPTH = 4

MIX_WIDTH = D_MODEL
A_WIDTH = MIX_WIDTH // 2
B_WIDTH = MIX_WIDTH // 2
C_WIDTH = MIX_WIDTH // 2
D_WIDTH = MIX_WIDTH // 2
CHUNK = 128
A_GROUPS = 4
A_GROUP_DIM = A_WIDTH // A_GROUPS
HYENA_ORDER = 2
HYENA_DIRS = 2
FILTER_BANDS = 16
FILTER_EMB = 1 + 2 * FILTER_BANDS
FILTER_HIDDEN = 64
FILTER_OUT = HYENA_DIRS * HYENA_ORDER * B_WIDTH
DECAY_TARGET = 1e-2
FAST_DECAY_PCT = 0.3
SLOW_DECAY_PCT = 1.5
POOL_WINDOWS = (2, 4, 8, 16)
C_GROUPS = len(POOL_WINDOWS)
C_GROUP_DIM = C_WIDTH // C_GROUPS
SHORT_CONV = 3
D_FF = -(-8 * D_MODEL // (3 * 256)) * 256
N_EVEN = (DEPTH + 1) // 2
N_ODD = DEPTH // 2
AB_IN = 2 * A_WIDTH + 3 * B_WIDTH
CD_IN = C_WIDTH + 3 * D_WIDTH
RMS_EPS = 1e-6
LN_EPS = 1e-5

kernel_name = "hybrid_gmlp_hyena_pool_shortconv_encoder"


def rmsnorm(x, g):
    xf = x.astype(jnp.float32)
    y = xf * lax.rsqrt(jnp.mean(xf * xf, axis=-1, keepdims=True) + RMS_EPS)
    return (y * g.astype(jnp.float32)).astype(x.dtype)


def layernorm(x, g):
    xf = x.astype(jnp.float32)
    mu = jnp.mean(xf, axis=-1, keepdims=True)
    xc = xf - mu
    y = xc * lax.rsqrt(jnp.mean(xc * xc, axis=-1, keepdims=True) + LN_EPS)
    return (y * g.astype(jnp.float32)).astype(x.dtype)


def conv3_centred(x, w):
    xp = jnp.pad(x, ((0, 0), (1, 1), (0, 0)))
    return xp[:, :-2] * w[0] + xp[:, 1:-1] * w[1] + xp[:, 2:] * w[2]


def spatial_gating(u, v, ln_g, w_s, b_s):
    bsz, L, _ = v.shape
    v = layernorm(v, ln_g)
    vc = v.reshape(bsz, L // CHUNK, CHUNK, A_GROUPS, A_GROUP_DIM)
    s = jnp.einsum("gpq,bnqgc->bnpgc", w_s, vc) + b_s.T[:, :, None]
    return u * s.reshape(bsz, L, A_WIDTH)


def hyena_filter_spectra(L, w1, b1, freq, w2, b2, w3, decay):
    t = jnp.arange(L, dtype=jnp.float32)
    t01 = t / max(L - 1, 1)
    w = 2 * math.pi * t / L
    bands = jnp.linspace(1e-4, FILTER_BANDS - 1, FILTER_BANDS, dtype=jnp.float32)
    fw = w[:, None] * bands[None, :]
    z = jnp.concatenate([t01[:, None], jnp.cos(fw), -jnp.sin(fw)], axis=-1)
    f32 = lambda a: a.astype(jnp.float32)
    h = jnp.sin(f32(freq[0]) * (z @ f32(w1) + f32(b1)))
    h = jnp.sin(f32(freq[1]) * (h @ f32(w2) + f32(b2)))
    h = h @ f32(w3)
    h = h * jnp.exp(-t01[:, None] * jnp.abs(f32(decay))[None, :])
    h = h.reshape(L, HYENA_DIRS, HYENA_ORDER, B_WIDTH)
    fwd, bwd = h[:, 0], h[:, 1]
    buf = jnp.concatenate([fwd, jnp.zeros_like(fwd[:1]), bwd[:L - 1][::-1]], axis=0)
    return jnp.fft.rfft(buf, axis=0)


def fft_long_conv(z, h_spec, skip):
    L = z.shape[1]
    zf = z.astype(jnp.float32)
    zs = jnp.fft.rfft(zf, n=2 * L, axis=1)
    y = jnp.fft.irfft(zs * h_spec[None], n=2 * L, axis=1)[:, :L]
    return (y + zf * skip.astype(jnp.float32)).astype(z.dtype)


def hyena_mixer(proj, conv_w, w1, b1, freq, w2, b2, w3, decay, skip):
    L = proj.shape[1]
    pc = conv3_centred(proj, conv_w)
    v = pc[..., :B_WIDTH]
    gates = (pc[..., B_WIDTH:2 * B_WIDTH], pc[..., 2 * B_WIDTH:])
    spec = hyena_filter_spectra(L, w1, b1, freq, w2, b2, w3, decay)
    z = v
    for o in range(HYENA_ORDER):
        z = gates[o] * fft_long_conv(z, spec[:, o], skip[o])
    return z


def multiscale_pool(x, w_grp, scale):
    L = x.shape[1]
    t = jnp.arange(L)
    outs = []
    for g, w in enumerate(POOL_WINDOWS):
        left = w // 2
        right = w - left - 1
        xg = x[..., g * C_GROUP_DIM:(g + 1) * C_GROUP_DIM].astype(jnp.float32)
        xp = jnp.pad(xg, ((0, 0), (left, right), (0, 0)))
        cs = jnp.concatenate([jnp.zeros_like(xp[:, :1]), jnp.cumsum(xp, axis=1)], axis=1)
        s = cs[:, w:] - cs[:, :L]
        cnt = (jnp.minimum(t + right, L - 1) - jnp.maximum(t - left, 0) + 1).astype(jnp.float32)
        pooled = (s / cnt[None, :, None] - xg).astype(x.dtype)
        outs.append(pooled @ w_grp[g])
    return jnp.concatenate(outs, axis=-1) * scale


def short_gated_conv(proj, conv_w):
    b = proj[..., :D_WIDTH]
    c = proj[..., D_WIDTH:2 * D_WIDTH]
    h = proj[..., 2 * D_WIDTH:]
    return b * conv3_centred(c * h, conv_w)


def swiglu(x, w_gu, w_down):
    gu = x @ w_gu
    return (jax.nn.silu(gu[..., :D_FF]) * gu[..., D_FF:]) @ w_down


def setup_inputs(seed: int = 0) -> dict:
    key = jax.random.key(seed)
    ks = jax.random.split(key, 24)

    def nrm(k, shape, scale):
        return jax.random.normal(k, shape, jnp.float32) * scale

    min_decay = math.log(DECAY_TARGET) / SLOW_DECAY_PCT
    max_decay = math.log(DECAY_TARGET) / FAST_DECAY_PCT
    base_decay = jnp.linspace(min_decay, max_decay, FILTER_OUT, dtype=jnp.float32)
    return {
        "x": nrm(ks[0], (BATCH, SEQ, D_MODEL), 1.0),
        "norm_g": 1.0 + nrm(ks[1], (DEPTH, 4, D_MODEL), 0.1),
        "ffn_w_gu": nrm(ks[2], (DEPTH, D_MODEL, 2 * D_FF), D_MODEL ** -0.5),
        "ffn_w_down": nrm(ks[3], (DEPTH, D_FF, D_MODEL), D_FF ** -0.5),
        "ab_w_in": nrm(ks[4], (N_EVEN, D_MODEL, AB_IN), D_MODEL ** -0.5),
        "ab_w_out": nrm(ks[5], (N_EVEN, A_WIDTH + B_WIDTH, D_MODEL), (A_WIDTH + B_WIDTH) ** -0.5),
        "a_ln_g": 1.0 + nrm(ks[6], (N_EVEN, A_WIDTH), 0.1),
        "a_w_s": nrm(ks[7], (N_EVEN, A_GROUPS, CHUNK, CHUNK), CHUNK ** -0.5),
        "a_b_s": 1.0 + nrm(ks[8], (N_EVEN, A_GROUPS, CHUNK), 0.1),
        "b_conv_w": nrm(ks[9], (N_EVEN, SHORT_CONV, 3 * B_WIDTH), SHORT_CONV ** -0.5),
        "b_filt_w1": nrm(ks[10], (N_EVEN, FILTER_EMB, FILTER_HIDDEN), FILTER_EMB ** -0.5),
        "b_filt_b1": nrm(ks[11], (N_EVEN, FILTER_HIDDEN), 0.1),
        "b_filt_freq": 1.0 + nrm(ks[12], (N_EVEN, 2, FILTER_HIDDEN), 0.05),
        "b_filt_w2": nrm(ks[13], (N_EVEN, FILTER_HIDDEN, FILTER_HIDDEN), FILTER_HIDDEN ** -0.5),
        "b_filt_b2": nrm(ks[14], (N_EVEN, FILTER_HIDDEN), 0.1),
        "b_filt_w3": nrm(ks[15], (N_EVEN, FILTER_HIDDEN, FILTER_OUT), 0.02),
        "b_decay": base_decay[None, :] * (1.0 + nrm(ks[16], (N_EVEN, FILTER_OUT), 0.05)),
        "b_skip": nrm(ks[17], (N_EVEN, HYENA_ORDER, B_WIDTH), 1.0),
        "cd_w_in": nrm(ks[18], (N_ODD, D_MODEL, CD_IN), D_MODEL ** -0.5),
        "cd_w_out": nrm(ks[19], (N_ODD, C_WIDTH + D_WIDTH, D_MODEL), (C_WIDTH + D_WIDTH) ** -0.5),
        "c_w": nrm(ks[20], (N_ODD, C_GROUPS, C_GROUP_DIM, C_GROUP_DIM), C_GROUP_DIM ** -0.5),
        "c_scale": 1.0 + nrm(ks[21], (N_ODD, C_WIDTH), 0.1),
        "d_conv_w": nrm(ks[22], (N_ODD, SHORT_CONV, D_WIDTH), SHORT_CONV ** -0.5),
    }


def reference(x, norm_g, ffn_w_gu, ffn_w_down, ab_w_in, ab_w_out, a_ln_g, a_w_s, a_b_s,
              b_conv_w, b_filt_w1, b_filt_b1, b_filt_freq, b_filt_w2, b_filt_b2, b_filt_w3,
              b_decay, b_skip, cd_w_in, cd_w_out, c_w, c_scale, d_conv_w):
    for i in range(DEPTH):
        g = norm_g[i]
        h = rmsnorm(x, g[0])
        if i % 2 == 0:
            j = i // 2
            proj = h @ ab_w_in[j]
            za = jax.nn.gelu(proj[..., :2 * A_WIDTH])
            y_a = spatial_gating(za[..., :A_WIDTH], za[..., A_WIDTH:], a_ln_g[j], a_w_s[j], a_b_s[j])
            y_b = hyena_mixer(proj[..., 2 * A_WIDTH:], b_conv_w[j], b_filt_w1[j], b_filt_b1[j],
                              b_filt_freq[j], b_filt_w2[j], b_filt_b2[j], b_filt_w3[j],
                              b_decay[j], b_skip[j])
            mix = jnp.concatenate([y_a, y_b], axis=-1) @ ab_w_out[j]
        else:
            j = i // 2
            proj = h @ cd_w_in[j]
            y_c = multiscale_pool(proj[..., :C_WIDTH], c_w[j], c_scale[j])
            y_d = short_gated_conv(proj[..., C_WIDTH:], d_conv_w[j])
            mix = jnp.concatenate([y_c, y_d], axis=-1) @ cd_w_out[j]
        x = x + rmsnorm(mix, g[1])
        f = swiglu(rmsnorm(x, g[2]), ffn_w_gu[i], ffn_w_down[i])
        x = x + rmsnorm(f, g[3])
    return x
```

```cpp
#include <hip/hip_runtime.h>
#include <hip/hip_cooperative_groups.h>
#include <cstdio>
namespace cg = cooperative_groups;

#ifndef ONE_LAUNCH
#define ONE_LAUNCH 1
#endif

__device__ __forceinline__ int opaque_tid() { int t = (int)threadIdx.x; asm volatile("" : "+v"(t)); return t; }
namespace pg8 {
#define PG8_LAS __attribute__((address_space(3)))
typedef unsigned short bf16_t;
typedef short bf16x8 __attribute__((ext_vector_type(8)));
typedef float f32x4 __attribute__((ext_vector_type(4)));
typedef unsigned u32x4 __attribute__((ext_vector_type(4)));
constexpr int BM = 256, BK = 64, HALF = 128, HTB = HALF * BK * 2  , STAGE_BYTES = 8 * HTB, NXCD = 8, WGM = 8;

__host__ __device__ __forceinline__ int lds_byte(int r, int c) { const int st = (r >> 4) * 2 + (c >> 5), rr = r & 15, cc = c & 31, ob = rr * 64 + cc * 2; return st * 1024 + (ob ^ (((ob >> 9) & 1) << 5)); }
__host__ __device__ __forceinline__ void stage_rc(int b, int& R, int& C) { const int st = b / 1024, sb = b % 1024, swz = sb ^ (((sb >> 9) & 1) << 5); R = (st >> 1) * 16 + swz / 64; C = (st & 1) * 32 + (swz % 64) / 2; }
__host__ __device__ __forceinline__ int perm32(int rho) { const int n = rho >> 4, i = rho & 15; return 8 * (i >> 2) + 4 * n + (i & 3); }
struct Unit { int pm, pn; };
struct Gemm { const bf16_t* A; const bf16_t* Bt; int M, N, K; };

struct StaticOrder {
    int nM, nN, nwg, G, c;
    __host__ __device__ void init(int M, int N, int G_, int c_) { nM = M / BM; nN = N / BM; nwg = nM * nN; G = G_; c = c_; }
    __host__ __device__ bool next(int i, Unit& u) const {
        const long L = (long)i * G + c; if (L >= nwg) return false;
        int wgid = (int)L; { const int q = nwg / NXCD, r = nwg % NXCD, xcd = wgid % NXCD, off = wgid / NXCD; wgid = (xcd < r ? xcd * (q + 1) : r * (q + 1) + (xcd - r) * q) + off; }
        const int nig = WGM * nN, gid = wgid / nig, fm = gid * WGM, gsz = (nM - fm) < WGM ? (nM - fm) : WGM;
        u.pm = fm + ((wgid % nig) % gsz); u.pn = (wgid % nig) / gsz; return true;
    }
    __device__ __forceinline__ void a_ready(const Unit&) const {}
    __device__ __forceinline__ void done(const Unit&) const {}
};
__device__ __forceinline__ unsigned cvt_pk_bf16(float lo, float hi) { unsigned r; asm volatile("v_cvt_pk_bf16_f32 %0, %1, %2" : "=v"(r) : "v"(lo), "v"(hi)); return r; }

__device__ __forceinline__ float gelu_tanh_f(float x) { const float y = 1.5957691216f * (x + 0.044715f * x * x * x); return x * __builtin_amdgcn_rcpf(1.0f + __expf(-y)); }
__device__ __forceinline__ float silu_f(float x) { return x * __builtin_amdgcn_rcpf(1.0f + __expf(-x)); }

struct EpiBf16G {
    static constexpr bool PERM = true, AFTER_DRAIN = false;
    bf16_t* O; int ldc; int gelu_tiles;
    __device__ __forceinline__ void operator()(const f32x4 (&acc)[2][2][4][2], const Unit& u, int wr, int wc, int fr, int fq) const {
        const int row0 = u.pm * BM + wr * 64 + fr, col0 = u.pn * BM + wc * 32 + 8 * fq;
        const bool act = u.pn < gelu_tiles;
#pragma unroll
        for (int ai = 0; ai < 2; ++ai)
#pragma unroll
            for (int m = 0; m < 4; ++m) { bf16_t* rowp = O + (size_t)(row0 + ai * HALF + m * 16) * ldc + col0;
#pragma unroll
                for (int bj = 0; bj < 2; ++bj) { f32x4 v0 = acc[ai][bj][m][0], v1 = acc[ai][bj][m][1];
                    if (act) {
#pragma unroll
                        for (int j = 0; j < 4; ++j) { v0[j] = gelu_tanh_f(v0[j]); v1[j] = gelu_tanh_f(v1[j]); } }
                    u32x4 w; w.x = cvt_pk_bf16(v0[0], v0[1]); w.y = cvt_pk_bf16(v0[2], v0[3]); w.z = cvt_pk_bf16(v1[0], v1[1]); w.w = cvt_pk_bf16(v1[2], v1[3]);
                    *(u32x4*)(rowp + bj * HALF) = w; } }
    }
};
struct EpiSwiGLU {
    static constexpr bool PERM = true, AFTER_DRAIN = false;
    bf16_t* O; int ldc;
    __device__ __forceinline__ void operator()(const f32x4 (&acc)[2][2][4][2], const Unit& u, int wr, int wc, int fr, int fq) const {
        const int row0 = u.pm * BM + wr * 64 + fr, col0 = u.pn * HALF + wc * 32 + 8 * fq;
#pragma unroll
        for (int ai = 0; ai < 2; ++ai)
#pragma unroll
            for (int m = 0; m < 4; ++m) { bf16_t* rowp = O + (size_t)(row0 + ai * HALF + m * 16) * ldc + col0;
                f32x4 v0, v1;
#pragma unroll
                for (int j = 0; j < 4; ++j) { v0[j] = silu_f(acc[ai][0][m][0][j]) * acc[ai][1][m][0][j]; v1[j] = silu_f(acc[ai][0][m][1][j]) * acc[ai][1][m][1][j]; }
                u32x4 w; w.x = cvt_pk_bf16(v0[0], v0[1]); w.y = cvt_pk_bf16(v0[2], v0[3]); w.z = cvt_pk_bf16(v1[0], v1[1]); w.w = cvt_pk_bf16(v1[2], v1[3]);
                *(u32x4*)rowp = w; }
    }
};

template <class Epi, class Sched, bool STAMP = false>
__device__ __forceinline__ void gemm_phase(PG8_LAS unsigned char* lds, const Gemm g, const Sched& S, const Epi& E, unsigned long long* stamps) {
    const int tid = opaque_tid(), wid = __builtin_amdgcn_readfirstlane(tid >> 6), lane = tid & 63, wr = wid >> 2, wc = wid & 3, fr = lane & 15, fq = lane >> 4;
    const int K = g.K, nt = K / BK;
    int ts_lo = 0, ts_hi = 0, nts = 0; const unsigned long long rt_entry = STAMP ? (unsigned long long)wall_clock64() : 0ull;
#define PG8_STAMP() do { if (STAMP && wid == 0 && nts < 64) { const unsigned long long _c = (unsigned long long)clock64(); \
        ts_lo = (lane == nts) ? (int)(unsigned)_c : ts_lo; ts_hi = (lane == nts) ? (int)(unsigned)(_c >> 32) : ts_hi; ++nts; } } while (0)
    PG8_STAMP();
    unsigned voffA[2], voffB[2];
#pragma unroll
    for (int i = 0; i < 2; ++i) { int R, C; stage_rc(tid * 16 + i * 8192, R, C); const int Rb = Epi::PERM ? ((R & ~31) + perm32(R & 31)) : R;
        voffA[i] = (unsigned)(R * K + C) * 2u; voffB[i] = (unsigned)(Rb * K + C) * 2u; }
    const size_t kstep = (size_t)(BK * 2);
    const size_t hstep = (size_t)HALF * K * 2;
    const size_t tstep = 2 * hstep;
    const unsigned ldsw = (unsigned)wid * 1024u;
    const int aoff = lds_byte(wr * 64 + fr, fq * 8), boff = lds_byte(wc * 32 + fr, fq * 8);
#define PG8_SA(b, h) (((b) * 2 + (h)) * HTB)
#define PG8_SB(b, h) ((4 + (b) * 2 + (h)) * HTB)
#define PG8_STAGE(bufoff, gbase, voff) do { _Pragma("unroll") for (int _i = 0; _i < 2; ++_i) \
        __builtin_amdgcn_global_load_lds((const unsigned*)((const char*)(gbase) + (voff)[_i]), (PG8_LAS unsigned*)(lds + (bufoff) + ldsw + _i * 8192), 16, 0, 0); } while (0)
#define PG8_LDA(dst, b, h) do { _Pragma("unroll") for (int m = 0; m < 4; ++m) _Pragma("unroll") for (int k = 0; k < 2; ++k) dst[m][k] = *(const PG8_LAS bf16x8*)(lds + PG8_SA(b, h) + aoff + m * 2048 + k * 1024); } while (0)
#define PG8_LDB(dst, b, h) do { _Pragma("unroll") for (int n = 0; n < 2; ++n) _Pragma("unroll") for (int k = 0; k < 2; ++k) dst[n][k] = *(const PG8_LAS bf16x8*)(lds + PG8_SB(b, h) + boff + n * 2048 + k * 1024); } while (0)
#define PG8_MMA(ai, bj, At, Bt) do { __builtin_amdgcn_s_setprio(1); _Pragma("unroll") for (int m = 0; m < 4; ++m) _Pragma("unroll") for (int n = 0; n < 2; ++n) _Pragma("unroll") for (int k = 0; k < 2; ++k) \
        acc[ai][bj][m][n] = __builtin_amdgcn_mfma_f32_16x16x32_bf16(Bt[n][k], At[m][k], acc[ai][bj][m][n], 0, 0, 0); __builtin_amdgcn_s_setprio(0); } while (0)
#define PG8_WAIT_V(n) asm volatile("s_waitcnt vmcnt(" #n ")" ::: "memory")
#define PG8_WAIT_L(n) asm volatile("s_waitcnt lgkmcnt(" #n ")" ::: "memory")
#define PG8_BAR __builtin_amdgcn_s_barrier()
#define PG8_SCHED __builtin_amdgcn_sched_barrier(0)
    Unit cur, nxt; int ui = 0;
    if (!S.next(0, cur)) return;
    f32x4 acc[2][2][4][2];
#pragma unroll
    for (int a = 0; a < 2; ++a)
#pragma unroll
        for (int b = 0; b < 2; ++b)
#pragma unroll
            for (int m = 0; m < 4; ++m)
#pragma unroll
                for (int n = 0; n < 2; ++n) acc[a][b][m][n] = (f32x4){0.f, 0.f, 0.f, 0.f};
    bf16x8 At[4][2], B0[2][2], B1[2][2];
    const char* cA = (const char*)g.A + (size_t)cur.pm * tstep; const char* cB = (const char*)g.Bt + (size_t)cur.pn * tstep;
    S.a_ready(cur);
    PG8_STAGE(PG8_SB(0, 0), cB, voffB); PG8_STAGE(PG8_SA(0, 0), cA, voffA); PG8_STAGE(PG8_SB(0, 1), cB + hstep, voffB); PG8_STAGE(PG8_SA(0, 1), cA + hstep, voffA);
    if (wr == 1) PG8_BAR;
    PG8_WAIT_V(4); PG8_BAR;
    PG8_STAGE(PG8_SB(1, 0), cB + kstep, voffB); PG8_STAGE(PG8_SA(1, 0), cA + kstep, voffA); PG8_STAGE(PG8_SB(1, 1), cB + hstep + kstep, voffB);
    PG8_WAIT_V(6); PG8_BAR;
    PG8_STAMP();
    for (;;) {
        const bool has_next = S.next(ui + 1, nxt);
        const char* nA = has_next ? (const char*)g.A + (size_t)nxt.pm * tstep : cA; const char* nB = has_next ? (const char*)g.Bt + (size_t)nxt.pn * tstep : cB;
        for (int t = 0; t < nt; t += 2) {
            const bool last = (t == nt - 2);
            const char* a1 = cA + (size_t)(t + 1) * kstep;
            const char* a2 = last ? nA : cA + (size_t)(t + 2) * kstep; const char* b2 = last ? nB : cB + (size_t)(t + 2) * kstep;
            const char* a3 = a2 + kstep; const char* b3 = b2 + kstep;
            if (last && has_next) S.a_ready(nxt);
            PG8_LDB(B0, 0, 0); PG8_SCHED; PG8_LDA(At, 0, 0); PG8_STAGE(PG8_SA(1, 1), a1 + hstep, voffA);
            PG8_WAIT_L(8); PG8_BAR; PG8_WAIT_L(0); PG8_MMA(0, 0, At, B0); PG8_BAR; PG8_SCHED;
            PG8_LDB(B1, 0, 1); PG8_STAGE(PG8_SB(0, 0), b2, voffB);
            PG8_BAR; PG8_WAIT_L(0); PG8_MMA(0, 1, At, B1); PG8_BAR;
            PG8_LDA(At, 0, 1); PG8_STAGE(PG8_SA(0, 0), a2, voffA);
            PG8_BAR; PG8_WAIT_L(0); PG8_MMA(1, 0, At, B0); PG8_BAR; PG8_SCHED;
            PG8_STAGE(PG8_SB(0, 1), b2 + hstep, voffB);
            PG8_WAIT_V(6); PG8_BAR; PG8_MMA(1, 1, At, B1); PG8_BAR;
            PG8_LDB(B0, 1, 0); PG8_SCHED; PG8_LDA(At, 1, 0); PG8_STAGE(PG8_SA(0, 1), a2 + hstep, voffA);
            PG8_WAIT_L(8); PG8_BAR; PG8_WAIT_L(0); PG8_MMA(0, 0, At, B0); PG8_BAR; PG8_SCHED;
            PG8_LDB(B1, 1, 1); PG8_STAGE(PG8_SB(1, 0), b3, voffB);
            PG8_BAR; PG8_WAIT_L(0); PG8_MMA(0, 1, At, B1); PG8_BAR;
            PG8_LDA(At, 1, 1); PG8_STAGE(PG8_SA(1, 0), a3, voffA);
            PG8_BAR; PG8_WAIT_L(0); PG8_MMA(1, 0, At, B0); PG8_BAR; PG8_SCHED;
            PG8_STAGE(PG8_SB(1, 1), b3 + hstep, voffB);
            PG8_WAIT_V(6); PG8_BAR; PG8_MMA(1, 1, At, B1); PG8_BAR;
        }
        PG8_STAMP();
        if constexpr (!Epi::AFTER_DRAIN) { E(acc, cur, wr, wc, fr, fq); S.done(cur); }
        PG8_STAMP();
        if (!has_next) break;
#pragma unroll
        for (int a = 0; a < 2; ++a)
#pragma unroll
            for (int b = 0; b < 2; ++b)
#pragma unroll
                for (int m = 0; m < 4; ++m)
#pragma unroll
                    for (int n = 0; n < 2; ++n) acc[a][b][m][n] = (f32x4){0.f, 0.f, 0.f, 0.f};
        cur = nxt; cA = nA; cB = nB; ++ui;
    }
    PG8_WAIT_V(0);
    if (wr == 0) PG8_BAR;
    PG8_BAR;
    if constexpr (Epi::AFTER_DRAIN) { E.fused(acc, cur, wr, wc, fr, fq, lds, wid, lane); S.done(cur); }
    PG8_STAMP();
    if (STAMP && wid == 0) { stamps[lane] = lane < nts ? (((unsigned long long)(unsigned)ts_hi << 32) | (unsigned)ts_lo) : 0ull;
        if (lane == 62) stamps[62] = rt_entry; if (lane == 63) stamps[63] = (unsigned long long)wall_clock64(); }
#undef PG8_STAMP
#undef PG8_SA
#undef PG8_SB
#undef PG8_STAGE
#undef PG8_LDA
#undef PG8_LDB
#undef PG8_MMA
#undef PG8_WAIT_V
#undef PG8_WAIT_L
#undef PG8_BAR
#undef PG8_SCHED
}
}

#define LAS PG8_LAS
typedef unsigned short u16;
typedef unsigned char uchar;
using pg8::bf16x8; using pg8::f32x4; using pg8::u32x4; using pg8::cvt_pk_bf16;
typedef float f32x16 __attribute__((ext_vector_type(16)));
typedef unsigned u32x2 __attribute__((ext_vector_type(2)));
typedef int i32x4 __attribute__((ext_vector_type(4)));

constexpr int T_ = 65536, DM = 1024, SEQ = 2048, NB = 32, DFF = 2816, NTHR = 512;
constexpr int LDS_BYTES = 151552;
constexpr size_t SZ_ABIN = 2ull * 2560 * 1024 * 2, SZ_ABOUT = 2ull * 1024 * 1024 * 2, SZ_CDIN = 2ull * 2048 * 1024 * 2, SZ_CDOUT = 2ull * 1024 * 1024 * 2,
                 SZ_GU = 4ull * 5632 * 1024 * 2, SZ_DOWN = 4ull * 1024 * 2816 * 2, SZ_G = 2ull * 2 * 512 * 4096 * 2;
constexpr size_t WS_ABIN = 0, WS_ABOUT = WS_ABIN + SZ_ABIN, WS_CDIN = WS_ABOUT + SZ_ABOUT, WS_CDOUT = WS_CDIN + SZ_CDIN, WS_GU = WS_CDOUT + SZ_CDOUT, WS_DOWN = WS_GU + SZ_GU,
                 WS_G = WS_DOWN + SZ_DOWN,
                 WS_H = WS_G + SZ_G,
                 WS_B = WS_H + (size_t)T_ * 1024 * 2,
                 WS_C = WS_B + (size_t)T_ * 2560 * 2,
                 WS_D = WS_C + (size_t)1536 * 32 * 2048 * 2,
                 WS_E = WS_D + (size_t)T_ * 1024 * 2,
                 WS_END = WS_E + (size_t)T_ * 1024 * 2;
static_assert(WS_END <= (1ull << 30), "workspace map exceeds 1 GiB");
static_assert((size_t)T_ * DFF * 2 <= WS_D - WS_B, "act does not fit B + C");

__device__ __forceinline__ float bflo(unsigned w) { return __uint_as_float(w << 16); }
__device__ __forceinline__ float bfhi(unsigned w) { return __uint_as_float(w & 0xffff0000u); }
__device__ __forceinline__ float bf2f(u16 v) { return __uint_as_float(((unsigned)v) << 16); }
__device__ __forceinline__ u16 f2bf(float f) { return (u16)(cvt_pk_bf16(f, 0.f) & 0xffffu); }
__device__ __forceinline__ float wave_sum(float v) {
#pragma unroll
    for (int o = 32; o >= 1; o >>= 1) v += __shfl_xor(v, o, 64);
    return v;
}

__device__ void wt_job(LAS uchar* lds, const float* __restrict__ W, int ldw, int K, int N, u16* __restrict__ out, int ldo, int mode) {
    LAS float* tile = (LAS float*)lds;
    const int tid = opaque_tid(); const int nkt = K / 64, nnt = N / 64, ntiles = nkt * nnt;
    for (int ti = blockIdx.x; ti < ntiles; ti += gridDim.x) {
        const int kt = ti % nkt, nt = ti / nkt; const int k0 = kt * 64, n0 = nt * 64;
        int sc0 = n0; if (mode == 1) { const int pn = n0 >> 8, r = n0 & 255; sc0 = (r < 128) ? (pn * 128 + r) : (DFF + pn * 128 + (r - 128)); }
#pragma unroll
        for (int i = 0; i < 2; ++i) { const int idx = tid + i * 512; const int kk = idx >> 4, c4 = (idx & 15) * 4;
            const float4 v = *(const float4*)(W + (size_t)(k0 + kk) * ldw + sc0 + c4);
            tile[kk * 65 + c4 + 0] = v.x; tile[kk * 65 + c4 + 1] = v.y; tile[kk * 65 + c4 + 2] = v.z; tile[kk * 65 + c4 + 3] = v.w; }
        __syncthreads();
        { const int nn = tid >> 3, kc = (tid & 7) * 8;
          float f0 = tile[(kc + 0) * 65 + nn], f1 = tile[(kc + 1) * 65 + nn], f2 = tile[(kc + 2) * 65 + nn], f3 = tile[(kc + 3) * 65 + nn];
          float f4 = tile[(kc + 4) * 65 + nn], f5 = tile[(kc + 5) * 65 + nn], f6 = tile[(kc + 6) * 65 + nn], f7 = tile[(kc + 7) * 65 + nn];
          u32x4 w; w.x = cvt_pk_bf16(f0, f1); w.y = cvt_pk_bf16(f2, f3); w.z = cvt_pk_bf16(f4, f5); w.w = cvt_pk_bf16(f6, f7);
          *(u32x4*)(out + (size_t)(n0 + nn) * ldo + k0 + kc) = w; }
        __syncthreads();
    }
}
__device__ void fold_job(const float* __restrict__ cw, const float* __restrict__ scale, const float* __restrict__ Wout, u16* __restrict__ out) {
    for (int idx = blockIdx.x * NTHR + opaque_tid(); idx < 512 * 1024; idx += gridDim.x * NTHR) {
        const int k = idx >> 10, n = idx & 1023; const int g = k >> 7;
        const float* cwr = cw + (size_t)k * 128;
        float acc = 0.f;
        for (int c2 = 0; c2 < 128; ++c2) acc += cwr[c2] * scale[g * 128 + c2] * Wout[(size_t)(g * 128 + c2) * 1024 + n];
        out[(size_t)n * 1024 + k] = f2bf(acc);
    }
}
__device__ void filter_job(LAS uchar* lds, const float* __restrict__ w1a, const float* __restrict__ b1a, const float* __restrict__ freqa, const float* __restrict__ w2a,
                           const float* __restrict__ b2a, const float* __restrict__ w3a, const float* __restrict__ decaya, u16* __restrict__ Gall) {
    LAS float* zf = (LAS float*)lds;
    LAS float* h1 = zf + 64 * 33;
    LAS float* h2 = h1 + 64 * 64;
    const int tid = opaque_tid(), lane = tid & 63, wave = tid >> 6;
    for (int item = blockIdx.x; item < 256; item += gridDim.x) {
        const int j = item >> 7, tg = (item >> 2) & 31, cq = item & 3, t0 = tg * 64;
        const float* w1 = w1a + j * 33 * 64; const float* b1 = b1a + j * 64; const float* freq = freqa + j * 128; const float* w2 = w2a + j * 4096; const float* b2 = b2a + j * 64;
        const float* w3 = w3a + (size_t)j * 64 * 2048; const float* decay = decaya + j * 2048; u16* Gj = Gall + (size_t)j * 2 * 512 * 4096;
        for (int idx = tid; idx < 64 * 33; idx += NTHR) { const int tt = idx / 33, f = idx - tt * 33; const float t = (float)(t0 + tt);
            float val;
            if (f == 0) val = t / 2047.0f;
            else { const int fi = (f - 1) & 15; const float band = 1e-4f + (float)fi * ((15.0f - 1e-4f) / 15.0f); const float w = 6.283185307179586f * t / 2048.0f; const float fw = w * band;
                   val = (f <= 16) ? cosf(fw) : -sinf(fw); }
            zf[idx] = val; }
        __syncthreads();
        for (int idx = tid; idx < 4096; idx += NTHR) { const int tt = idx >> 6, k = idx & 63; float acc = 0.f;
            for (int f = 0; f < 33; ++f) acc += zf[tt * 33 + f] * w1[f * 64 + k];
            h1[tt * 64 + k] = sinf(freq[k] * (acc + b1[k])); }
        __syncthreads();
        for (int idx = tid; idx < 4096; idx += NTHR) { const int tt = idx >> 6, k = idx & 63; float acc = 0.f;
            for (int k2 = 0; k2 < 64; ++k2) acc += h1[tt * 64 + k2] * w2[k2 * 64 + k];
            h2[k * 64 + tt] = sinf(freq[64 + k] * (acc + b2[k])); }
        __syncthreads();
        { const int t = t0 + lane; const float t01 = (float)t / 2047.0f;
          for (int ci = 0; ci < 64; ++ci) { const int col = cq * 512 + wave * 64 + ci; float acc = 0.f;
#pragma unroll 8
              for (int k = 0; k < 64; ++k) acc += h2[k * 64 + lane] * w3[k * 2048 + col];
              acc *= expf(-t01 * fabsf(decay[col]));
              const int dir = col >> 10, o = (col >> 9) & 1, c = col & 511; u16* g = Gj + (size_t)(o * 512 + c) * 4096;
              if (dir == 0) { g[2048 - t] = f2bf(acc); if (t == 0) g[0] = 0; } else if (t <= 2046) g[2049 + t] = f2bf(acc); } }
        __syncthreads();
    }
}

__device__ void resid_pass(const float* __restrict__ xin, const u16* __restrict__ mix, const float* __restrict__ gpost, float* __restrict__ xout, const float* __restrict__ gnext, u16* __restrict__ hout) {
    const int tid = opaque_tid(); const int lane = tid & 63, wave = tid >> 6;
    for (int row = blockIdx.x * 8 + wave; row < T_; row += gridDim.x * 8) {
        float4 xv[4];
#pragma unroll
        for (int c = 0; c < 4; ++c) xv[c] = *(const float4*)(xin + (size_t)row * 1024 + c * 256 + lane * 4);
        if (mix) {
            float4 mv[4]; float ss = 0.f;
#pragma unroll
            for (int c = 0; c < 4; ++c) { const u32x2 m = *(const u32x2*)(mix + (size_t)row * 1024 + c * 256 + lane * 4);
                mv[c].x = bflo(m.x); mv[c].y = bfhi(m.x); mv[c].z = bflo(m.y); mv[c].w = bfhi(m.y);
                ss += mv[c].x * mv[c].x + mv[c].y * mv[c].y + mv[c].z * mv[c].z + mv[c].w * mv[c].w; }
            ss = wave_sum(ss); const float rstd = rsqrtf(ss * (1.0f / 1024.0f) + 1e-6f);
#pragma unroll
            for (int c = 0; c < 4; ++c) { const float4 g = *(const float4*)(gpost + c * 256 + lane * 4);
                xv[c].x += mv[c].x * rstd * g.x; xv[c].y += mv[c].y * rstd * g.y; xv[c].z += mv[c].z * rstd * g.z; xv[c].w += mv[c].w * rstd * g.w;
                *(float4*)(xout + (size_t)row * 1024 + c * 256 + lane * 4) = xv[c]; }
        }
        if (gnext) {
            float ss = 0.f;
#pragma unroll
            for (int c = 0; c < 4; ++c) ss += xv[c].x * xv[c].x + xv[c].y * xv[c].y + xv[c].z * xv[c].z + xv[c].w * xv[c].w;
            ss = wave_sum(ss); const float rstd = rsqrtf(ss * (1.0f / 1024.0f) + 1e-6f);
#pragma unroll
            for (int c = 0; c < 4; ++c) { const float4 g = *(const float4*)(gnext + c * 256 + lane * 4);
                u32x2 w; w.x = cvt_pk_bf16(xv[c].x * rstd * g.x, xv[c].y * rstd * g.y); w.y = cvt_pk_bf16(xv[c].z * rstd * g.z, xv[c].w * rstd * g.w);
                *(u32x2*)(hout + (size_t)row * 1024 + c * 256 + lane * 4) = w; }
        }
    }
}

__device__ __forceinline__ void tr_tile(LAS u16* tile  , const u16* __restrict__ src, size_t lds_src, u16* __restrict__ dst, size_t ldd) {
    const int tid = opaque_tid(), r = tid >> 3, ch = (tid & 7) * 8;
    const u32x4 v = *(const u32x4*)(src + (size_t)r * lds_src + ch);
    tile[(ch + 0) * 72 + r] = (u16)(v.x & 0xffffu); tile[(ch + 1) * 72 + r] = (u16)(v.x >> 16);
    tile[(ch + 2) * 72 + r] = (u16)(v.y & 0xffffu); tile[(ch + 3) * 72 + r] = (u16)(v.y >> 16);
    tile[(ch + 4) * 72 + r] = (u16)(v.z & 0xffffu); tile[(ch + 5) * 72 + r] = (u16)(v.z >> 16);
    tile[(ch + 6) * 72 + r] = (u16)(v.w & 0xffffu); tile[(ch + 7) * 72 + r] = (u16)(v.w >> 16);
    __syncthreads();
    const u32x4 o = *(const LAS u32x4*)(tile + r * 72 + ch);
    *(u32x4*)(dst + (size_t)r * ldd + ch) = o;
    __syncthreads();
}
__device__ void transpose_fwd_phase(LAS uchar* lds, const u16* __restrict__ proj, u16* __restrict__ pT) {
    LAS u16* tile = (LAS u16*)lds;
    const int ntiles = NB * 32 * 24;
    for (int ti = blockIdx.x; ti < ntiles; ti += gridDim.x) {
        const int ct = ti % 24, st = (ti / 24) & 31, b = ti / (24 * 32);
        tr_tile(tile, proj + (size_t)(b * SEQ + st * 64) * 2560 + 1024 + ct * 64, 2560, pT + ((size_t)(ct * 64) * NB + b) * SEQ + st * 64, (size_t)NB * SEQ);
    }
}
__device__ void transpose_back_phase(LAS uchar* lds, const u16* __restrict__ yT, u16* __restrict__ ycat) {
    LAS u16* tile = (LAS u16*)lds;
    const int ntiles = NB * 32 * 8;
    for (int ti = blockIdx.x; ti < ntiles; ti += gridDim.x) {
        const int st = ti & 31, ct = (ti >> 5) & 7, b = ti >> 8;
        tr_tile(tile, yT + ((size_t)(ct * 64) * NB + b) * SEQ + st * 64, (size_t)NB * SEQ, ycat + (size_t)(b * SEQ + st * 64) * 1024 + 512 + ct * 64, 1024);
    }
}

__device__ void gating_phase(LAS uchar* lds, const u16* __restrict__ proj  , const float* __restrict__ ln_g  ,
                             const float* __restrict__ w_s  , const float* __restrict__ b_s  , u16* __restrict__ ycat  ) {
    LAS u16* vT = (LAS u16*)lds;
    LAS u16* wsb = vT + 128 * 136;
    LAS float* stats = (LAS float*)(wsb + 128 * 136);
    const int tid = opaque_tid(), lane = tid & 63, wave = tid >> 6, fr = lane & 15, fq = lane >> 4;
    for (int item = blockIdx.x; item < T_ / 128; item += gridDim.x) {
        const int tok0 = item * 128;
        for (int tt = 0; tt < 16; ++tt) { const int q = wave * 16 + tt;
            const u32x4 v = *(const u32x4*)(proj + (size_t)(tok0 + q) * 2560 + 512 + lane * 8);
            const float f0 = bflo(v.x), f1 = bfhi(v.x), f2 = bflo(v.y), f3 = bfhi(v.y), f4 = bflo(v.z), f5 = bfhi(v.z), f6 = bflo(v.w), f7 = bfhi(v.w);
            const float mean = wave_sum(f0 + f1 + f2 + f3 + f4 + f5 + f6 + f7) * (1.0f / 512.0f);
            const float d0 = f0 - mean, d1 = f1 - mean, d2 = f2 - mean, d3 = f3 - mean, d4 = f4 - mean, d5 = f5 - mean, d6 = f6 - mean, d7 = f7 - mean;
            const float var = wave_sum(d0 * d0 + d1 * d1 + d2 * d2 + d3 * d3 + d4 * d4 + d5 * d5 + d6 * d6 + d7 * d7) * (1.0f / 512.0f);
            if (lane == 0) { stats[q * 2] = mean; stats[q * 2 + 1] = rsqrtf(var + 1e-5f); } }
        __syncthreads();
        for (int g = 0; g < 4; ++g) {
#pragma unroll
            for (int i = 0; i < 4; ++i) { const int idx = tid + i * NTHR; const int q = idx >> 4, c0 = (idx & 15) * 8;
                const u32x4 v = *(const u32x4*)(proj + (size_t)(tok0 + q) * 2560 + 512 + g * 128 + c0);
                const float mean = stats[q * 2], rstd = stats[q * 2 + 1];
                const float4 g0 = *(const float4*)(ln_g + g * 128 + c0), g1 = *(const float4*)(ln_g + g * 128 + c0 + 4);
                vT[(c0 + 0) * 136 + q] = f2bf((bflo(v.x) - mean) * rstd * g0.x); vT[(c0 + 1) * 136 + q] = f2bf((bfhi(v.x) - mean) * rstd * g0.y);
                vT[(c0 + 2) * 136 + q] = f2bf((bflo(v.y) - mean) * rstd * g0.z); vT[(c0 + 3) * 136 + q] = f2bf((bfhi(v.y) - mean) * rstd * g0.w);
                vT[(c0 + 4) * 136 + q] = f2bf((bflo(v.z) - mean) * rstd * g1.x); vT[(c0 + 5) * 136 + q] = f2bf((bfhi(v.z) - mean) * rstd * g1.y);
                vT[(c0 + 6) * 136 + q] = f2bf((bflo(v.w) - mean) * rstd * g1.z); vT[(c0 + 7) * 136 + q] = f2bf((bfhi(v.w) - mean) * rstd * g1.w); }
#pragma unroll
            for (int i = 0; i < 8; ++i) { const int idx = tid + i * NTHR; const int p = idx >> 5, q0 = (idx & 31) * 4;
                const float4 w = *(const float4*)(w_s + (size_t)(g * 128 + p) * 128 + q0);
                u32x2 o; o.x = cvt_pk_bf16(w.x, w.y); o.y = cvt_pk_bf16(w.z, w.w);
                *(LAS u32x2*)(wsb + p * 136 + q0) = o; }
            __syncthreads();
            f32x4 acc[8];
#pragma unroll
            for (int mi = 0; mi < 8; ++mi) acc[mi] = (f32x4){0.f, 0.f, 0.f, 0.f};
#pragma unroll
            for (int kk = 0; kk < 4; ++kk) {
                const bf16x8 bfrag = *(const LAS bf16x8*)(wsb + (16 * wave + fr) * 136 + 32 * kk + 8 * fq);
#pragma unroll
                for (int mi = 0; mi < 8; ++mi) { const bf16x8 afrag = *(const LAS bf16x8*)(vT + (16 * mi + fr) * 136 + 32 * kk + 8 * fq);
                    acc[mi] = __builtin_amdgcn_mfma_f32_16x16x32_bf16(afrag, bfrag, acc[mi], 0, 0, 0); }
            }
            { const int p = 16 * wave + fr; const size_t tok = (size_t)(tok0 + p); const float bias = b_s[g * 128 + p];
#pragma unroll
              for (int mi = 0; mi < 8; ++mi) { const int c = 16 * mi + 4 * fq;
                  const u32x2 uu = *(const u32x2*)(proj + tok * 2560 + g * 128 + c);
                  u32x2 o; o.x = cvt_pk_bf16(bflo(uu.x) * (acc[mi][0] + bias), bfhi(uu.x) * (acc[mi][1] + bias)); o.y = cvt_pk_bf16(bflo(uu.y) * (acc[mi][2] + bias), bfhi(uu.y) * (acc[mi][3] + bias));
                  *(u32x2*)(ycat + tok * 1024 + g * 128 + c) = o; } }
            __syncthreads();
        }
    }
}

constexpr int HZ_ROW = 4112;
constexpr int HZ_KR0 = NB * HZ_ROW;
constexpr int HZ_KRC = 8208;
static_assert(HZ_KR0 + 2 * HZ_KRC <= LDS_BYTES, "hyena LDS");

__device__ __forceinline__ void hy_load_kr(LAS uchar* lds, const u16* __restrict__ g) {
    const int tid = opaque_tid();
    const u32x4 w = *(const u32x4*)(g + tid * 8);
    const unsigned nxt = (tid < 511) ? (unsigned)g[tid * 8 + 8] : 0u;
    *(LAS u32x4*)(lds + HZ_KR0 + tid * 16) = w;
    u32x4 s; s.x = (w.x >> 16) | (w.y << 16); s.y = (w.y >> 16) | (w.z << 16); s.z = (w.z >> 16) | (w.w << 16); s.w = (w.w >> 16) | (nxt << 16);
    *(LAS u32x4*)(lds + HZ_KR0 + HZ_KRC + tid * 16) = s;
}
__device__ __forceinline__ void conv3_8(const u16* __restrict__ p, int s0, float w0, float w1, float w2, float (&o)[8]) {
    const u32x4 v = *(const u32x4*)(p + s0);
    const float prev = (s0 > 0) ? bf2f(p[s0 - 1]) : 0.f, next = (s0 + 8 < SEQ) ? bf2f(p[s0 + 8]) : 0.f;
    const float x0 = bflo(v.x), x1 = bfhi(v.x), x2 = bflo(v.y), x3 = bfhi(v.y), x4 = bflo(v.z), x5 = bfhi(v.z), x6 = bflo(v.w), x7 = bfhi(v.w);
    o[0] = w0 * prev + w1 * x0 + w2 * x1; o[1] = w0 * x0 + w1 * x1 + w2 * x2; o[2] = w0 * x1 + w1 * x2 + w2 * x3; o[3] = w0 * x2 + w1 * x3 + w2 * x4;
    o[4] = w0 * x3 + w1 * x4 + w2 * x5; o[5] = w0 * x4 + w1 * x5 + w2 * x6; o[6] = w0 * x5 + w1 * x6 + w2 * x7; o[7] = w0 * x6 + w1 * x7 + w2 * next;
}
__device__ void hyena_phase(LAS uchar* lds, const u16* __restrict__ pT  , const u16* __restrict__ G  , const float* __restrict__ conv_w  ,
                            const float* __restrict__ skip  , u16* __restrict__ yT  ) {
    const int tid = opaque_tid(), lane = tid & 63, wave = __builtin_amdgcn_readfirstlane(tid >> 6), r = lane & 31, h = lane >> 5;
    const int tbase = 256 * wave;
    for (int c = blockIdx.x; c < 512; c += gridDim.x) {
        {
            const u16* src = pT + (size_t)c * NB * SEQ; const float w0 = conv_w[c], w1 = conv_w[1536 + c], w2 = conv_w[3072 + c];
            for (int idx = tid; idx < NB * 256; idx += NTHR) { const int b = idx >> 8, s0 = (idx & 255) * 8; float o[8];
                conv3_8(src + (size_t)b * SEQ, s0, w0, w1, w2, o);
                u32x4 w; w.x = cvt_pk_bf16(o[0], o[1]); w.y = cvt_pk_bf16(o[2], o[3]); w.z = cvt_pk_bf16(o[4], o[5]); w.w = cvt_pk_bf16(o[6], o[7]);
                *(LAS u32x4*)(lds + b * HZ_ROW + s0 * 2) = w; }
            hy_load_kr(lds, G + (size_t)c * 4096);
        }
        __syncthreads();
#pragma unroll 1
        for (int o = 0; o < 2; ++o) {
            f32x16 acc[8];
#pragma unroll
            for (int i = 0; i < 8; ++i)
#pragma unroll
                for (int k = 0; k < 16; ++k) acc[i][k] = 0.f;
#pragma unroll 1
            for (int d = -tbase - 224; d <= 2032 - tbase; d += 16) {
                const int e = d + 8 * h - r + 2048; const int par = e & 1;
                const LAS unsigned* ap = (const LAS unsigned*)(lds + HZ_KR0 + par * HZ_KRC + (e - par) * 2);
                i32x4 av; av.x = (int)ap[0]; av.y = (int)ap[1]; av.z = (int)ap[2]; av.w = (int)ap[3];
                const bf16x8 a = __builtin_bit_cast(bf16x8, av);
#pragma unroll
                for (int i = 0; i < 8; ++i) { const int s0 = tbase + 32 * i + d;
                    if (s0 >= 0 && s0 <= 2032) { const bf16x8 b = *(const LAS bf16x8*)(lds + r * HZ_ROW + (s0 + 8 * h) * 2);
                        acc[i] = __builtin_amdgcn_mfma_f32_32x32x16_bf16(a, b, acc[i], 0, 0, 0); } }
            }
            { const int cc = 512 * (o + 1) + c; const float w0 = conv_w[cc], w1 = conv_w[1536 + cc], w2 = conv_w[3072 + cc]; const float sk = skip[o * 512 + c];
              const u16* p0 = pT + ((size_t)cc * NB + r) * SEQ + tbase + 4 * h;
              const LAS uchar* z0 = lds + r * HZ_ROW + (tbase + 4 * h) * 2;
              const int tl = tbase + 4 * h;
#pragma unroll
              for (int i = 0; i < 8; ++i) {
                  __builtin_amdgcn_sched_barrier(0);
#pragma unroll
                  for (int q = 0; q < 4; ++q) { const int off = 32 * i + 8 * q;
                      const u32x2 zz = *(const LAS u32x2*)(z0 + off * 2);
                      const u32x2 gv = *(const u32x2*)(p0 + off);
                      const float um = bf2f(p0[off - 1]), up = bf2f(p0[off + 4]);
                      const float gm = (tl + off > 0) ? um : 0.f, gp = (tl + off + 4 < SEQ) ? up : 0.f;
                      const float g0 = bflo(gv.x), g1 = bfhi(gv.x), g2 = bflo(gv.y), g3 = bfhi(gv.y);
                      acc[i][4 * q + 0] = (w0 * gm + w1 * g0 + w2 * g1) * (acc[i][4 * q + 0] + sk * bflo(zz.x));
                      acc[i][4 * q + 1] = (w0 * g0 + w1 * g1 + w2 * g2) * (acc[i][4 * q + 1] + sk * bfhi(zz.x));
                      acc[i][4 * q + 2] = (w0 * g1 + w1 * g2 + w2 * g3) * (acc[i][4 * q + 2] + sk * bflo(zz.y));
                      acc[i][4 * q + 3] = (w0 * g2 + w1 * g3 + w2 * gp) * (acc[i][4 * q + 3] + sk * bfhi(zz.y)); } } }
            __syncthreads();
#pragma unroll
            for (int i = 0; i < 8; ++i)
#pragma unroll
                for (int q = 0; q < 4; ++q) {
                    u32x2 w; w.x = cvt_pk_bf16(acc[i][4 * q + 0], acc[i][4 * q + 1]); w.y = cvt_pk_bf16(acc[i][4 * q + 2], acc[i][4 * q + 3]);
                    *(LAS u32x2*)(lds + r * HZ_ROW + (tbase + 4 * h) * 2 + (32 * i + 8 * q) * 2) = w; }
            if (o == 0) hy_load_kr(lds, G + (size_t)(512 + c) * 4096);
            __syncthreads();
        }
        for (int idx = tid; idx < NB * 256; idx += NTHR) { const int b = idx >> 8, s0 = (idx & 255) * 8;
            *(u32x4*)(yT + ((size_t)c * NB + b) * SEQ + s0) = *(const LAS u32x4*)(lds + b * HZ_ROW + s0 * 2); }
        __syncthreads();
    }
}

__device__ void stencil_phase(const u16* __restrict__ proj  , const float* __restrict__ dconv  , u16* __restrict__ ycat  ) {
    for (size_t idx = (size_t)blockIdx.x * NTHR + opaque_tid(); idx < (size_t)T_ * 128; idx += (size_t)gridDim.x * NTHR) {
        const int tok = (int)(idx >> 7), chunk = (int)(idx & 127); const int t = tok & (SEQ - 1);
        float o[8];
        if (chunk < 64) {
            const int ch0 = chunk * 8, g = ch0 >> 7, w = 2 << g, left = w >> 1, right = w - left - 1;
            const int lo = max(t - left, 0), hi = min(t + right, SEQ - 1);
            float s[8];
#pragma unroll
            for (int k = 0; k < 8; ++k) s[k] = 0.f;
            const u16* base = proj + (size_t)(tok - t) * 2048 + ch0;
            for (int p = lo; p <= hi; ++p) { const u32x4 v = *(const u32x4*)(base + (size_t)p * 2048);
                s[0] += bflo(v.x); s[1] += bfhi(v.x); s[2] += bflo(v.y); s[3] += bfhi(v.y); s[4] += bflo(v.z); s[5] += bfhi(v.z); s[6] += bflo(v.w); s[7] += bfhi(v.w); }
            const u32x4 cv = *(const u32x4*)(base + (size_t)t * 2048);
            const float inv = 1.0f / (float)(hi - lo + 1);
            o[0] = s[0] * inv - bflo(cv.x); o[1] = s[1] * inv - bfhi(cv.x); o[2] = s[2] * inv - bflo(cv.y); o[3] = s[3] * inv - bfhi(cv.y);
            o[4] = s[4] * inv - bflo(cv.z); o[5] = s[5] * inv - bfhi(cv.z); o[6] = s[6] * inv - bflo(cv.w); o[7] = s[7] * inv - bfhi(cv.w);
        } else {
            const int ch0 = (chunk - 64) * 8; const u16* row = proj + (size_t)tok * 2048;
            float acc[8];
#pragma unroll
            for (int k = 0; k < 8; ++k) acc[k] = 0.f;
#pragma unroll
            for (int dt = -1; dt <= 1; ++dt) { const int tt = t + dt;
                if (tt >= 0 && tt < SEQ) { const u16* rr = row + (ptrdiff_t)dt * 2048;
                    const u32x4 cv = *(const u32x4*)(rr + 1024 + ch0), hv = *(const u32x4*)(rr + 1536 + ch0);
                    const float4 wa = *(const float4*)(dconv + (dt + 1) * 512 + ch0), wb = *(const float4*)(dconv + (dt + 1) * 512 + ch0 + 4);
                    acc[0] += wa.x * bflo(cv.x) * bflo(hv.x); acc[1] += wa.y * bfhi(cv.x) * bfhi(hv.x); acc[2] += wa.z * bflo(cv.y) * bflo(hv.y); acc[3] += wa.w * bfhi(cv.y) * bfhi(hv.y);
                    acc[4] += wb.x * bflo(cv.z) * bflo(hv.z); acc[5] += wb.y * bfhi(cv.z) * bfhi(hv.z); acc[6] += wb.z * bflo(cv.w) * bflo(hv.w); acc[7] += wb.w * bfhi(cv.w) * bfhi(hv.w); } }
            const u32x4 bv = *(const u32x4*)(row + 512 + ch0);
            o[0] = bflo(bv.x) * acc[0]; o[1] = bfhi(bv.x) * acc[1]; o[2] = bflo(bv.y) * acc[2]; o[3] = bfhi(bv.y) * acc[3];
            o[4] = bflo(bv.z) * acc[4]; o[5] = bfhi(bv.z) * acc[5]; o[6] = bflo(bv.w) * acc[6]; o[7] = bfhi(bv.w) * acc[7];
        }
        u32x4 w; w.x = cvt_pk_bf16(o[0], o[1]); w.y = cvt_pk_bf16(o[2], o[3]); w.z = cvt_pk_bf16(o[4], o[5]); w.w = cvt_pk_bf16(o[6], o[7]);
        *(u32x4*)(ycat + (size_t)tok * 1024 + chunk * 8) = w;
    }
}

constexpr int NPH = 1 + 2 * 9 + 2 * 7;
struct Args { const float* in[23]; float* out; uchar* ws; int lo, hi; };

__global__ void __launch_bounds__(NTHR, 2) fwd_kernel(Args a) {
    extern __shared__ __attribute__((aligned(16))) uchar lds_raw[];
    LAS uchar* lds = (LAS uchar*)lds_raw;
    cg::grid_group grid = cg::this_grid();
    const int lo = a.lo, hi = a.hi; int ph = 0;
#define PH_BEGIN if (ph >= lo && ph < hi) {
#define PH_END } if (ph >= lo && ph + 1 < hi) grid.sync(); ++ph;
    uchar* ws = a.ws;
    u16* Wabin = (u16*)(ws + WS_ABIN); u16* Wabout = (u16*)(ws + WS_ABOUT); u16* Wcdin = (u16*)(ws + WS_CDIN); u16* Wcdout = (u16*)(ws + WS_CDOUT);
    u16* Wgu = (u16*)(ws + WS_GU); u16* Wdown = (u16*)(ws + WS_DOWN); u16* Gf = (u16*)(ws + WS_G);
    u16* H = (u16*)(ws + WS_H); u16* PROJ = (u16*)(ws + WS_B); u16* YT = (u16*)(ws + WS_B); u16* ACT = (u16*)(ws + WS_B); u16* PT = (u16*)(ws + WS_C);
    u16* YCAT = (u16*)(ws + WS_D); u16* MIX = (u16*)(ws + WS_E);
    const float* x_in = a.in[0]; const float* norm_g = a.in[1]; float* X = a.out;

    PH_BEGIN
        filter_job(lds, a.in[10], a.in[11], a.in[12], a.in[13], a.in[14], a.in[15], a.in[16], Gf);
        for (int j = 0; j < 2; ++j) {
            wt_job(lds, a.in[4] + (size_t)j * 1024 * 2560, 2560, 1024, 2560, Wabin + (size_t)j * 2560 * 1024, 1024, 0);
            wt_job(lds, a.in[5] + (size_t)j * 1024 * 1024, 1024, 1024, 1024, Wabout + (size_t)j * 1024 * 1024, 1024, 0);
            wt_job(lds, a.in[18] + (size_t)j * 1024 * 2048, 2048, 1024, 2048, Wcdin + (size_t)j * 2048 * 1024, 1024, 0);
            wt_job(lds, a.in[19] + (size_t)j * 1024 * 1024 + 512 * 1024, 1024, 512, 1024, Wcdout + (size_t)j * 1024 * 1024 + 512, 1024, 0);
            fold_job(a.in[20] + (size_t)j * 4 * 128 * 128, a.in[21] + j * 512, a.in[19] + (size_t)j * 1024 * 1024, Wcdout + (size_t)j * 1024 * 1024);
        }
        for (int i = 0; i < 4; ++i) {
            wt_job(lds, a.in[2] + (size_t)i * 1024 * 5632, 5632, 1024, 5632, Wgu + (size_t)i * 5632 * 1024, 1024, 1);
            wt_job(lds, a.in[3] + (size_t)i * 2816 * 1024, 1024, 2816, 1024, Wdown + (size_t)i * 1024 * 2816, 2816, 0);
        }
        resid_pass(x_in, nullptr, nullptr, nullptr, norm_g, H);
    PH_END

#pragma unroll 1
    for (int i = 0; i < 4; ++i) {
        const int j = i >> 1; const bool even = (i & 1) == 0;
        const float* g4 = norm_g + (size_t)i * 4 * 1024;
        PH_BEGIN
            const int N = even ? 2560 : 2048;
            pg8::Gemm g{H, even ? Wabin + (size_t)j * 2560 * 1024 : Wcdin + (size_t)j * 2048 * 1024, T_, N, 1024};
            pg8::StaticOrder S; S.init(T_, N, (int)gridDim.x, (int)blockIdx.x);
            pg8::EpiBf16G E{PROJ, N, even ? 4 : 0};

#ifndef SKIP_G1
            pg8::gemm_phase<pg8::EpiBf16G, pg8::StaticOrder, false>(lds, g, S, E, nullptr);
#endif
        PH_END
        if (even) {
            PH_BEGIN
                gating_phase(lds, PROJ, a.in[6] + j * 512, a.in[7] + (size_t)j * 4 * 128 * 128, a.in[8] + j * 512, YCAT);
                transpose_fwd_phase(lds, PROJ, PT);
            PH_END
            PH_BEGIN
#ifndef SKIP_HY
                hyena_phase(lds, PT, Gf + (size_t)j * 2 * 512 * 4096, a.in[9] + (size_t)j * 3 * 1536, a.in[17] + j * 1024, YT);
#endif
            PH_END
            PH_BEGIN
                transpose_back_phase(lds, YT, YCAT);
            PH_END
        } else {
            PH_BEGIN
                stencil_phase(PROJ, a.in[22] + (size_t)j * 3 * 512, YCAT);
            PH_END
        }
        PH_BEGIN
            pg8::Gemm g{YCAT, even ? Wabout + (size_t)j * 1024 * 1024 : Wcdout + (size_t)j * 1024 * 1024, T_, 1024, 1024};
            pg8::StaticOrder S; S.init(T_, 1024, (int)gridDim.x, (int)blockIdx.x);
            pg8::EpiBf16G E{MIX, 1024, 0};

#ifndef SKIP_G2
            pg8::gemm_phase<pg8::EpiBf16G, pg8::StaticOrder, false>(lds, g, S, E, nullptr);
#endif
        PH_END
        PH_BEGIN
            resid_pass(i == 0 ? x_in : X, MIX, g4 + 1024, X, g4 + 2048, H);
        PH_END
        PH_BEGIN
            pg8::Gemm g{H, Wgu + (size_t)i * 5632 * 1024, T_, 5632, 1024};
            pg8::StaticOrder S; S.init(T_, 5632, (int)gridDim.x, (int)blockIdx.x);
            pg8::EpiSwiGLU E{ACT, DFF};

#ifndef SKIP_G3
            pg8::gemm_phase<pg8::EpiSwiGLU, pg8::StaticOrder, false>(lds, g, S, E, nullptr);
#endif
        PH_END
        PH_BEGIN
            pg8::Gemm g{ACT, Wdown + (size_t)i * 1024 * 2816, T_, 1024, DFF};
            pg8::StaticOrder S; S.init(T_, 1024, (int)gridDim.x, (int)blockIdx.x);
            pg8::EpiBf16G E{MIX, 1024, 0};

#ifndef SKIP_G4
            pg8::gemm_phase<pg8::EpiBf16G, pg8::StaticOrder, false>(lds, g, S, E, nullptr);
#endif
        PH_END
        PH_BEGIN
            resid_pass(X, MIX, g4 + 3072, X, (i < 3) ? (g4 + 4096) : nullptr, H);
        PH_END
    }
#undef PH_BEGIN
#undef PH_END
}

extern "C" void kernel_launch(void* const* d_in, const int* in_sizes, int n_in, void* d_out, int out_size, void* d_ws, size_t ws_size, hipStream_t stream) {
    static int grid = 0;
    if (grid == 0) {
        if (n_in != 23 || out_size != T_ * DM || ws_size < WS_END) { fprintf(stderr, "kernel_launch: unexpected problem (n_in %d out %d ws %zu)\n", n_in, out_size, ws_size); grid = -1; return; }
        int dev = 0, cus = 0, per_cu = 0;
        (void)hipGetDevice(&dev); (void)hipDeviceGetAttribute(&cus, hipDeviceAttributeMultiprocessorCount, dev);
        if (hipFuncSetAttribute((const void*)fwd_kernel, hipFuncAttributeMaxDynamicSharedMemorySize, LDS_BYTES) != hipSuccess) { fprintf(stderr, "kernel_launch: hipFuncSetAttribute failed\n"); grid = -1; return; }
        if (hipOccupancyMaxActiveBlocksPerMultiprocessor(&per_cu, (const void*)fwd_kernel, NTHR, LDS_BYTES) != hipSuccess || per_cu < 1) { fprintf(stderr, "kernel_launch: occupancy query gave %d\n", per_cu); per_cu = 1; }
        (void)hipGetLastError();
        grid = cus * per_cu;
        fprintf(stderr, "kernel_launch: grid %d (cus %d x %d)\n", grid, cus, per_cu);
    }
    if (grid < 0) return;
    Args a{};
    for (int i = 0; i < 23; ++i) a.in[i] = (const float*)d_in[i];
    a.out = (float*)d_out; a.ws = (uchar*)d_ws;
#if ONE_LAUNCH
    a.lo = 0; a.hi = NPH;
    void* args[] = {&a};
    hipError_t e = hipLaunchCooperativeKernel((const void*)fwd_kernel, dim3(grid), dim3(NTHR), args, LDS_BYTES, stream);
    if (e != hipSuccess) fprintf(stderr, "kernel_launch: cooperative launch failed: %s (grid %d)\n", hipGetErrorString(e), grid);
#else
    for (int p = 0; p < NPH; ++p) { a.lo = p; a.hi = p + 1;
        hipLaunchKernelGGL(fwd_kernel, dim3(grid), dim3(NTHR), LDS_BYTES, stream, a); }
#endif
}
```

```cpp
#include <hip/hip_runtime.h>
#include <hip/hip_cooperative_groups.h>
#include <cstdio>
namespace cg = cooperative_groups;

#ifndef ONE_LAUNCH
#define ONE_LAUNCH 1
#endif
#ifndef DBL_MASK
#define DBL_MASK 0
#endif
#define DBL(bit) (((DBL_MASK >> (bit)) & 1) ? 2 : 1)

__device__ __forceinline__ int opaque_tid() { int t = (int)threadIdx.x; asm volatile("" : "+v"(t)); return t; }
namespace pg8 {
#define PG8_LAS __attribute__((address_space(3)))
typedef unsigned short bf16_t;
typedef short bf16x8 __attribute__((ext_vector_type(8)));
typedef float f32x4 __attribute__((ext_vector_type(4)));
typedef unsigned u32x4 __attribute__((ext_vector_type(4)));
constexpr int RS_LDS_OFF = 132096;
constexpr int BM = 256, BK = 64, HALF = 128, HTB = HALF * BK * 2  , STAGE_BYTES = 8 * HTB, NXCD = 8, WGM = 8;

__host__ __device__ __forceinline__ int lds_byte(int r, int c) { const int st = (r >> 4) * 2 + (c >> 5), rr = r & 15, cc = c & 31, ob = rr * 64 + cc * 2; return st * 1024 + (ob ^ (((ob >> 9) & 1) << 5)); }
__host__ __device__ __forceinline__ void stage_rc(int b, int& R, int& C) { const int st = b / 1024, sb = b % 1024, swz = sb ^ (((sb >> 9) & 1) << 5); R = (st >> 1) * 16 + swz / 64; C = (st & 1) * 32 + (swz % 64) / 2; }
__host__ __device__ __forceinline__ int perm32(int rho) { const int n = rho >> 4, i = rho & 15; return 8 * (i >> 2) + 4 * n + (i & 3); }
struct Unit { int pm, pn; };
struct Gemm { const bf16_t* A; const bf16_t* Bt; int M, N, K; };

struct StaticOrder {
    int nM, nN, nwg, G, c;
    __host__ __device__ void init(int M, int N, int G_, int c_) { nM = M / BM; nN = N / BM; nwg = nM * nN; G = G_; c = c_; }
    __host__ __device__ bool next(int i, Unit& u) const {
        const long L = (long)i * G + c; if (L >= nwg) return false;
        int wgid = (int)L; { const int q = nwg / NXCD, r = nwg % NXCD, xcd = wgid % NXCD, off = wgid / NXCD; wgid = (xcd < r ? xcd * (q + 1) : r * (q + 1) + (xcd - r) * q) + off; }
        const int nig = WGM * nN, gid = wgid / nig, fm = gid * WGM, gsz = (nM - fm) < WGM ? (nM - fm) : WGM;
        u.pm = fm + ((wgid % nig) % gsz); u.pn = (wgid % nig) / gsz; return true;
    }
    __device__ __forceinline__ void a_ready(const Unit&) const {}
    __device__ __forceinline__ void done(const Unit&) const {}
};
__device__ __forceinline__ unsigned cvt_pk_bf16(float lo, float hi) { unsigned r; asm volatile("v_cvt_pk_bf16_f32 %0, %1, %2" : "=v"(r) : "v"(lo), "v"(hi)); return r; }

__device__ __forceinline__ float gelu_tanh_f(float x) { const float y = 1.5957691216f * (x + 0.044715f * x * x * x); return x * __builtin_amdgcn_rcpf(1.0f + __expf(-y)); }
__device__ __forceinline__ float silu_f(float x) { return x * __builtin_amdgcn_rcpf(1.0f + __expf(-x)); }

struct EpiBf16G {
    static constexpr bool PERM = true, AFTER_DRAIN = false, SWAP = false;
    bf16_t* O; int ldc; int gelu_tiles; const float* rs;
    __device__ __forceinline__ void operator()(const f32x4 (&acc)[2][2][4][2], const Unit& u, int wr, int wc, int fr, int fq, const PG8_LAS float* rsl) const {
        const int row0 = u.pm * BM + wr * 64 + fr, col0 = u.pn * BM + wc * 32 + 8 * fq;
        const bool act = u.pn < gelu_tiles;
#pragma unroll
        for (int ai = 0; ai < 2; ++ai)
#pragma unroll
            for (int m = 0; m < 4; ++m) { const int row = row0 + ai * HALF + m * 16; bf16_t* rowp = O + (size_t)row * ldc + col0;
                const float sc = rs ? rsl[wr * 64 + fr + ai * HALF + m * 16] : 1.0f;
#pragma unroll
                for (int bj = 0; bj < 2; ++bj) { f32x4 v0 = acc[ai][bj][m][0] * sc, v1 = acc[ai][bj][m][1] * sc;
                    if (act) {
#pragma unroll
                        for (int j = 0; j < 4; ++j) { v0[j] = gelu_tanh_f(v0[j]); v1[j] = gelu_tanh_f(v1[j]); } }
                    u32x4 w; w.x = cvt_pk_bf16(v0[0], v0[1]); w.y = cvt_pk_bf16(v0[2], v0[3]); w.z = cvt_pk_bf16(v1[0], v1[1]); w.w = cvt_pk_bf16(v1[2], v1[3]);
                    *(u32x4*)(rowp + bj * HALF) = w; } }
    }
};
struct EpiPT {
    static constexpr bool PERM = false, AFTER_DRAIN = false, SWAP = true;
    bf16_t* O; const float* rs;
    __device__ __forceinline__ void operator()(const f32x4 (&acc)[2][2][4][2], const Unit& u, int wr, int wc, int fr, int fq, const PG8_LAS float* rsl) const {
        const int row0 = u.pm * BM + wr * 64 + 4 * fq, col0 = u.pn * BM + wc * 32 + fr;
        const int b = row0 >> 11, s0 = row0 & 2047;
        typedef unsigned u32x2_t __attribute__((ext_vector_type(2)));
#pragma unroll
        for (int ai = 0; ai < 2; ++ai)
#pragma unroll
            for (int m = 0; m < 4; ++m) { const f32x4 sc = *(const PG8_LAS f32x4*)(rsl + wr * 64 + 4 * fq + ai * HALF + m * 16);
#pragma unroll
                for (int bj = 0; bj < 2; ++bj)
#pragma unroll
                    for (int n = 0; n < 2; ++n) { bf16_t* colp = O + ((size_t)(col0 + bj * HALF + n * 16) * 32 + b) * 2048 + s0;
                        const f32x4 v = acc[ai][bj][m][n] * sc;
                        u32x2_t w; w.x = cvt_pk_bf16(v[0], v[1]); w.y = cvt_pk_bf16(v[2], v[3]);
                        *(u32x2_t*)(colp + ai * HALF + m * 16) = w; } }
    }
};
struct EpiSwiGLU {
    static constexpr bool PERM = true, AFTER_DRAIN = false, SWAP = false;
    bf16_t* O; int ldc; const float* rs;
    __device__ __forceinline__ void operator()(const f32x4 (&acc)[2][2][4][2], const Unit& u, int wr, int wc, int fr, int fq, const PG8_LAS float* rsl) const {
        const int row0 = u.pm * BM + wr * 64 + fr, col0 = u.pn * HALF + wc * 32 + 8 * fq;
#pragma unroll
        for (int ai = 0; ai < 2; ++ai)
#pragma unroll
            for (int m = 0; m < 4; ++m) { const int row = row0 + ai * HALF + m * 16; bf16_t* rowp = O + (size_t)row * ldc + col0;
                const float sc = rsl[wr * 64 + fr + ai * HALF + m * 16];
                const f32x4 g0 = acc[ai][0][m][0] * sc, g1 = acc[ai][0][m][1] * sc, u0 = acc[ai][1][m][0] * sc, u1 = acc[ai][1][m][1] * sc;
                const f32x4 a0 = g0 * (-1.4426950408889634f), a1 = g1 * (-1.4426950408889634f);
                f32x4 e0, e1;
#pragma unroll
                for (int j = 0; j < 4; ++j) { e0[j] = __builtin_amdgcn_exp2f(a0[j]); e1[j] = __builtin_amdgcn_exp2f(a1[j]); }
                const f32x4 d0 = e0 + 1.0f, d1 = e1 + 1.0f;
                f32x4 r0, r1;
#pragma unroll
                for (int j = 0; j < 4; ++j) { r0[j] = __builtin_amdgcn_rcpf(d0[j]); r1[j] = __builtin_amdgcn_rcpf(d1[j]); }
                const f32x4 v0 = (g0 * u0) * r0, v1 = (g1 * u1) * r1;
                u32x4 w; w.x = cvt_pk_bf16(v0[0], v0[1]); w.y = cvt_pk_bf16(v0[2], v0[3]); w.z = cvt_pk_bf16(v1[0], v1[1]); w.w = cvt_pk_bf16(v1[2], v1[3]);
                *(u32x4*)rowp = w; }
    }
};

template <class Epi, class Sched, bool STAMP = false>
__device__ __forceinline__ void gemm_phase(PG8_LAS unsigned char* lds, const Gemm g, const Sched& S, const Epi& E, unsigned long long* stamps) {
    const int tid = opaque_tid(), wid = __builtin_amdgcn_readfirstlane(tid >> 6), lane = tid & 63, wr = wid >> 2, wc = wid & 3, fr = lane & 15, fq = lane >> 4;
    const int K = g.K, nt = K / BK;
    int ts_lo = 0, ts_hi = 0, nts = 0; const unsigned long long rt_entry = STAMP ? (unsigned long long)wall_clock64() : 0ull;
#define PG8_STAMP() do { if (STAMP && wid == 0 && nts < 64) { const unsigned long long _c = (unsigned long long)clock64(); \
        ts_lo = (lane == nts) ? (int)(unsigned)_c : ts_lo; ts_hi = (lane == nts) ? (int)(unsigned)(_c >> 32) : ts_hi; ++nts; } } while (0)
    PG8_STAMP();
    unsigned voffA[2], voffB[2];
#pragma unroll
    for (int i = 0; i < 2; ++i) { int R, C; stage_rc(tid * 16 + i * 8192, R, C); const int Rb = Epi::PERM ? ((R & ~31) + perm32(R & 31)) : R;
        voffA[i] = (unsigned)(R * K + C) * 2u; voffB[i] = (unsigned)(Rb * K + C) * 2u; }
    const size_t kstep = (size_t)(BK * 2);
    const size_t hstep = (size_t)HALF * K * 2;
    const size_t tstep = 2 * hstep;
    const unsigned ldsw = (unsigned)wid * 1024u;
    const int aoff = lds_byte(wr * 64 + fr, fq * 8), boff = lds_byte(wc * 32 + fr, fq * 8);
#define PG8_SA(b, h) (((b) * 2 + (h)) * HTB)
#define PG8_SB(b, h) ((4 + (b) * 2 + (h)) * HTB)
#define PG8_STAGE(bufoff, gbase, voff) do { _Pragma("unroll") for (int _i = 0; _i < 2; ++_i) \
        __builtin_amdgcn_global_load_lds((const unsigned*)((const char*)(gbase) + (voff)[_i]), (PG8_LAS unsigned*)(lds + (bufoff) + ldsw + _i * 8192), 16, 0, 0); } while (0)
#define PG8_LDA(dst, b, h) do { _Pragma("unroll") for (int m = 0; m < 4; ++m) _Pragma("unroll") for (int k = 0; k < 2; ++k) dst[m][k] = *(const PG8_LAS bf16x8*)(lds + PG8_SA(b, h) + aoff + m * 2048 + k * 1024); } while (0)
#define PG8_LDB(dst, b, h) do { _Pragma("unroll") for (int n = 0; n < 2; ++n) _Pragma("unroll") for (int k = 0; k < 2; ++k) dst[n][k] = *(const PG8_LAS bf16x8*)(lds + PG8_SB(b, h) + boff + n * 2048 + k * 1024); } while (0)
#define PG8_MMA(ai, bj, At, Bt) do { __builtin_amdgcn_s_setprio(1); _Pragma("unroll") for (int m = 0; m < 4; ++m) _Pragma("unroll") for (int n = 0; n < 2; ++n) _Pragma("unroll") for (int k = 0; k < 2; ++k) \
        acc[ai][bj][m][n] = Epi::SWAP ? __builtin_amdgcn_mfma_f32_16x16x32_bf16(At[m][k], Bt[n][k], acc[ai][bj][m][n], 0, 0, 0) : __builtin_amdgcn_mfma_f32_16x16x32_bf16(Bt[n][k], At[m][k], acc[ai][bj][m][n], 0, 0, 0); __builtin_amdgcn_s_setprio(0); } while (0)
#define PG8_WAIT_V(n) asm volatile("s_waitcnt vmcnt(" #n ")" ::: "memory")
#define PG8_WAIT_L(n) asm volatile("s_waitcnt lgkmcnt(" #n ")" ::: "memory")
#define PG8_BAR __builtin_amdgcn_s_barrier()
#define PG8_SCHED __builtin_amdgcn_sched_barrier(0)
#define PG8_STAGE_RS(unit, buf) do { if (E.rs != nullptr && wid < 4) __builtin_amdgcn_global_load_lds((const unsigned*)(E.rs + (unit).pm * BM + wid * 64 + lane), (PG8_LAS unsigned*)(lds + RS_LDS_OFF + (buf) * 1024 + wid * 256), 4, 0, 0); } while (0)
    Unit cur, nxt; int ui = 0;
    if (!S.next(0, cur)) return;
    f32x4 acc[2][2][4][2];
#pragma unroll
    for (int a = 0; a < 2; ++a)
#pragma unroll
        for (int b = 0; b < 2; ++b)
#pragma unroll
            for (int m = 0; m < 4; ++m)
#pragma unroll
                for (int n = 0; n < 2; ++n) acc[a][b][m][n] = (f32x4){0.f, 0.f, 0.f, 0.f};
    bf16x8 At[4][2], B0[2][2], B1[2][2];
    const char* cA = (const char*)g.A + (size_t)cur.pm * tstep; const char* cB = (const char*)g.Bt + (size_t)cur.pn * tstep;
    S.a_ready(cur);
    PG8_STAGE_RS(cur, 0);
    PG8_STAGE(PG8_SB(0, 0), cB, voffB); PG8_STAGE(PG8_SA(0, 0), cA, voffA); PG8_STAGE(PG8_SB(0, 1), cB + hstep, voffB); PG8_STAGE(PG8_SA(0, 1), cA + hstep, voffA);
    if (wr == 1) PG8_BAR;
    PG8_WAIT_V(4); PG8_BAR;
    PG8_STAGE(PG8_SB(1, 0), cB + kstep, voffB); PG8_STAGE(PG8_SA(1, 0), cA + kstep, voffA); PG8_STAGE(PG8_SB(1, 1), cB + hstep + kstep, voffB);
    PG8_WAIT_V(6); PG8_BAR;
    PG8_STAMP();
    for (;;) {
        const bool has_next = S.next(ui + 1, nxt);
        const char* nA = has_next ? (const char*)g.A + (size_t)nxt.pm * tstep : cA; const char* nB = has_next ? (const char*)g.Bt + (size_t)nxt.pn * tstep : cB;
        for (int t = 0; t < nt; t += 2) {
            const bool last = (t == nt - 2);
            const char* a1 = cA + (size_t)(t + 1) * kstep;
            const char* a2 = last ? nA : cA + (size_t)(t + 2) * kstep; const char* b2 = last ? nB : cB + (size_t)(t + 2) * kstep;
            const char* a3 = a2 + kstep; const char* b3 = b2 + kstep;
            if (last && has_next) { S.a_ready(nxt); PG8_STAGE_RS(nxt, (ui + 1) & 1); }
            PG8_LDB(B0, 0, 0); PG8_SCHED; PG8_LDA(At, 0, 0); PG8_STAGE(PG8_SA(1, 1), a1 + hstep, voffA);
            PG8_WAIT_L(8); PG8_BAR; PG8_WAIT_L(0); PG8_MMA(0, 0, At, B0); PG8_BAR; PG8_SCHED;
            PG8_LDB(B1, 0, 1); PG8_STAGE(PG8_SB(0, 0), b2, voffB);
            PG8_BAR; PG8_WAIT_L(0); PG8_MMA(0, 1, At, B1); PG8_BAR;
            PG8_LDA(At, 0, 1); PG8_STAGE(PG8_SA(0, 0), a2, voffA);
            PG8_BAR; PG8_WAIT_L(0); PG8_MMA(1, 0, At, B0); PG8_BAR; PG8_SCHED;
            PG8_STAGE(PG8_SB(0, 1), b2 + hstep, voffB);
            PG8_WAIT_V(6); PG8_BAR; PG8_MMA(1, 1, At, B1); PG8_BAR;
            PG8_LDB(B0, 1, 0); PG8_SCHED; PG8_LDA(At, 1, 0); PG8_STAGE(PG8_SA(0, 1), a2 + hstep, voffA);
            PG8_WAIT_L(8); PG8_BAR; PG8_WAIT_L(0); PG8_MMA(0, 0, At, B0); PG8_BAR; PG8_SCHED;
            PG8_LDB(B1, 1, 1); PG8_STAGE(PG8_SB(1, 0), b3, voffB);
            PG8_BAR; PG8_WAIT_L(0); PG8_MMA(0, 1, At, B1); PG8_BAR;
            PG8_LDA(At, 1, 1); PG8_STAGE(PG8_SA(1, 0), a3, voffA);
            PG8_BAR; PG8_WAIT_L(0); PG8_MMA(1, 0, At, B0); PG8_BAR; PG8_SCHED;
            PG8_STAGE(PG8_SB(1, 1), b3 + hstep, voffB);
            PG8_WAIT_V(6); PG8_BAR; PG8_MMA(1, 1, At, B1); PG8_BAR;
        }
        PG8_STAMP();
        if constexpr (!Epi::AFTER_DRAIN) { E(acc, cur, wr, wc, fr, fq, (const PG8_LAS float*)(lds + RS_LDS_OFF + (ui & 1) * 1024)); S.done(cur); }
        PG8_STAMP();
        if (!has_next) break;
#pragma unroll
        for (int a = 0; a < 2; ++a)
#pragma unroll
            for (int b = 0; b < 2; ++b)
#pragma unroll
                for (int m = 0; m < 4; ++m)
#pragma unroll
                    for (int n = 0; n < 2; ++n) acc[a][b][m][n] = (f32x4){0.f, 0.f, 0.f, 0.f};
        cur = nxt; cA = nA; cB = nB; ++ui;
    }
    PG8_WAIT_V(0);
    if (wr == 0) PG8_BAR;
    PG8_BAR;
    if constexpr (Epi::AFTER_DRAIN) { E.fused(acc, cur, wr, wc, fr, fq, lds, wid, lane); S.done(cur); }
    PG8_STAMP();
    if (STAMP && wid == 0) { stamps[lane] = lane < nts ? (((unsigned long long)(unsigned)ts_hi << 32) | (unsigned)ts_lo) : 0ull;
        if (lane == 62) stamps[62] = rt_entry; if (lane == 63) stamps[63] = (unsigned long long)wall_clock64(); }
#undef PG8_STAMP
#undef PG8_SA
#undef PG8_SB
#undef PG8_STAGE
#undef PG8_LDA
#undef PG8_LDB
#undef PG8_MMA
#undef PG8_WAIT_V
#undef PG8_WAIT_L
#undef PG8_BAR
#undef PG8_SCHED
#undef PG8_STAGE_RS
}
}

#define LAS PG8_LAS
typedef unsigned short u16;
typedef unsigned char uchar;
using pg8::bf16x8; using pg8::f32x4; using pg8::u32x4; using pg8::cvt_pk_bf16;
typedef float f32x16 __attribute__((ext_vector_type(16)));
typedef unsigned u32x2 __attribute__((ext_vector_type(2)));
typedef int i32x4 __attribute__((ext_vector_type(4)));

constexpr int T_ = 65536, DM = 1024, SEQ = 2048, NB = 32, DFF = 2816, NTHR = 512;
constexpr int LDS_ST_OFF = 151552;
constexpr int LDS_BYTES = LDS_ST_OFF + 16;
constexpr size_t SZ_ABIN = 2ull * 2560 * 1024 * 2, SZ_ABOUT = 2ull * 1024 * 1024 * 2, SZ_CDIN = 2ull * 2048 * 1024 * 2, SZ_CDOUT = 2ull * 1024 * 1024 * 2,
                 SZ_GU = 4ull * 5632 * 1024 * 2, SZ_DOWN = 4ull * 1024 * 2816 * 2, SZ_G = 2ull * 2 * 512 * 4096 * 2;
constexpr size_t WS_ABIN = 0, WS_ABOUT = WS_ABIN + SZ_ABIN, WS_CDIN = WS_ABOUT + SZ_ABOUT, WS_CDOUT = WS_CDIN + SZ_CDIN, WS_GU = WS_CDOUT + SZ_CDOUT, WS_DOWN = WS_GU + SZ_GU,
                 WS_G = WS_DOWN + SZ_DOWN,
                 WS_H = WS_G + SZ_G,
                 WS_B = WS_H + (size_t)T_ * 1024 * 2,
                 WS_C = WS_B + (size_t)T_ * 2560 * 2,
                 WS_D = WS_C + (size_t)1536 * 32 * 2048 * 2,
                 WS_E = WS_D + (size_t)T_ * 1024 * 2,
                 WS_BAR = WS_E + (size_t)T_ * 1024 * 2,
                 WS_RSTD = WS_BAR + 16384,
                 WS_END = WS_RSTD + (size_t)T_ * 4;
static_assert(WS_END <= (1ull << 30), "workspace map exceeds 1 GiB");
static_assert((size_t)T_ * DFF * 2 <= WS_D - WS_B, "act does not fit B + C");

__device__ __forceinline__ float bflo(unsigned w) { return __uint_as_float(w << 16); }
__device__ __forceinline__ float bfhi(unsigned w) { return __uint_as_float(w & 0xffff0000u); }
__device__ __forceinline__ float bf2f(u16 v) { return __uint_as_float(((unsigned)v) << 16); }
__device__ __forceinline__ u16 f2bf(float f) { return (u16)(cvt_pk_bf16(f, 0.f) & 0xffffu); }
__device__ __forceinline__ float wave_sum(float v) {
#pragma unroll
    for (int o = 32; o >= 1; o >>= 1) v += __shfl_xor(v, o, 64);
    return v;
}

__device__ void wt_job(LAS uchar* lds, const float* __restrict__ W, int ldw, int K, int N, u16* __restrict__ out, int ldo, int mode, const float* __restrict__ gain) {
    LAS float* tile = (LAS float*)lds;
    const int tid = opaque_tid(); const int nkq = K / 256, nnt = N / 64, nsteps = nkq * nnt;
    for (int ti = blockIdx.x; ti < nsteps; ti += gridDim.x) {
        const int kq = ti % nkq, nt = ti / nkq; const int k0 = kq * 256, n0 = nt * 64;
        int sc0 = n0; if (mode == 1) { const int pn = n0 >> 8, r = n0 & 255; sc0 = (r < 128) ? (pn * 128 + r) : (DFF + pn * 128 + (r - 128)); }
        float4 v[8];
#pragma unroll
        for (int i = 0; i < 8; ++i) { const int idx = tid + i * 512; const int kk = idx >> 4, c4 = (idx & 15) * 4;
            v[i] = *(const float4*)(W + (size_t)(k0 + kk) * ldw + sc0 + c4); }
#pragma unroll
        for (int i = 0; i < 8; ++i) { const int idx = tid + i * 512; const int kk = idx >> 4, c4 = (idx & 15) * 4;
            const float gk = gain ? gain[k0 + kk] : 1.0f;
            tile[kk * 65 + c4 + 0] = v[i].x * gk; tile[kk * 65 + c4 + 1] = v[i].y * gk; tile[kk * 65 + c4 + 2] = v[i].z * gk; tile[kk * 65 + c4 + 3] = v[i].w * gk; }
        __syncthreads();
#pragma unroll
        for (int q = 0; q < 4; ++q) { const int nn = tid >> 3, kc = q * 64 + (tid & 7) * 8;
          float f0 = tile[(kc + 0) * 65 + nn], f1 = tile[(kc + 1) * 65 + nn], f2 = tile[(kc + 2) * 65 + nn], f3 = tile[(kc + 3) * 65 + nn];
          float f4 = tile[(kc + 4) * 65 + nn], f5 = tile[(kc + 5) * 65 + nn], f6 = tile[(kc + 6) * 65 + nn], f7 = tile[(kc + 7) * 65 + nn];
          u32x4 w; w.x = cvt_pk_bf16(f0, f1); w.y = cvt_pk_bf16(f2, f3); w.z = cvt_pk_bf16(f4, f5); w.w = cvt_pk_bf16(f6, f7);
          *(u32x4*)(out + (size_t)(n0 + nn) * ldo + k0 + kc) = w; }
        __syncthreads();
    }
}
__device__ void fold_job(const float* __restrict__ cw, const float* __restrict__ scale, const float* __restrict__ Wout, u16* __restrict__ out) {
    for (int idx = blockIdx.x * NTHR + opaque_tid(); idx < 512 * 128; idx += gridDim.x * NTHR) {
        const int k = idx >> 7, n0 = (idx & 127) * 8; const int g = k >> 7;
        const float* cwr = cw + (size_t)k * 128; const float* sc = scale + g * 128; const float* wr = Wout + (size_t)(g * 128) * 1024 + n0;
        float acc[8];
#pragma unroll
        for (int u = 0; u < 8; ++u) acc[u] = 0.f;
#pragma unroll 8
        for (int c2 = 0; c2 < 128; ++c2) { const float cf = cwr[c2] * sc[c2]; const float4 w0 = *(const float4*)(wr + (size_t)c2 * 1024), w1 = *(const float4*)(wr + (size_t)c2 * 1024 + 4);
            acc[0] += cf * w0.x; acc[1] += cf * w0.y; acc[2] += cf * w0.z; acc[3] += cf * w0.w; acc[4] += cf * w1.x; acc[5] += cf * w1.y; acc[6] += cf * w1.z; acc[7] += cf * w1.w; }
#pragma unroll
        for (int u = 0; u < 8; ++u) out[(size_t)(n0 + u) * 1024 + k] = f2bf(acc[u]);
    }
}
__device__ void filter_job(LAS uchar* lds, const float* __restrict__ w1a, const float* __restrict__ b1a, const float* __restrict__ freqa, const float* __restrict__ w2a,
                           const float* __restrict__ b2a, const float* __restrict__ w3a, const float* __restrict__ decaya, u16* __restrict__ Gall) {
    LAS float* h2 = (LAS float*)lds;
    LAS float* zf = h2 + 64 * 64;
    LAS float* h1 = zf + 64 * 33;
    LAS float* w3s = h2 + 64 * 64;
    const int tid = opaque_tid(), lane = tid & 63, wave = __builtin_amdgcn_readfirstlane(tid >> 6);
    for (int item = blockIdx.x; item < 256; item += gridDim.x) {
        const int j = item >> 7, tg = (item >> 2) & 31, cq = item & 3, t0 = tg * 64;
        const float* w1 = w1a + j * 33 * 64; const float* b1 = b1a + j * 64; const float* freq = freqa + j * 128; const float* w2 = w2a + j * 4096; const float* b2 = b2a + j * 64;
        const float* w3 = w3a + (size_t)j * 64 * 2048; const float* decay = decaya + j * 2048; u16* Gj = Gall + (size_t)j * 2 * 512 * 4096;
        float4 wpre[16];
#pragma unroll
        for (int i = 0; i < 16; ++i) { const int idx = tid + i * NTHR; wpre[i] = *(const float4*)(w3 + (size_t)(idx >> 7) * 2048 + cq * 512 + (idx & 127) * 4); }
        for (int idx = tid; idx < 64 * 33; idx += NTHR) { const int tt = idx / 33, f = idx - tt * 33; const float t = (float)(t0 + tt);
            float val;
            if (f == 0) val = t / 2047.0f;
            else { const int fi = (f - 1) & 15; const float band = 1e-4f + (float)fi * ((15.0f - 1e-4f) / 15.0f); const float w = 6.283185307179586f * t / 2048.0f; const float fw = w * band;
                   val = (f <= 16) ? cosf(fw) : -sinf(fw); }
            zf[idx] = val; }
        __syncthreads();
        for (int idx = tid; idx < 4096; idx += NTHR) { const int tt = idx >> 6, k = idx & 63; float acc = 0.f;
            for (int f = 0; f < 33; ++f) acc += zf[tt * 33 + f] * w1[f * 64 + k];
            h1[tt * 64 + k] = sinf(freq[k] * (acc + b1[k])); }
        __syncthreads();
        for (int idx = tid; idx < 4096; idx += NTHR) { const int tt = idx >> 6, k = idx & 63; float acc = 0.f;
            for (int k2 = 0; k2 < 64; ++k2) acc += h1[tt * 64 + k2] * w2[k2 * 64 + k];
            h2[k * 64 + tt] = sinf(freq[64 + k] * (acc + b2[k])); }
        __syncthreads();
#pragma unroll
        for (int i = 0; i < 16; ++i) { const int idx = tid + i * NTHR; f32x4 wv; wv.x = wpre[i].x; wv.y = wpre[i].y; wv.z = wpre[i].z; wv.w = wpre[i].w; *(LAS f32x4*)(w3s + (idx >> 7) * 512 + (idx & 127) * 4) = wv; }
        __syncthreads();
        { const int t = t0 + lane; const float t01 = (float)t / 2047.0f;
          for (int ci = 0; ci < 64; ci += 4) { const int cl = wave * 64 + ci, col = cq * 512 + cl; float a0 = 0.f, a1 = 0.f, a2 = 0.f, a3 = 0.f;
#pragma unroll 16
              for (int k = 0; k < 64; ++k) { const f32x4 w = *(const LAS f32x4*)(w3s + k * 512 + cl); const float hv = h2[k * 64 + lane]; a0 += hv * w.x; a1 += hv * w.y; a2 += hv * w.z; a3 += hv * w.w; }
              const float4 dc = *(const float4*)(decay + col);
              a0 *= expf(-t01 * fabsf(dc.x)); a1 *= expf(-t01 * fabsf(dc.y)); a2 *= expf(-t01 * fabsf(dc.z)); a3 *= expf(-t01 * fabsf(dc.w));
              const int dir = col >> 10, o = (col >> 9) & 1, c = col & 511; u16* g = Gj + (size_t)(o * 512 + c) * 4096;
              if (dir == 0) { g[2048 - t] = f2bf(a0); g[4096 + 2048 - t] = f2bf(a1); g[8192 + 2048 - t] = f2bf(a2); g[12288 + 2048 - t] = f2bf(a3);
                              if (t == 0) { g[0] = 0; g[4096] = 0; g[8192] = 0; g[12288] = 0; } }
              else if (t <= 2046) { g[2049 + t] = f2bf(a0); g[4096 + 2049 + t] = f2bf(a1); g[8192 + 2049 + t] = f2bf(a2); g[12288 + 2049 + t] = f2bf(a3); } } }
        __syncthreads();
    }
}

__device__ __forceinline__ void unpack8(const u32x4 v, float (&f)[8]) { f[0] = bflo(v.x); f[1] = bfhi(v.x); f[2] = bflo(v.y); f[3] = bfhi(v.y); f[4] = bflo(v.z); f[5] = bfhi(v.z); f[6] = bflo(v.w); f[7] = bfhi(v.w); }
__device__ __forceinline__ float4 ntload4(const float* p) { const f32x4 v = __builtin_nontemporal_load((const f32x4*)p); float4 r; r.x = v.x; r.y = v.y; r.z = v.z; r.w = v.w; return r; }
__device__ __forceinline__ void ntstore4(float* p, float a, float b, float c, float d) { f32x4 w; w.x = a; w.y = b; w.z = c; w.w = d; __builtin_nontemporal_store(w, (f32x4*)p); }
__device__ void resid_pass(const float* __restrict__ xin_f, u16* __restrict__ xb, const u16* __restrict__ mix, const float* __restrict__ gpost, float* __restrict__ rstd_out, float* __restrict__ out_f) {
    const int tid = opaque_tid(); const int lane = tid & 63, wave = tid >> 6;
    const int stride = gridDim.x * 8;
    constexpr int NR = 4;
    for (int row0 = blockIdx.x * 8 + wave; row0 < T_; row0 += NR * stride) {
        float x[NR][16];
        if (xin_f) {
#pragma unroll
            for (int k = 0; k < NR; ++k) { const int row = min(row0 + k * stride, T_ - 1);
#pragma unroll
                for (int c = 0; c < 2; ++c) { const float4 a0 = ntload4(xin_f + (size_t)row * 1024 + c * 512 + lane * 8), a1 = ntload4(xin_f + (size_t)row * 1024 + c * 512 + lane * 8 + 4);
                    x[k][c * 8 + 0] = a0.x; x[k][c * 8 + 1] = a0.y; x[k][c * 8 + 2] = a0.z; x[k][c * 8 + 3] = a0.w; x[k][c * 8 + 4] = a1.x; x[k][c * 8 + 5] = a1.y; x[k][c * 8 + 6] = a1.z; x[k][c * 8 + 7] = a1.w; } }
        } else {
            u32x4 xr[NR][2], mr[NR][2];
#pragma unroll
            for (int k = 0; k < NR; ++k) { const int row = min(row0 + k * stride, T_ - 1);
#pragma unroll
                for (int c = 0; c < 2; ++c) { xr[k][c] = *(const u32x4*)(xb + (size_t)row * 1024 + c * 512 + lane * 8); mr[k][c] = __builtin_nontemporal_load((const u32x4*)(mix + (size_t)row * 1024 + c * 512 + lane * 8)); } }
            float g[16];
#pragma unroll
            for (int c = 0; c < 2; ++c) { const float4 a0 = *(const float4*)(gpost + c * 512 + lane * 8), a1 = *(const float4*)(gpost + c * 512 + lane * 8 + 4);
                g[c * 8 + 0] = a0.x; g[c * 8 + 1] = a0.y; g[c * 8 + 2] = a0.z; g[c * 8 + 3] = a0.w; g[c * 8 + 4] = a1.x; g[c * 8 + 5] = a1.y; g[c * 8 + 6] = a1.z; g[c * 8 + 7] = a1.w; }
#pragma unroll
            for (int k = 0; k < NR; ++k) { float m[16]; float ss = 0.f;
#pragma unroll
                for (int c = 0; c < 2; ++c) { float t8[8]; unpack8(mr[k][c], t8);
#pragma unroll
                    for (int e = 0; e < 8; ++e) { m[c * 8 + e] = t8[e]; ss += t8[e] * t8[e]; } }
                ss = wave_sum(ss); const float rstd = rsqrtf(ss * (1.0f / 1024.0f) + 1e-6f);
#pragma unroll
                for (int c = 0; c < 2; ++c) { float t8[8]; unpack8(xr[k][c], t8);
#pragma unroll
                    for (int e = 0; e < 8; ++e) x[k][c * 8 + e] = t8[e] + m[c * 8 + e] * rstd * g[c * 8 + e]; } }
        }
#pragma unroll
        for (int k = 0; k < NR; ++k) { const int row = row0 + k * stride;
            if (row < T_) {
                if (out_f) {
#pragma unroll
                    for (int c = 0; c < 2; ++c) { ntstore4(out_f + (size_t)row * 1024 + c * 512 + lane * 8, x[k][c * 8 + 0], x[k][c * 8 + 1], x[k][c * 8 + 2], x[k][c * 8 + 3]);
                        ntstore4(out_f + (size_t)row * 1024 + c * 512 + lane * 8 + 4, x[k][c * 8 + 4], x[k][c * 8 + 5], x[k][c * 8 + 6], x[k][c * 8 + 7]); }
                } else {
                    float ss = 0.f;
#pragma unroll
                    for (int e = 0; e < 16; ++e) ss += x[k][e] * x[k][e];
                    ss = wave_sum(ss);
                    if (lane == 0) rstd_out[row] = rsqrtf(ss * (1.0f / 1024.0f) + 1e-6f);
#pragma unroll
                    for (int c = 0; c < 2; ++c) { u32x4 w; w.x = cvt_pk_bf16(x[k][c * 8 + 0], x[k][c * 8 + 1]); w.y = cvt_pk_bf16(x[k][c * 8 + 2], x[k][c * 8 + 3]); w.z = cvt_pk_bf16(x[k][c * 8 + 4], x[k][c * 8 + 5]); w.w = cvt_pk_bf16(x[k][c * 8 + 6], x[k][c * 8 + 7]);
                        *(u32x4*)(xb + (size_t)row * 1024 + c * 512 + lane * 8) = w; }
                }
            }
        }
    }
}

constexpr int TRS = 66;
__device__ __forceinline__ void tr_tile8(LAS u16* tiles  , const u16* __restrict__ src, size_t lds_src, size_t src_ts, u16* __restrict__ dst, size_t ldd, size_t dst_ts) {
    const int tid = opaque_tid(), r = tid >> 3, ch = (tid & 7) * 8;
    u32x4 v[8];
#pragma unroll
    for (int k = 0; k < 8; ++k) v[k] = *(const u32x4*)(src + k * src_ts + (size_t)r * lds_src + ch);
#pragma unroll
    for (int k = 0; k < 8; ++k) { LAS u16* tile = tiles + k * 64 * TRS;
        tile[(ch + 0) * TRS + r] = (u16)(v[k].x & 0xffffu); tile[(ch + 1) * TRS + r] = (u16)(v[k].x >> 16);
        tile[(ch + 2) * TRS + r] = (u16)(v[k].y & 0xffffu); tile[(ch + 3) * TRS + r] = (u16)(v[k].y >> 16);
        tile[(ch + 4) * TRS + r] = (u16)(v[k].z & 0xffffu); tile[(ch + 5) * TRS + r] = (u16)(v[k].z >> 16);
        tile[(ch + 6) * TRS + r] = (u16)(v[k].w & 0xffffu); tile[(ch + 7) * TRS + r] = (u16)(v[k].w >> 16); }
    __syncthreads();
#pragma unroll
    for (int k = 0; k < 8; ++k) { const LAS unsigned* p = (const LAS unsigned*)(tiles + k * 64 * TRS + r * TRS + ch);
        u32x4 o; o.x = p[0]; o.y = p[1]; o.z = p[2]; o.w = p[3];
        *(u32x4*)(dst + k * dst_ts + (size_t)r * ldd + ch) = o; }
    __syncthreads();
}
__device__ void transpose_fwd_phase(LAS uchar* lds, const u16* __restrict__ proj, u16* __restrict__ pT) {
    LAS u16* tiles = (LAS u16*)lds;
    for (int it = blockIdx.x; it < NB * 32 * 3; it += gridDim.x) {
        const int c8 = it % 3, st = (it / 3) & 31, b = it / 96;
        tr_tile8(tiles, proj + (size_t)(b * SEQ + st * 64) * 2560 + 1024 + c8 * 512, 2560, 64, pT + ((size_t)(c8 * 512) * NB + b) * SEQ + st * 64, (size_t)NB * SEQ, (size_t)64 * NB * SEQ);
    }
}
__device__ void transpose_back_phase(LAS uchar* lds, const u16* __restrict__ yT, u16* __restrict__ ycat) {
    LAS u16* tiles = (LAS u16*)lds;
    for (int it = blockIdx.x; it < NB * 32; it += gridDim.x) {
        const int st = it & 31, b = it >> 5;
        tr_tile8(tiles, yT + (size_t)b * SEQ + st * 64, (size_t)NB * SEQ, (size_t)64 * NB * SEQ, ycat + (size_t)(b * SEQ + st * 64) * 1024 + 512, 1024, 64);
    }
}
__device__ void gating_phase(LAS uchar* lds, const u16* __restrict__ proj  , const float* __restrict__ ln_g  ,
                             const float* __restrict__ w_s  , const float* __restrict__ b_s  , u16* __restrict__ ycat  ) {
    LAS u16* vT = (LAS u16*)lds;
    LAS u16* wsb = vT + 128 * 136;
    LAS float* stats = (LAS float*)(wsb + 128 * 136);
    const int tid = opaque_tid(), lane = tid & 63, wave = tid >> 6, fr = lane & 15, fq = lane >> 4;
    for (int item = blockIdx.x; item < T_ / 128; item += gridDim.x) {
        const int tok0 = item * 128;
        { u32x4 vv[16];
#pragma unroll
          for (int tt = 0; tt < 16; ++tt) vv[tt] = *(const u32x4*)(proj + (size_t)(tok0 + wave * 16 + tt) * 1024 + 512 + lane * 8);
#pragma unroll
          for (int tt = 0; tt < 16; ++tt) { const int q = wave * 16 + tt; const u32x4 v = vv[tt];
            const float f0 = bflo(v.x), f1 = bfhi(v.x), f2 = bflo(v.y), f3 = bfhi(v.y), f4 = bflo(v.z), f5 = bfhi(v.z), f6 = bflo(v.w), f7 = bfhi(v.w);
            const float mean = wave_sum(f0 + f1 + f2 + f3 + f4 + f5 + f6 + f7) * (1.0f / 512.0f);
            const float d0 = f0 - mean, d1 = f1 - mean, d2 = f2 - mean, d3 = f3 - mean, d4 = f4 - mean, d5 = f5 - mean, d6 = f6 - mean, d7 = f7 - mean;
            const float var = wave_sum(d0 * d0 + d1 * d1 + d2 * d2 + d3 * d3 + d4 * d4 + d5 * d5 + d6 * d6 + d7 * d7) * (1.0f / 512.0f);
            if (lane == 0) { stats[q * 2] = mean; stats[q * 2 + 1] = rsqrtf(var + 1e-5f); } } }
        __syncthreads();
        u32x4 vreg[4]; float4 wreg[8];
#define GATE_LOAD(g) do { _Pragma("unroll") for (int i = 0; i < 4; ++i) { const int idx = tid + i * NTHR; vreg[i] = *(const u32x4*)(proj + (size_t)(tok0 + (idx >> 4)) * 1024 + 512 + (g) * 128 + (idx & 15) * 8); } \
                          _Pragma("unroll") for (int i = 0; i < 8; ++i) { const int idx = tid + i * NTHR; wreg[i] = *(const float4*)(w_s + (size_t)((g) * 128 + (idx >> 5)) * 128 + (idx & 31) * 4); } } while (0)
        GATE_LOAD(0);
#pragma unroll
        for (int g = 0; g < 4; ++g) {
#pragma unroll
            for (int i = 0; i < 4; ++i) { const int idx = tid + i * NTHR; const int q = idx >> 4, c0 = (idx & 15) * 8;
                const u32x4 v = vreg[i];
                const float mean = stats[q * 2], rstd = stats[q * 2 + 1];
                const float4 g0 = *(const float4*)(ln_g + g * 128 + c0), g1 = *(const float4*)(ln_g + g * 128 + c0 + 4);
                vT[(c0 + 0) * 136 + q] = f2bf((bflo(v.x) - mean) * rstd * g0.x); vT[(c0 + 1) * 136 + q] = f2bf((bfhi(v.x) - mean) * rstd * g0.y);
                vT[(c0 + 2) * 136 + q] = f2bf((bflo(v.y) - mean) * rstd * g0.z); vT[(c0 + 3) * 136 + q] = f2bf((bfhi(v.y) - mean) * rstd * g0.w);
                vT[(c0 + 4) * 136 + q] = f2bf((bflo(v.z) - mean) * rstd * g1.x); vT[(c0 + 5) * 136 + q] = f2bf((bfhi(v.z) - mean) * rstd * g1.y);
                vT[(c0 + 6) * 136 + q] = f2bf((bflo(v.w) - mean) * rstd * g1.z); vT[(c0 + 7) * 136 + q] = f2bf((bfhi(v.w) - mean) * rstd * g1.w); }
#pragma unroll
            for (int i = 0; i < 8; ++i) { const int idx = tid + i * NTHR; const int p = idx >> 5, q0 = (idx & 31) * 4;
                const float4 w = wreg[i];
                u32x2 o; o.x = cvt_pk_bf16(w.x, w.y); o.y = cvt_pk_bf16(w.z, w.w);
                *(LAS u32x2*)(wsb + p * 136 + q0) = o; }
            __syncthreads();
            if (g < 3) GATE_LOAD(g + 1);
            const int p = 16 * wave + fr; const size_t tok = (size_t)(tok0 + p); const float bias = b_s[g * 128 + p];
            u32x2 uu[8];
#pragma unroll
            for (int mi = 0; mi < 8; ++mi) uu[mi] = *(const u32x2*)(proj + tok * 1024 + g * 128 + 16 * mi + 4 * fq);
            f32x4 acc[8];
#pragma unroll
            for (int mi = 0; mi < 8; ++mi) acc[mi] = (f32x4){0.f, 0.f, 0.f, 0.f};
#pragma unroll
            for (int kk = 0; kk < 4; ++kk) {
                const bf16x8 bfrag = *(const LAS bf16x8*)(wsb + (16 * wave + fr) * 136 + 32 * kk + 8 * fq);
#pragma unroll
                for (int mi = 0; mi < 8; ++mi) { const bf16x8 afrag = *(const LAS bf16x8*)(vT + (16 * mi + fr) * 136 + 32 * kk + 8 * fq);
                    acc[mi] = __builtin_amdgcn_mfma_f32_16x16x32_bf16(afrag, bfrag, acc[mi], 0, 0, 0); }
            }
#pragma unroll
            for (int mi = 0; mi < 8; ++mi) { const int c = 16 * mi + 4 * fq;
                u32x2 o; o.x = cvt_pk_bf16(bflo(uu[mi].x) * (acc[mi][0] + bias), bfhi(uu[mi].x) * (acc[mi][1] + bias)); o.y = cvt_pk_bf16(bflo(uu[mi].y) * (acc[mi][2] + bias), bfhi(uu[mi].y) * (acc[mi][3] + bias));
                *(u32x2*)(ycat + tok * 1024 + g * 128 + c) = o; }
            __syncthreads();
        }
#undef GATE_LOAD
    }
}

constexpr int HZ_ROW = 4112;
constexpr int HZ_KR0 = NB * HZ_ROW;
constexpr int HZ_KRC = 8208;
static_assert(HZ_KR0 + 2 * HZ_KRC <= LDS_ST_OFF, "hyena LDS");

__device__ __forceinline__ void hy_load_kr(LAS uchar* lds, const u16* __restrict__ g) {
    const int tid = opaque_tid();
    const u32x4 w = *(const u32x4*)(g + tid * 8);
    const unsigned nxt = (tid < 511) ? (unsigned)g[tid * 8 + 8] : 0u;
    *(LAS u32x4*)(lds + HZ_KR0 + tid * 16) = w;
    u32x4 s; s.x = (w.x >> 16) | (w.y << 16); s.y = (w.y >> 16) | (w.z << 16); s.z = (w.z >> 16) | (w.w << 16); s.w = (w.w >> 16) | (nxt << 16);
    *(LAS u32x4*)(lds + HZ_KR0 + HZ_KRC + tid * 16) = s;
}
__device__ __forceinline__ void conv3_8(const u16* __restrict__ p, int s0, float w0, float w1, float w2, float (&o)[8]) {
    const u32x4 v = *(const u32x4*)(p + s0);
    const float prev = (s0 > 0) ? bf2f(p[s0 - 1]) : 0.f, next = (s0 + 8 < SEQ) ? bf2f(p[s0 + 8]) : 0.f;
    const float x0 = bflo(v.x), x1 = bfhi(v.x), x2 = bflo(v.y), x3 = bfhi(v.y), x4 = bflo(v.z), x5 = bfhi(v.z), x6 = bflo(v.w), x7 = bfhi(v.w);
    o[0] = w0 * prev + w1 * x0 + w2 * x1; o[1] = w0 * x0 + w1 * x1 + w2 * x2; o[2] = w0 * x1 + w1 * x2 + w2 * x3; o[3] = w0 * x2 + w1 * x3 + w2 * x4;
    o[4] = w0 * x3 + w1 * x4 + w2 * x5; o[5] = w0 * x4 + w1 * x5 + w2 * x6; o[6] = w0 * x5 + w1 * x6 + w2 * x7; o[7] = w0 * x6 + w1 * x7 + w2 * next;
}
__device__ void hyena_phase(LAS uchar* lds, const u16* __restrict__ pT  , const u16* __restrict__ G  , const float* __restrict__ conv_w  ,
                            const float* __restrict__ skip  , u16* __restrict__ yT  ) {
    const int tid = opaque_tid(), lane = tid & 63, wave = __builtin_amdgcn_readfirstlane(tid >> 6), r = lane & 31, h = lane >> 5;
    const int tbase = 256 * wave;
    const int e0 = 8 * h - r + 2048 - tbase, par = e0 & 1;
    const LAS uchar* abase = lds + HZ_KR0 + par * HZ_KRC + (e0 - par) * 2;
    const LAS uchar* bbase = lds + r * HZ_ROW + 16 * h;
    for (int c = blockIdx.x; c < 512; c += gridDim.x) {
        {
            const u16* src = pT + (size_t)c * NB * SEQ; const float w0 = conv_w[c], w1 = conv_w[1536 + c], w2 = conv_w[3072 + c];
#pragma unroll 4
            for (int it = 0; it < 16; ++it) { const int idx = tid + it * NTHR; const int b = idx >> 8, s0 = (idx & 255) * 8; float o[8];
                conv3_8(src + (size_t)b * SEQ, s0, w0, w1, w2, o);
                u32x4 w; w.x = cvt_pk_bf16(o[0], o[1]); w.y = cvt_pk_bf16(o[2], o[3]); w.z = cvt_pk_bf16(o[4], o[5]); w.w = cvt_pk_bf16(o[6], o[7]);
                *(LAS u32x4*)(lds + b * HZ_ROW + s0 * 2) = w; }
            hy_load_kr(lds, G + (size_t)c * 4096);
        }
        __syncthreads();
#pragma unroll 1
        for (int o = 0; o < 2; ++o) {
            f32x16 acc[8];
#pragma unroll
            for (int i = 0; i < 8; ++i)
#pragma unroll
                for (int k = 0; k < 16; ++k) acc[i][k] = 0.f;
#pragma unroll 1
            for (int p = 0; p < 2; ++p) {
                bf16x8 W[8];
#pragma unroll
                for (int k = 1; k < 8; ++k) { const LAS unsigned* ap = (const LAS unsigned*)(abase + (16 * p - 32 * k) * 2);
                    i32x4 av; av.x = (int)ap[0]; av.y = (int)ap[1]; av.z = (int)ap[2]; av.w = (int)ap[3]; W[8 - k] = __builtin_bit_cast(bf16x8, av); }
#pragma unroll 1
                for (int J = 0; J < 8; ++J) {
                    const LAS uchar* aj = abase + (16 * p + 256 * J) * 2;
                    const LAS uchar* bj = bbase + (16 * p + 256 * J) * 2;
#pragma unroll
                    for (int jj = 0; jj < 8; ++jj) {
                        const LAS unsigned* ap = (const LAS unsigned*)(aj + 64 * jj);
                        i32x4 av; av.x = (int)ap[0]; av.y = (int)ap[1]; av.z = (int)ap[2]; av.w = (int)ap[3]; W[jj] = __builtin_bit_cast(bf16x8, av);
                        const bf16x8 bb = *(const LAS bf16x8*)(bj + 64 * jj);
#pragma unroll
                        for (int i = 0; i < 8; ++i) acc[i] = __builtin_amdgcn_mfma_f32_32x32x16_bf16(W[(jj - i) & 7], bb, acc[i], 0, 0, 0);
                    }
                }
            }
            { const int cc = 512 * (o + 1) + c; const float w0 = conv_w[cc], w1 = conv_w[1536 + cc], w2 = conv_w[3072 + cc]; const float sk = skip[o * 512 + c];
              const u16* p0 = pT + ((size_t)cc * NB + r) * SEQ + tbase + 4 * h;
              const LAS uchar* z0 = lds + r * HZ_ROW + (tbase + 4 * h) * 2;
              const int tl = tbase + 4 * h;
#pragma unroll
              for (int i = 0; i < 8; ++i) {
                  if ((i & 3) == 0) __builtin_amdgcn_sched_barrier(0);
#pragma unroll
                  for (int q = 0; q < 4; ++q) { const int off = 32 * i + 8 * q;
                      const u32x2 zz = *(const LAS u32x2*)(z0 + off * 2);
                      const u32x2 gv = *(const u32x2*)(p0 + off);
                      const float um = bf2f(p0[off - 1]), up = bf2f(p0[off + 4]);
                      const float gm = (tl + off > 0) ? um : 0.f, gp = (tl + off + 4 < SEQ) ? up : 0.f;
                      const float g0 = bflo(gv.x), g1 = bfhi(gv.x), g2 = bflo(gv.y), g3 = bfhi(gv.y);
                      acc[i][4 * q + 0] = (w0 * gm + w1 * g0 + w2 * g1) * (acc[i][4 * q + 0] + sk * bflo(zz.x));
                      acc[i][4 * q + 1] = (w0 * g0 + w1 * g1 + w2 * g2) * (acc[i][4 * q + 1] + sk * bfhi(zz.x));
                      acc[i][4 * q + 2] = (w0 * g1 + w1 * g2 + w2 * g3) * (acc[i][4 * q + 2] + sk * bflo(zz.y));
                      acc[i][4 * q + 3] = (w0 * g2 + w1 * g3 + w2 * gp) * (acc[i][4 * q + 3] + sk * bfhi(zz.y)); } } }
            __syncthreads();
#pragma unroll
            for (int i = 0; i < 8; ++i)
#pragma unroll
                for (int q = 0; q < 4; ++q) {
                    u32x2 w; w.x = cvt_pk_bf16(acc[i][4 * q + 0], acc[i][4 * q + 1]); w.y = cvt_pk_bf16(acc[i][4 * q + 2], acc[i][4 * q + 3]);
                    *(LAS u32x2*)(lds + r * HZ_ROW + (tbase + 4 * h) * 2 + (32 * i + 8 * q) * 2) = w; }
            if (o == 0) hy_load_kr(lds, G + (size_t)(512 + c) * 4096);
            __syncthreads();
        }
        for (int idx = tid; idx < NB * 256; idx += NTHR) { const int b = idx >> 8, s0 = (idx & 255) * 8;
            *(u32x4*)(yT + ((size_t)c * NB + b) * SEQ + s0) = *(const LAS u32x4*)(lds + b * HZ_ROW + s0 * 2); }
        __syncthreads();
    }
}

__device__ __forceinline__ u32x4 pack8(const float (&o)[8]) { u32x4 w; w.x = cvt_pk_bf16(o[0], o[1]); w.y = cvt_pk_bf16(o[2], o[3]); w.z = cvt_pk_bf16(o[4], o[5]); w.w = cvt_pk_bf16(o[6], o[7]); return w; }
template <int W> __device__ __forceinline__ void pool_unit(const u16* __restrict__ seq  , int t0, u16* __restrict__ out  ) {
    constexpr int LEFT = W / 2, RIGHT = W - LEFT - 1, NR = 8 + W - 1;
    u32x4 rows[NR];
#pragma unroll
    for (int k = 0; k < NR; ++k) { const int p = t0 - LEFT + k; const int pc = min(max(p, 0), SEQ - 1);
        const u32x4 v = *(const u32x4*)(seq + (size_t)pc * 2048); const bool ok = (p >= 0 && p < SEQ);
        rows[k].x = ok ? v.x : 0u; rows[k].y = ok ? v.y : 0u; rows[k].z = ok ? v.z : 0u; rows[k].w = ok ? v.w : 0u; }
    float sm[8];
#pragma unroll
    for (int c = 0; c < 8; ++c) sm[c] = 0.f;
#pragma unroll
    for (int k = 0; k < W; ++k) { float f[8]; unpack8(rows[k], f);
#pragma unroll
        for (int c = 0; c < 8; ++c) sm[c] += f[c]; }
#pragma unroll
    for (int i = 0; i < 8; ++i) { const int t = t0 + i; const int lo = max(t - LEFT, 0), hi = min(t + RIGHT, SEQ - 1); const float inv = 1.0f / (float)(hi - lo + 1);
        float ctr[8], o[8]; unpack8(rows[i + LEFT], ctr);
#pragma unroll
        for (int c = 0; c < 8; ++c) o[c] = sm[c] * inv - ctr[c];
        *(u32x4*)(out + (size_t)t * 1024) = pack8(o);
        if (i < 7) { float fa[8], fs[8]; unpack8(rows[i + W], fa); unpack8(rows[i], fs);
#pragma unroll
            for (int c = 0; c < 8; ++c) sm[c] += fa[c] - fs[c]; } }
}
__device__ __forceinline__ void dconv_unit(const u16* __restrict__ seq  , int t0, const float* __restrict__ dconv  , u16* __restrict__ out  ) {
    u32x4 cr[10], hr[10], br[8];
#pragma unroll
    for (int k = 0; k < 10; ++k) { const int p = t0 - 1 + k; const int pc = min(max(p, 0), SEQ - 1);
        const u32x4 v = *(const u32x4*)(seq + (size_t)pc * 2048 + 1024); hr[k] = *(const u32x4*)(seq + (size_t)pc * 2048 + 1536); const bool ok = (p >= 0 && p < SEQ);
        cr[k].x = ok ? v.x : 0u; cr[k].y = ok ? v.y : 0u; cr[k].z = ok ? v.z : 0u; cr[k].w = ok ? v.w : 0u; }
#pragma unroll
    for (int i = 0; i < 8; ++i) br[i] = *(const u32x4*)(seq + (size_t)(t0 + i) * 2048 + 512);
    float w0[8], w1[8], w2[8];
    { const float4 a0 = *(const float4*)(dconv), a1 = *(const float4*)(dconv + 4), b0 = *(const float4*)(dconv + 512), b1 = *(const float4*)(dconv + 516), c0 = *(const float4*)(dconv + 1024), c1 = *(const float4*)(dconv + 1028);
      w0[0] = a0.x; w0[1] = a0.y; w0[2] = a0.z; w0[3] = a0.w; w0[4] = a1.x; w0[5] = a1.y; w0[6] = a1.z; w0[7] = a1.w;
      w1[0] = b0.x; w1[1] = b0.y; w1[2] = b0.z; w1[3] = b0.w; w1[4] = b1.x; w1[5] = b1.y; w1[6] = b1.z; w1[7] = b1.w;
      w2[0] = c0.x; w2[1] = c0.y; w2[2] = c0.z; w2[3] = c0.w; w2[4] = c1.x; w2[5] = c1.y; w2[6] = c1.z; w2[7] = c1.w; }
    float pm[8], pc_[8], pn[8];
    { float c[8], h[8]; unpack8(cr[0], c); unpack8(hr[0], h);
#pragma unroll
      for (int k = 0; k < 8; ++k) pm[k] = c[k] * h[k];
      unpack8(cr[1], c); unpack8(hr[1], h);
#pragma unroll
      for (int k = 0; k < 8; ++k) pc_[k] = c[k] * h[k]; }
#pragma unroll
    for (int i = 0; i < 8; ++i) { float c[8], h[8], bb[8], o[8]; unpack8(cr[i + 2], c); unpack8(hr[i + 2], h); unpack8(br[i], bb);
#pragma unroll
        for (int k = 0; k < 8; ++k) { pn[k] = c[k] * h[k]; o[k] = bb[k] * (w0[k] * pm[k] + w1[k] * pc_[k] + w2[k] * pn[k]); pm[k] = pc_[k]; pc_[k] = pn[k]; }
        *(u32x4*)(out + (size_t)(t0 + i) * 1024) = pack8(o); }
}
__device__ void stencil_phase(const u16* __restrict__ proj  , const float* __restrict__ dconv  , u16* __restrict__ ycat  ) {
    const int tid = opaque_tid(), lane = tid & 63, wave = __builtin_amdgcn_readfirstlane(tid >> 6);
    const int chl = (lane & 15) * 8, run = lane >> 4;
    for (int wu = blockIdx.x * 8 + wave; wu < (T_ / 32) * 8; wu += gridDim.x * 8) {
        const int rq = wu >> 3, kind = wu & 7; const int tok0 = rq * 32 + run * 8; const int t0 = tok0 & (SEQ - 1); const size_t s0 = (size_t)(tok0 - t0);
        if (kind < 4) { const int ch0 = kind * 128 + chl; const u16* seq = proj + s0 * 2048 + ch0; u16* out = ycat + s0 * 1024 + ch0;
            if (kind == 0) pool_unit<2>(seq, t0, out); else if (kind == 1) pool_unit<4>(seq, t0, out); else if (kind == 2) pool_unit<8>(seq, t0, out); else pool_unit<16>(seq, t0, out);
        } else { const int ch0 = (kind - 4) * 128 + chl; dconv_unit(proj + s0 * 2048 + ch0, t0, dconv + ch0, ycat + s0 * 1024 + 512 + ch0); }
    }
}


#define XB_TMO      128
#define XB_XCNT(j)  (256  + 64 * (j))
#define XB_XSUB(j)  (1280 + 64 * (j))
#define XB_XGEN(j)  (2304 + 64 * (j))
#define XB_TOP      3328
#define XB_TOPGEN   3392
#define XCD_BAR_WORDS 3456
#define XB_SPIN_CAP (1u << 20)
__device__ __forceinline__ unsigned xb_ld(unsigned* p)              { return __hip_atomic_load(p, __ATOMIC_RELAXED, __HIP_MEMORY_SCOPE_AGENT); }
__device__ __forceinline__ unsigned xb_add(unsigned* p, unsigned v) { return __hip_atomic_fetch_add(p, v, __ATOMIC_RELAXED, __HIP_MEMORY_SCOPE_AGENT); }
__device__ __forceinline__ unsigned xb_xcc_id() { return (unsigned)__builtin_amdgcn_s_getreg((3 << 11) | 20) & 0xFu; }
#define XB_SPIN(cond, bar) do { unsigned _sp = 0; while (cond) { __builtin_amdgcn_s_sleep(1); \
    if ((++_sp & 255u) == 0u) { if (xb_ld(&(bar)[XB_TMO])) break; if (_sp > XB_SPIN_CAP) { atomicAdd(&(bar)[XB_TMO], 1u); break; } } } } while (0)
struct XcdBarrier { unsigned* bar; unsigned x; volatile LAS unsigned* st; };
__device__ __forceinline__ XcdBarrier xcd_barrier_post(unsigned* bar, volatile LAS unsigned* st) {
    XcdBarrier b; b.bar = bar; b.x = xb_xcc_id(); b.st = st;
    if (threadIdx.x == 0) (void)xb_add(&bar[XB_XCNT(b.x)], 1u);
    return b;
}
__device__ __forceinline__ void xcd_barrier_complete(unsigned* bar, unsigned x, unsigned& nloc, unsigned& nx) {
    const unsigned G = gridDim.x * gridDim.y * gridDim.z;
    unsigned sum, cnt, mine, sp = 0u;
    for (;;) {
        sum = 0u; cnt = 0u; mine = 0u;
#pragma unroll
        for (unsigned j = 0; j < 16; ++j) { const unsigned c = xb_ld(&bar[XB_XCNT(j)]); sum += c; cnt += (c > 0u) ? 1u : 0u; mine = (j == x) ? c : mine; }
        if (sum == G) break;
        __builtin_amdgcn_s_sleep(1);
        if ((++sp & 255u) == 0u) { if (xb_ld(&bar[XB_TMO])) break; if (sp > XB_SPIN_CAP) { atomicAdd(&bar[XB_TMO], 1u); break; } }
    }
    nloc = mine > 0u ? mine : 1u; nx = cnt > 0u ? cnt : 1u;
}
__device__ __forceinline__ void xcd_barrier(const XcdBarrier& b) {
    asm volatile("s_waitcnt vmcnt(0)" ::: "memory");
    __syncthreads();
    if (threadIdx.x == 0) {
        unsigned* bar = b.bar;
        __builtin_amdgcn_s_waitcnt(0);
        unsigned nloc = b.st[0], nx = b.st[1];
        if (nloc == 0u) { xcd_barrier_complete(bar, b.x, nloc, nx); b.st[0] = nloc; b.st[1] = nx; }
        const unsigned old = xb_add(&bar[XB_XSUB(b.x)], 1u);
        const unsigned gen = old / nloc;
        if (old + 1u == (gen + 1u) * nloc) {
            __builtin_amdgcn_fence(__ATOMIC_RELEASE, "agent");
            asm volatile("s_waitcnt vmcnt(0)" ::: "memory");
            const unsigned og = xb_add(&bar[XB_TOP], 1u);
            const unsigned tg = og / nx;
            if (og + 1u == (tg + 1u) * nx) xb_add(&bar[XB_TOPGEN], 1u);
            else XB_SPIN(xb_ld(&bar[XB_TOPGEN]) == tg, bar);
            __builtin_amdgcn_fence(__ATOMIC_ACQUIRE, "agent");
            xb_add(&bar[XB_XGEN(b.x)], 1u);
            asm volatile("s_waitcnt vmcnt(0)" ::: "memory");
        } else {
            XB_SPIN(xb_ld(&bar[XB_XGEN(b.x)]) == gen, bar);
            __builtin_amdgcn_fence(__ATOMIC_ACQUIRE, "agent");
            asm volatile("s_waitcnt vmcnt(0)" ::: "memory");
        }
    }
    __syncthreads();
}

constexpr int NPH = 1 + 2 * 8 + 2 * 7;
struct Args { const float* in[23]; float* out; uchar* ws; int lo, hi; };

__global__ void __launch_bounds__(NTHR, 2) fwd_kernel(Args a) {
    extern __shared__ __attribute__((aligned(16))) uchar lds_raw[];
    LAS uchar* lds = (LAS uchar*)lds_raw;
    cg::grid_group grid = cg::this_grid();
    const int lo = a.lo, hi = a.hi; int ph = 0;
    volatile LAS unsigned* xst = (volatile LAS unsigned*)(lds + LDS_ST_OFF);
    if (threadIdx.x == 0) { xst[0] = 0u; xst[1] = 0u; }
    __syncthreads();
    XcdBarrier xb = xcd_barrier_post((unsigned*)(a.ws + WS_BAR), xst);
#define PH_BEGIN if (ph >= lo && ph < hi) {
#define PH_END } if (ph >= lo && ph + 1 < hi) { if (lo < 0) grid.sync();   xcd_barrier(xb); if (DBL(11) == 2) { xcd_barrier(xb); xcd_barrier(xb); } } ++ph;
    uchar* ws = a.ws;
    u16* Wabin = (u16*)(ws + WS_ABIN); u16* Wabout = (u16*)(ws + WS_ABOUT); u16* Wcdin = (u16*)(ws + WS_CDIN); u16* Wcdout = (u16*)(ws + WS_CDOUT);
    u16* Wgu = (u16*)(ws + WS_GU); u16* Wdown = (u16*)(ws + WS_DOWN); u16* Gf = (u16*)(ws + WS_G);
    u16* H = (u16*)(ws + WS_H); u16* PROJ = (u16*)(ws + WS_B); u16* YT = (u16*)(ws + WS_B + (size_t)T_ * 1024 * 2);     u16* ACT = (u16*)(ws + WS_B); u16* PT = (u16*)(ws + WS_C);
    u16* YCAT = (u16*)(ws + WS_D); u16* MIX = (u16*)(ws + WS_E); float* RSTD = (float*)(ws + WS_RSTD);
    const float* x_in = a.in[0]; const float* norm_g = a.in[1]; float* X = a.out;

    PH_BEGIN
      for (int rep = 0; rep < DBL(0); ++rep) {
        filter_job(lds, a.in[10], a.in[11], a.in[12], a.in[13], a.in[14], a.in[15], a.in[16], Gf);
        for (int j = 0; j < 2; ++j) {
            wt_job(lds, a.in[4] + (size_t)j * 1024 * 2560, 2560, 1024, 2560, Wabin + (size_t)j * 2560 * 1024, 1024, 0, norm_g + (size_t)(2 * j) * 4 * 1024);
            wt_job(lds, a.in[5] + (size_t)j * 1024 * 1024, 1024, 1024, 1024, Wabout + (size_t)j * 1024 * 1024, 1024, 0, nullptr);
            wt_job(lds, a.in[18] + (size_t)j * 1024 * 2048, 2048, 1024, 2048, Wcdin + (size_t)j * 2048 * 1024, 1024, 0, norm_g + (size_t)(2 * j + 1) * 4 * 1024);
            wt_job(lds, a.in[19] + (size_t)j * 1024 * 1024 + 512 * 1024, 1024, 512, 1024, Wcdout + (size_t)j * 1024 * 1024 + 512, 1024, 0, nullptr);
            fold_job(a.in[20] + (size_t)j * 4 * 128 * 128, a.in[21] + j * 512, a.in[19] + (size_t)j * 1024 * 1024, Wcdout + (size_t)j * 1024 * 1024);
        }
        for (int i = 0; i < 4; ++i) {
            wt_job(lds, a.in[2] + (size_t)i * 1024 * 5632, 5632, 1024, 5632, Wgu + (size_t)i * 5632 * 1024, 1024, 1, norm_g + (size_t)(i * 4 + 2) * 1024);
            wt_job(lds, a.in[3] + (size_t)i * 2816 * 1024, 1024, 2816, 1024, Wdown + (size_t)i * 1024 * 2816, 2816, 0, nullptr);
        }
      }
        resid_pass(x_in, H, nullptr, nullptr, RSTD, nullptr);
    PH_END

#pragma unroll 1
    for (int i = 0; i < 4; ++i) {
        const int j = i >> 1; const bool even = (i & 1) == 0;
        const float* g4 = norm_g + (size_t)i * 4 * 1024;
        PH_BEGIN
            { const int N = even ? 1024 : 2048;
              pg8::Gemm g{H, even ? Wabin + (size_t)j * 2560 * 1024 : Wcdin + (size_t)j * 2048 * 1024, T_, N, 1024};
              pg8::StaticOrder S; S.init(T_, N, (int)gridDim.x, (int)blockIdx.x);
              pg8::EpiBf16G E{PROJ, N, even ? 4 : 0, RSTD};
#ifndef SKIP_G1
              for (int rep = 0; rep < DBL(6); ++rep) pg8::gemm_phase<pg8::EpiBf16G, pg8::StaticOrder, false>(lds, g, S, E, nullptr);
#endif
            }
            if (even) {
              pg8::Gemm g{H, Wabin + (size_t)j * 2560 * 1024 + (size_t)1024 * 1024, T_, 1536, 1024};
              pg8::StaticOrder S; S.init(T_, 1536, (int)gridDim.x, (int)blockIdx.x);
              pg8::EpiPT E{PT, RSTD};
              pg8::gemm_phase<pg8::EpiPT, pg8::StaticOrder, false>(lds, g, S, E, nullptr);
            }
        PH_END
        if (even) {
            PH_BEGIN
                for (int rep = 0; rep < DBL(1); ++rep) gating_phase(lds, PROJ, a.in[6] + j * 512, a.in[7] + (size_t)j * 4 * 128 * 128, a.in[8] + j * 512, YCAT);
                for (int rep = 0; rep < DBL(3); ++rep) hyena_phase(lds, PT, Gf + (size_t)j * 2 * 512 * 4096, a.in[9] + (size_t)j * 3 * 1536, a.in[17] + j * 1024, YT);
            PH_END
            PH_BEGIN
                for (int rep = 0; rep < DBL(4); ++rep) transpose_back_phase(lds, YT, YCAT);
            PH_END
        } else {
            PH_BEGIN
                for (int rep = 0; rep < DBL(5); ++rep) stencil_phase(PROJ, a.in[22] + (size_t)j * 3 * 512, YCAT);
            PH_END
        }
        PH_BEGIN
            pg8::Gemm g{YCAT, even ? Wabout + (size_t)j * 1024 * 1024 : Wcdout + (size_t)j * 1024 * 1024, T_, 1024, 1024};
            pg8::StaticOrder S; S.init(T_, 1024, (int)gridDim.x, (int)blockIdx.x);
            pg8::EpiBf16G E{MIX, 1024, 0, nullptr};

#ifndef SKIP_G2
            for (int rep = 0; rep < DBL(7); ++rep) pg8::gemm_phase<pg8::EpiBf16G, pg8::StaticOrder, false>(lds, g, S, E, nullptr);
#endif
        PH_END
        PH_BEGIN
            if (DBL(10) == 2) resid_pass(nullptr, (u16*)(ws + WS_C), MIX, g4 + 1024, (float*)(ws + WS_B), nullptr);
            resid_pass(nullptr, H, MIX, g4 + 1024, RSTD, nullptr);
        PH_END
        PH_BEGIN
            pg8::Gemm g{H, Wgu + (size_t)i * 5632 * 1024, T_, 5632, 1024};
            pg8::StaticOrder S; S.init(T_, 5632, (int)gridDim.x, (int)blockIdx.x);
            pg8::EpiSwiGLU E{ACT, DFF, RSTD};

#ifndef SKIP_G3
            for (int rep = 0; rep < DBL(8); ++rep) pg8::gemm_phase<pg8::EpiSwiGLU, pg8::StaticOrder, false>(lds, g, S, E, nullptr);
#endif
        PH_END
        PH_BEGIN
            pg8::Gemm g{ACT, Wdown + (size_t)i * 1024 * 2816, T_, 1024, DFF};
            pg8::StaticOrder S; S.init(T_, 1024, (int)gridDim.x, (int)blockIdx.x);
            pg8::EpiBf16G E{MIX, 1024, 0, nullptr};

#ifndef SKIP_G4
            for (int rep = 0; rep < DBL(9); ++rep) pg8::gemm_phase<pg8::EpiBf16G, pg8::StaticOrder, false>(lds, g, S, E, nullptr);
#endif
        PH_END
        PH_BEGIN
            if (DBL(10) == 2) resid_pass(nullptr, (u16*)(ws + WS_C), MIX, g4 + 3072, (float*)(ws + WS_B), nullptr);
            resid_pass(nullptr, H, MIX, g4 + 3072, RSTD, (i == 3) ? X : nullptr);
        PH_END
    }
#undef PH_BEGIN
#undef PH_END
}

extern "C" void kernel_launch(void* const* d_in, const int* in_sizes, int n_in, void* d_out, int out_size, void* d_ws, size_t ws_size, hipStream_t stream) {
    static int grid = 0;
    if (grid == 0) {
        if (n_in != 23 || out_size != T_ * DM || ws_size < WS_END) { fprintf(stderr, "kernel_launch: unexpected problem (n_in %d out %d ws %zu)\n", n_in, out_size, ws_size); grid = -1; return; }
        int dev = 0, cus = 0, per_cu = 0;
        (void)hipGetDevice(&dev); (void)hipDeviceGetAttribute(&cus, hipDeviceAttributeMultiprocessorCount, dev);
        if (hipFuncSetAttribute((const void*)fwd_kernel, hipFuncAttributeMaxDynamicSharedMemorySize, LDS_BYTES) != hipSuccess) { fprintf(stderr, "kernel_launch: hipFuncSetAttribute failed\n"); grid = -1; return; }
        if (hipOccupancyMaxActiveBlocksPerMultiprocessor(&per_cu, (const void*)fwd_kernel, NTHR, LDS_BYTES) != hipSuccess || per_cu < 1) { fprintf(stderr, "kernel_launch: occupancy query gave %d\n", per_cu); per_cu = 1; }
        (void)hipGetLastError();
        grid = cus * per_cu;
        fprintf(stderr, "kernel_launch: grid %d (cus %d x %d)\n", grid, cus, per_cu);
    }
    if (grid < 0) return;
    Args a{};
    for (int i = 0; i < 23; ++i) a.in[i] = (const float*)d_in[i];
    a.out = (float*)d_out; a.ws = (uchar*)d_ws;
#if ONE_LAUNCH
    (void)hipMemsetAsync((char*)d_ws + WS_BAR, 0, XCD_BAR_WORDS * 4, stream);
    a.lo = 0; a.hi = NPH;
    void* args[] = {&a};
    hipError_t e = hipLaunchCooperativeKernel((const void*)fwd_kernel, dim3(grid), dim3(NTHR), args, LDS_BYTES, stream);
    if (e != hipSuccess) fprintf(stderr, "kernel_launch: cooperative launch failed: %s (grid %d)\n", hipGetErrorString(e), grid);
#else
    for (int p = 0; p < NPH; ++p) { a.lo = p; a.hi = p + 1;
        hipLaunchKernelGGL(fwd_kernel, dim3(grid), dim3(NTHR), LDS_BYTES, stream, a); }
#endif
}
```

```cpp
#include <hip/hip_runtime.h>
#include <hip/hip_cooperative_groups.h>
#include <cstdio>
namespace cg = cooperative_groups;

#ifndef ONE_LAUNCH
#define ONE_LAUNCH 1
#endif
#ifndef DBL_MASK
#define DBL_MASK 0
#endif
#define DBL(bit) (((DBL_MASK >> (bit)) & 1) ? 2 : 1)

__device__ __forceinline__ int opaque_tid() { int t = (int)threadIdx.x; asm volatile("" : "+v"(t)); return t; }
namespace pg8 {
#define PG8_LAS __attribute__((address_space(3)))
typedef unsigned short bf16_t;
typedef short bf16x8 __attribute__((ext_vector_type(8)));
typedef float f32x4 __attribute__((ext_vector_type(4)));
typedef unsigned u32x4 __attribute__((ext_vector_type(4)));
constexpr int RS_LDS_OFF = 132096;
constexpr int BM = 256, BK = 64, HALF = 128, HTB = HALF * BK * 2  , STAGE_BYTES = 8 * HTB, NXCD = 8, WGM = 8;

__host__ __device__ __forceinline__ int lds_byte(int r, int c) { const int st = (r >> 4) * 2 + (c >> 5), rr = r & 15, cc = c & 31, ob = rr * 64 + cc * 2; return st * 1024 + (ob ^ (((ob >> 9) & 1) << 5)); }
__host__ __device__ __forceinline__ void stage_rc(int b, int& R, int& C) { const int st = b / 1024, sb = b % 1024, swz = sb ^ (((sb >> 9) & 1) << 5); R = (st >> 1) * 16 + swz / 64; C = (st & 1) * 32 + (swz % 64) / 2; }
__host__ __device__ __forceinline__ int perm32(int rho) { const int n = rho >> 4, i = rho & 15; return 8 * (i >> 2) + 4 * n + (i & 3); }
struct Unit { int pm, pn; };
struct Gemm { const bf16_t* A; const bf16_t* Bt; int M, N, K; };

struct StaticOrder {
    int nM, nN, nwg, G, c;
    __host__ __device__ void init(int M, int N, int G_, int c_) { nM = M / BM; nN = N / BM; nwg = nM * nN; G = G_; c = c_; }
    __host__ __device__ bool next(int i, Unit& u) const {
        const long L = (long)i * G + c; if (L >= nwg) return false;
        int wgid = (int)L; { const int q = nwg / NXCD, r = nwg % NXCD, xcd = wgid % NXCD, off = wgid / NXCD; wgid = (xcd < r ? xcd * (q + 1) : r * (q + 1) + (xcd - r) * q) + off; }
        const int nig = WGM * nN, gid = wgid / nig, fm = gid * WGM, gsz = (nM - fm) < WGM ? (nM - fm) : WGM;
        u.pm = fm + ((wgid % nig) % gsz); u.pn = (wgid % nig) / gsz; return true;
    }
    __device__ __forceinline__ void a_ready(const Unit&) const {}
    __device__ __forceinline__ void done(const Unit&) const {}
};
__device__ __forceinline__ unsigned cvt_pk_bf16(float lo, float hi) { unsigned r; asm volatile("v_cvt_pk_bf16_f32 %0, %1, %2" : "=v"(r) : "v"(lo), "v"(hi)); return r; }

__device__ __forceinline__ float gelu_tanh_f(float x) { const float y = 1.5957691216f * (x + 0.044715f * x * x * x); return x * __builtin_amdgcn_rcpf(1.0f + __expf(-y)); }
__device__ __forceinline__ float silu_f(float x) { return x * __builtin_amdgcn_rcpf(1.0f + __expf(-x)); }

struct EpiBf16G {
    static constexpr bool PERM = true, AFTER_DRAIN = false, SWAP = false;
    bf16_t* O; int ldc; int gelu_tiles; const float* rs;
    __device__ __forceinline__ void operator()(const f32x4 (&acc)[2][2][4][2], const Unit& u, int wr, int wc, int fr, int fq, const PG8_LAS float* rsl) const {
        const int row0 = u.pm * BM + wr * 64 + fr, col0 = u.pn * BM + wc * 32 + 8 * fq;
        const bool act = u.pn < gelu_tiles;
#pragma unroll
        for (int ai = 0; ai < 2; ++ai)
#pragma unroll
            for (int m = 0; m < 4; ++m) { const int row = row0 + ai * HALF + m * 16; bf16_t* rowp = O + (size_t)row * ldc + col0;
                const float sc = rs ? rsl[wr * 64 + fr + ai * HALF + m * 16] : 1.0f;
#pragma unroll
                for (int bj = 0; bj < 2; ++bj) { f32x4 v0 = acc[ai][bj][m][0] * sc, v1 = acc[ai][bj][m][1] * sc;
                    if (act) {
#pragma unroll
                        for (int j = 0; j < 4; ++j) { v0[j] = gelu_tanh_f(v0[j]); v1[j] = gelu_tanh_f(v1[j]); } }
                    u32x4 w; w.x = cvt_pk_bf16(v0[0], v0[1]); w.y = cvt_pk_bf16(v0[2], v0[3]); w.z = cvt_pk_bf16(v1[0], v1[1]); w.w = cvt_pk_bf16(v1[2], v1[3]);
                    *(u32x4*)(rowp + bj * HALF) = w; } }
    }
};
struct EpiPT {
    static constexpr bool PERM = false, AFTER_DRAIN = false, SWAP = true;
    bf16_t* O; const float* rs;
    __device__ __forceinline__ void operator()(const f32x4 (&acc)[2][2][4][2], const Unit& u, int wr, int wc, int fr, int fq, const PG8_LAS float* rsl) const {
        const int row0 = u.pm * BM + wr * 64 + 4 * fq, col0 = u.pn * BM + wc * 32 + fr;
        const int b = row0 >> 11, s0 = row0 & 2047;
        typedef unsigned u32x2_t __attribute__((ext_vector_type(2)));
#pragma unroll
        for (int ai = 0; ai < 2; ++ai)
#pragma unroll
            for (int m = 0; m < 4; ++m) { const f32x4 sc = *(const PG8_LAS f32x4*)(rsl + wr * 64 + 4 * fq + ai * HALF + m * 16);
#pragma unroll
                for (int bj = 0; bj < 2; ++bj)
#pragma unroll
                    for (int n = 0; n < 2; ++n) { bf16_t* colp = O + ((size_t)(col0 + bj * HALF + n * 16) * 32 + b) * 2048 + s0;
                        const f32x4 v = acc[ai][bj][m][n] * sc;
                        u32x2_t w; w.x = cvt_pk_bf16(v[0], v[1]); w.y = cvt_pk_bf16(v[2], v[3]);
                        *(u32x2_t*)(colp + ai * HALF + m * 16) = w; } }
    }
};
struct EpiSwiGLU {
    static constexpr bool PERM = true, AFTER_DRAIN = false, SWAP = false;
    bf16_t* O; int ldc; const float* rs;
    __device__ __forceinline__ void operator()(const f32x4 (&acc)[2][2][4][2], const Unit& u, int wr, int wc, int fr, int fq, const PG8_LAS float* rsl) const {
        const int row0 = u.pm * BM + wr * 64 + fr, col0 = u.pn * HALF + wc * 32 + 8 * fq;
#pragma unroll
        for (int ai = 0; ai < 2; ++ai)
#pragma unroll
            for (int m = 0; m < 4; ++m) { const int row = row0 + ai * HALF + m * 16; bf16_t* rowp = O + (size_t)row * ldc + col0;
                const float sc = rsl[wr * 64 + fr + ai * HALF + m * 16];
                const f32x4 g0 = acc[ai][0][m][0] * sc, g1 = acc[ai][0][m][1] * sc, u0 = acc[ai][1][m][0] * sc, u1 = acc[ai][1][m][1] * sc;
                const f32x4 a0 = g0 * (-1.4426950408889634f), a1 = g1 * (-1.4426950408889634f);
                f32x4 e0, e1;
#pragma unroll
                for (int j = 0; j < 4; ++j) { e0[j] = __builtin_amdgcn_exp2f(a0[j]); e1[j] = __builtin_amdgcn_exp2f(a1[j]); }
                const f32x4 d0 = e0 + 1.0f, d1 = e1 + 1.0f;
                f32x4 r0, r1;
#pragma unroll
                for (int j = 0; j < 4; ++j) { r0[j] = __builtin_amdgcn_rcpf(d0[j]); r1[j] = __builtin_amdgcn_rcpf(d1[j]); }
                const f32x4 v0 = (g0 * u0) * r0, v1 = (g1 * u1) * r1;
                u32x4 w; w.x = cvt_pk_bf16(v0[0], v0[1]); w.y = cvt_pk_bf16(v0[2], v0[3]); w.z = cvt_pk_bf16(v1[0], v1[1]); w.w = cvt_pk_bf16(v1[2], v1[3]);
                *(u32x4*)rowp = w; }
    }
};

template <class Epi, class Sched, bool STAMP = false>
__device__ __forceinline__ void gemm_phase(PG8_LAS unsigned char* lds, const Gemm g, const Sched& S, const Epi& E, unsigned long long* stamps) {
    const int tid = opaque_tid(), wid = __builtin_amdgcn_readfirstlane(tid >> 6), lane = tid & 63, wr = wid >> 2, wc = wid & 3, fr = lane & 15, fq = lane >> 4;
    const int K = g.K, nt = K / BK;
    int ts_lo = 0, ts_hi = 0, nts = 0; const unsigned long long rt_entry = STAMP ? (unsigned long long)wall_clock64() : 0ull;
#define PG8_STAMP() do { if (STAMP && wid == 0 && nts < 64) { const unsigned long long _c = (unsigned long long)clock64(); \
        ts_lo = (lane == nts) ? (int)(unsigned)_c : ts_lo; ts_hi = (lane == nts) ? (int)(unsigned)(_c >> 32) : ts_hi; ++nts; } } while (0)
    PG8_STAMP();
    unsigned voffA[2], voffB[2];
#pragma unroll
    for (int i = 0; i < 2; ++i) { int R, C; stage_rc(tid * 16 + i * 8192, R, C); const int Rb = Epi::PERM ? ((R & ~31) + perm32(R & 31)) : R;
        voffA[i] = (unsigned)(R * K + C) * 2u; voffB[i] = (unsigned)(Rb * K + C) * 2u; }
    const size_t kstep = (size_t)(BK * 2);
    const size_t hstep = (size_t)HALF * K * 2;
    const size_t tstep = 2 * hstep;
    const unsigned ldsw = (unsigned)wid * 1024u;
    const int aoff = lds_byte(wr * 64 + fr, fq * 8), boff = lds_byte(wc * 32 + fr, fq * 8);
#define PG8_SA(b, h) (((b) * 2 + (h)) * HTB)
#define PG8_SB(b, h) ((4 + (b) * 2 + (h)) * HTB)
#define PG8_STAGE(bufoff, gbase, voff) do { _Pragma("unroll") for (int _i = 0; _i < 2; ++_i) \
        __builtin_amdgcn_global_load_lds((const unsigned*)((const char*)(gbase) + (voff)[_i]), (PG8_LAS unsigned*)(lds + (bufoff) + ldsw + _i * 8192), 16, 0, 0); } while (0)
#define PG8_LDA(dst, b, h) do { _Pragma("unroll") for (int m = 0; m < 4; ++m) _Pragma("unroll") for (int k = 0; k < 2; ++k) dst[m][k] = *(const PG8_LAS bf16x8*)(lds + PG8_SA(b, h) + aoff + m * 2048 + k * 1024); } while (0)
#define PG8_LDB(dst, b, h) do { _Pragma("unroll") for (int n = 0; n < 2; ++n) _Pragma("unroll") for (int k = 0; k < 2; ++k) dst[n][k] = *(const PG8_LAS bf16x8*)(lds + PG8_SB(b, h) + boff + n * 2048 + k * 1024); } while (0)
#define PG8_MMA(ai, bj, At, Bt) do { __builtin_amdgcn_s_setprio(1); _Pragma("unroll") for (int m = 0; m < 4; ++m) _Pragma("unroll") for (int n = 0; n < 2; ++n) _Pragma("unroll") for (int k = 0; k < 2; ++k) \
        acc[ai][bj][m][n] = Epi::SWAP ? __builtin_amdgcn_mfma_f32_16x16x32_bf16(At[m][k], Bt[n][k], acc[ai][bj][m][n], 0, 0, 0) : __builtin_amdgcn_mfma_f32_16x16x32_bf16(Bt[n][k], At[m][k], acc[ai][bj][m][n], 0, 0, 0); __builtin_amdgcn_s_setprio(0); } while (0)
#define PG8_WAIT_V(n) asm volatile("s_waitcnt vmcnt(" #n ")" ::: "memory")
#define PG8_WAIT_L(n) asm volatile("s_waitcnt lgkmcnt(" #n ")" ::: "memory")
#define PG8_BAR __builtin_amdgcn_s_barrier()
#define PG8_SCHED __builtin_amdgcn_sched_barrier(0)
#define PG8_STAGE_RS(unit, buf) do { if (E.rs != nullptr && wid < 4) __builtin_amdgcn_global_load_lds((const unsigned*)(E.rs + (unit).pm * BM + wid * 64 + lane), (PG8_LAS unsigned*)(lds + RS_LDS_OFF + (buf) * 1024 + wid * 256), 4, 0, 0); } while (0)
    Unit cur, nxt; int ui = 0;
    if (!S.next(0, cur)) return;
    f32x4 acc[2][2][4][2];
#pragma unroll
    for (int a = 0; a < 2; ++a)
#pragma unroll
        for (int b = 0; b < 2; ++b)
#pragma unroll
            for (int m = 0; m < 4; ++m)
#pragma unroll
                for (int n = 0; n < 2; ++n) acc[a][b][m][n] = (f32x4){0.f, 0.f, 0.f, 0.f};
    bf16x8 At[4][2], B0[2][2], B1[2][2];
    const char* cA = (const char*)g.A + (size_t)cur.pm * tstep; const char* cB = (const char*)g.Bt + (size_t)cur.pn * tstep;
    S.a_ready(cur);
    PG8_STAGE_RS(cur, 0);
    PG8_STAGE(PG8_SB(0, 0), cB, voffB); PG8_STAGE(PG8_SA(0, 0), cA, voffA); PG8_STAGE(PG8_SB(0, 1), cB + hstep, voffB); PG8_STAGE(PG8_SA(0, 1), cA + hstep, voffA);
    if (wr == 1) PG8_BAR;
    PG8_WAIT_V(4); PG8_BAR;
    PG8_STAGE(PG8_SB(1, 0), cB + kstep, voffB); PG8_STAGE(PG8_SA(1, 0), cA + kstep, voffA); PG8_STAGE(PG8_SB(1, 1), cB + hstep + kstep, voffB);
    PG8_WAIT_V(6); PG8_BAR;
    PG8_STAMP();
    for (;;) {
        const bool has_next = S.next(ui + 1, nxt);
        const char* nA = has_next ? (const char*)g.A + (size_t)nxt.pm * tstep : cA; const char* nB = has_next ? (const char*)g.Bt + (size_t)nxt.pn * tstep : cB;
        for (int t = 0; t < nt; t += 2) {
            const bool last = (t == nt - 2);
            const char* a1 = cA + (size_t)(t + 1) * kstep;
            const char* a2 = last ? nA : cA + (size_t)(t + 2) * kstep; const char* b2 = last ? nB : cB + (size_t)(t + 2) * kstep;
            const char* a3 = a2 + kstep; const char* b3 = b2 + kstep;
            if (last && has_next) { S.a_ready(nxt); PG8_STAGE_RS(nxt, (ui + 1) & 1); }
            PG8_LDB(B0, 0, 0); PG8_SCHED; PG8_LDA(At, 0, 0); PG8_STAGE(PG8_SA(1, 1), a1 + hstep, voffA);
            PG8_WAIT_L(8); PG8_BAR; PG8_WAIT_L(0); PG8_MMA(0, 0, At, B0); PG8_BAR; PG8_SCHED;
            PG8_LDB(B1, 0, 1); PG8_STAGE(PG8_SB(0, 0), b2, voffB);
            PG8_BAR; PG8_WAIT_L(0); PG8_MMA(0, 1, At, B1); PG8_BAR;
            PG8_LDA(At, 0, 1); PG8_STAGE(PG8_SA(0, 0), a2, voffA);
            PG8_BAR; PG8_WAIT_L(0); PG8_MMA(1, 0, At, B0); PG8_BAR; PG8_SCHED;
            PG8_STAGE(PG8_SB(0, 1), b2 + hstep, voffB);
            PG8_WAIT_V(6); PG8_BAR; PG8_MMA(1, 1, At, B1); PG8_BAR;
            PG8_LDB(B0, 1, 0); PG8_SCHED; PG8_LDA(At, 1, 0); PG8_STAGE(PG8_SA(0, 1), a2 + hstep, voffA);
            PG8_WAIT_L(8); PG8_BAR; PG8_WAIT_L(0); PG8_MMA(0, 0, At, B0); PG8_BAR; PG8_SCHED;
            PG8_LDB(B1, 1, 1); PG8_STAGE(PG8_SB(1, 0), b3, voffB);
            PG8_BAR; PG8_WAIT_L(0); PG8_MMA(0, 1, At, B1); PG8_BAR;
            PG8_LDA(At, 1, 1); PG8_STAGE(PG8_SA(1, 0), a3, voffA);
            PG8_BAR; PG8_WAIT_L(0); PG8_MMA(1, 0, At, B0); PG8_BAR; PG8_SCHED;
            PG8_STAGE(PG8_SB(1, 1), b3 + hstep, voffB);
            PG8_WAIT_V(6); PG8_BAR; PG8_MMA(1, 1, At, B1); PG8_BAR;
        }
        PG8_STAMP();
        if constexpr (!Epi::AFTER_DRAIN) { E(acc, cur, wr, wc, fr, fq, (const PG8_LAS float*)(lds + RS_LDS_OFF + (ui & 1) * 1024)); S.done(cur); }
        PG8_STAMP();
        if (!has_next) break;
#pragma unroll
        for (int a = 0; a < 2; ++a)
#pragma unroll
            for (int b = 0; b < 2; ++b)
#pragma unroll
                for (int m = 0; m < 4; ++m)
#pragma unroll
                    for (int n = 0; n < 2; ++n) acc[a][b][m][n] = (f32x4){0.f, 0.f, 0.f, 0.f};
        cur = nxt; cA = nA; cB = nB; ++ui;
    }
    PG8_WAIT_V(0);
    if (wr == 0) PG8_BAR;
    PG8_BAR;
    if constexpr (Epi::AFTER_DRAIN) { E.fused(acc, cur, wr, wc, fr, fq, lds, wid, lane); S.done(cur); }
    PG8_STAMP();
    if (STAMP && wid == 0) { stamps[lane] = lane < nts ? (((unsigned long long)(unsigned)ts_hi << 32) | (unsigned)ts_lo) : 0ull;
        if (lane == 62) stamps[62] = rt_entry; if (lane == 63) stamps[63] = (unsigned long long)wall_clock64(); }
#undef PG8_STAMP
#undef PG8_SA
#undef PG8_SB
#undef PG8_STAGE
#undef PG8_LDA
#undef PG8_LDB
#undef PG8_MMA
#undef PG8_WAIT_V
#undef PG8_WAIT_L
#undef PG8_BAR
#undef PG8_SCHED
#undef PG8_STAGE_RS
}
}

#define LAS PG8_LAS
typedef unsigned short u16;
typedef unsigned char uchar;
using pg8::bf16x8; using pg8::f32x4; using pg8::u32x4; using pg8::cvt_pk_bf16;
typedef float f32x16 __attribute__((ext_vector_type(16)));
typedef unsigned u32x2 __attribute__((ext_vector_type(2)));
typedef int i32x4 __attribute__((ext_vector_type(4)));

constexpr int T_ = 65536, DM = 1024, SEQ = 2048, NB = 32, DFF = 2816, NTHR = 512;
constexpr int LDS_ST_OFF = 151552;
constexpr int LDS_BYTES = LDS_ST_OFF + 16;
constexpr size_t SZ_ABIN = 2ull * 2560 * 1024 * 2, SZ_ABOUT = 2ull * 1024 * 1024 * 2, SZ_CDIN = 2ull * 2048 * 1024 * 2, SZ_CDOUT = 2ull * 1024 * 1024 * 2,
                 SZ_GU = 4ull * 5632 * 1024 * 2, SZ_DOWN = 4ull * 1024 * 2816 * 2, SZ_G = 2ull * 2 * 512 * 4096 * 2;
constexpr size_t WS_ABIN = 0, WS_ABOUT = WS_ABIN + SZ_ABIN, WS_CDIN = WS_ABOUT + SZ_ABOUT, WS_CDOUT = WS_CDIN + SZ_CDIN, WS_GU = WS_CDOUT + SZ_CDOUT, WS_DOWN = WS_GU + SZ_GU,
                 WS_G = WS_DOWN + SZ_DOWN,
                 WS_H = WS_G + SZ_G,
                 WS_B = WS_H + (size_t)T_ * 1024 * 2,
                 WS_C = WS_B + (size_t)T_ * 2560 * 2,
                 WS_D = WS_C + (size_t)1536 * 32 * 2048 * 2,
                 WS_E = WS_D + (size_t)T_ * 1024 * 2,
                 WS_BAR = WS_E + (size_t)T_ * 1024 * 2,
                 WS_RSTD = WS_BAR + 16384,
                 WS_END = WS_RSTD + (size_t)T_ * 4;
static_assert(WS_END <= (1ull << 30), "workspace map exceeds 1 GiB");
static_assert((size_t)T_ * DFF * 2 <= WS_D - WS_B, "act does not fit B + C");

__device__ __forceinline__ float bflo(unsigned w) { return __uint_as_float(w << 16); }
__device__ __forceinline__ float bfhi(unsigned w) { return __uint_as_float(w & 0xffff0000u); }
__device__ __forceinline__ float bf2f(u16 v) { return __uint_as_float(((unsigned)v) << 16); }
__device__ __forceinline__ u16 f2bf(float f) { return (u16)(cvt_pk_bf16(f, 0.f) & 0xffffu); }
__device__ __forceinline__ float wave_sum(float v) {
#pragma unroll
    for (int o = 32; o >= 1; o >>= 1) v += __shfl_xor(v, o, 64);
    return v;
}

__device__ void wt_job(LAS uchar* lds, const float* __restrict__ W, int ldw, int K, int N, u16* __restrict__ out, int ldo, int mode, const float* __restrict__ gain, int& rot) {
    LAS float* tile = (LAS float*)lds;
    const int tid = opaque_tid(); const int nkq = K / 256, nnt = N / 64, nsteps = nkq * nnt;
    const int G = (int)gridDim.x; const int first = ((int)blockIdx.x + G - (rot % G)) % G; rot += nsteps;
    for (int ti = first; ti < nsteps; ti += G) {
        const int kq = ti % nkq, nt = ti / nkq; const int k0 = kq * 256, n0 = nt * 64;
        int sc0 = n0; if (mode == 1) { const int pn = n0 >> 8, r = n0 & 255; sc0 = (r < 128) ? (pn * 128 + r) : (DFF + pn * 128 + (r - 128)); }
        float4 v[8];
#pragma unroll
        for (int i = 0; i < 8; ++i) { const int idx = tid + i * 512; const int kk = idx >> 4, c4 = (idx & 15) * 4;
            v[i] = *(const float4*)(W + (size_t)(k0 + kk) * ldw + sc0 + c4); }
#pragma unroll
        for (int i = 0; i < 8; ++i) { const int idx = tid + i * 512; const int kk = idx >> 4, c4 = (idx & 15) * 4;
            const float gk = gain ? gain[k0 + kk] : 1.0f;
            tile[kk * 65 + c4 + 0] = v[i].x * gk; tile[kk * 65 + c4 + 1] = v[i].y * gk; tile[kk * 65 + c4 + 2] = v[i].z * gk; tile[kk * 65 + c4 + 3] = v[i].w * gk; }
        __syncthreads();
#pragma unroll
        for (int q = 0; q < 4; ++q) { const int nn = tid >> 3, kc = q * 64 + (tid & 7) * 8;
          float f0 = tile[(kc + 0) * 65 + nn], f1 = tile[(kc + 1) * 65 + nn], f2 = tile[(kc + 2) * 65 + nn], f3 = tile[(kc + 3) * 65 + nn];
          float f4 = tile[(kc + 4) * 65 + nn], f5 = tile[(kc + 5) * 65 + nn], f6 = tile[(kc + 6) * 65 + nn], f7 = tile[(kc + 7) * 65 + nn];
          u32x4 w; w.x = cvt_pk_bf16(f0, f1); w.y = cvt_pk_bf16(f2, f3); w.z = cvt_pk_bf16(f4, f5); w.w = cvt_pk_bf16(f6, f7);
          *(u32x4*)(out + (size_t)(n0 + nn) * ldo + k0 + kc) = w; }
        __syncthreads();
    }
}
__device__ void fold_job(const float* __restrict__ cw, const float* __restrict__ scale, const float* __restrict__ Wout, u16* __restrict__ out) {
    for (int idx = blockIdx.x * NTHR + opaque_tid(); idx < 512 * 128; idx += gridDim.x * NTHR) {
        const int k = idx >> 7, n0 = (idx & 127) * 8; const int g = k >> 7;
        const float* cwr = cw + (size_t)k * 128; const float* sc = scale + g * 128; const float* wr = Wout + (size_t)(g * 128) * 1024 + n0;
        float acc[8];
#pragma unroll
        for (int u = 0; u < 8; ++u) acc[u] = 0.f;
#pragma unroll 8
        for (int c2 = 0; c2 < 128; ++c2) { const float cf = cwr[c2] * sc[c2]; const float4 w0 = *(const float4*)(wr + (size_t)c2 * 1024), w1 = *(const float4*)(wr + (size_t)c2 * 1024 + 4);
            acc[0] += cf * w0.x; acc[1] += cf * w0.y; acc[2] += cf * w0.z; acc[3] += cf * w0.w; acc[4] += cf * w1.x; acc[5] += cf * w1.y; acc[6] += cf * w1.z; acc[7] += cf * w1.w; }
#pragma unroll
        for (int u = 0; u < 8; ++u) out[(size_t)(n0 + u) * 1024 + k] = f2bf(acc[u]);
    }
}
__device__ void filter_job(LAS uchar* lds, const float* __restrict__ w1a, const float* __restrict__ b1a, const float* __restrict__ freqa, const float* __restrict__ w2a,
                           const float* __restrict__ b2a, const float* __restrict__ w3a, const float* __restrict__ decaya, u16* __restrict__ Gall) {
    LAS float* h2 = (LAS float*)lds;
    LAS float* zf = h2 + 64 * 64;
    LAS float* h1 = zf + 64 * 33;
    LAS float* w3s = h2 + 64 * 64;
    const int tid = opaque_tid(), lane = tid & 63, wave = __builtin_amdgcn_readfirstlane(tid >> 6);
    for (int item = blockIdx.x; item < 256; item += gridDim.x) {
        const int j = item >> 7, tg = (item >> 2) & 31, cq = item & 3, t0 = tg * 64;
        const float* w1 = w1a + j * 33 * 64; const float* b1 = b1a + j * 64; const float* freq = freqa + j * 128; const float* w2 = w2a + j * 4096; const float* b2 = b2a + j * 64;
        const float* w3 = w3a + (size_t)j * 64 * 2048; const float* decay = decaya + j * 2048; u16* Gj = Gall + (size_t)j * 2 * 512 * 4096;
        float4 wpre[16];
#pragma unroll
        for (int i = 0; i < 16; ++i) { const int idx = tid + i * NTHR; wpre[i] = *(const float4*)(w3 + (size_t)(idx >> 7) * 2048 + cq * 512 + (idx & 127) * 4); }
        for (int idx = tid; idx < 64 * 33; idx += NTHR) { const int tt = idx / 33, f = idx - tt * 33; const float t = (float)(t0 + tt);
            float val;
            if (f == 0) val = t / 2047.0f;
            else { const int fi = (f - 1) & 15; const float band = 1e-4f + (float)fi * ((15.0f - 1e-4f) / 15.0f); const float w = 6.283185307179586f * t / 2048.0f; const float fw = w * band;
                   val = (f <= 16) ? cosf(fw) : -sinf(fw); }
            zf[idx] = val; }
        __syncthreads();
        for (int idx = tid; idx < 4096; idx += NTHR) { const int tt = idx >> 6, k = idx & 63; float acc = 0.f;
            for (int f = 0; f < 33; ++f) acc += zf[tt * 33 + f] * w1[f * 64 + k];
            h1[tt * 64 + k] = sinf(freq[k] * (acc + b1[k])); }
        __syncthreads();
        for (int idx = tid; idx < 4096; idx += NTHR) { const int tt = idx >> 6, k = idx & 63; float acc = 0.f;
            for (int k2 = 0; k2 < 64; ++k2) acc += h1[tt * 64 + k2] * w2[k2 * 64 + k];
            h2[k * 64 + tt] = sinf(freq[64 + k] * (acc + b2[k])); }
        __syncthreads();
#pragma unroll
        for (int i = 0; i < 16; ++i) { const int idx = tid + i * NTHR; f32x4 wv; wv.x = wpre[i].x; wv.y = wpre[i].y; wv.z = wpre[i].z; wv.w = wpre[i].w; *(LAS f32x4*)(w3s + (idx >> 7) * 512 + (idx & 127) * 4) = wv; }
        __syncthreads();
        { const int t = t0 + lane; const float t01 = (float)t / 2047.0f;
          for (int ci = 0; ci < 64; ci += 4) { const int cl = wave * 64 + ci, col = cq * 512 + cl; float a0 = 0.f, a1 = 0.f, a2 = 0.f, a3 = 0.f;
#pragma unroll 16
              for (int k = 0; k < 64; ++k) { const f32x4 w = *(const LAS f32x4*)(w3s + k * 512 + cl); const float hv = h2[k * 64 + lane]; a0 += hv * w.x; a1 += hv * w.y; a2 += hv * w.z; a3 += hv * w.w; }
              const float4 dc = *(const float4*)(decay + col);
              a0 *= expf(-t01 * fabsf(dc.x)); a1 *= expf(-t01 * fabsf(dc.y)); a2 *= expf(-t01 * fabsf(dc.z)); a3 *= expf(-t01 * fabsf(dc.w));
              const int dir = col >> 10, o = (col >> 9) & 1, c = col & 511; u16* g = Gj + (size_t)(o * 512 + c) * 4096;
              if (dir == 0) { g[2048 - t] = f2bf(a0); g[4096 + 2048 - t] = f2bf(a1); g[8192 + 2048 - t] = f2bf(a2); g[12288 + 2048 - t] = f2bf(a3);
                              if (t == 0) { g[0] = 0; g[4096] = 0; g[8192] = 0; g[12288] = 0; } }
              else if (t <= 2046) { g[2049 + t] = f2bf(a0); g[4096 + 2049 + t] = f2bf(a1); g[8192 + 2049 + t] = f2bf(a2); g[12288 + 2049 + t] = f2bf(a3); } } }
        __syncthreads();
    }
}

__device__ __forceinline__ void unpack8(const u32x4 v, float (&f)[8]) { f[0] = bflo(v.x); f[1] = bfhi(v.x); f[2] = bflo(v.y); f[3] = bfhi(v.y); f[4] = bflo(v.z); f[5] = bfhi(v.z); f[6] = bflo(v.w); f[7] = bfhi(v.w); }
__device__ __forceinline__ float4 ntload4(const float* p) { const f32x4 v = __builtin_nontemporal_load((const f32x4*)p); float4 r; r.x = v.x; r.y = v.y; r.z = v.z; r.w = v.w; return r; }
__device__ __forceinline__ void ntstore4(float* p, float a, float b, float c, float d) { f32x4 w; w.x = a; w.y = b; w.z = c; w.w = d; __builtin_nontemporal_store(w, (f32x4*)p); }
__device__ void resid_pass(const float* __restrict__ xin_f, u16* __restrict__ xb, const u16* __restrict__ mix, const float* __restrict__ gpost, float* __restrict__ rstd_out, float* __restrict__ out_f) {
    const int tid = opaque_tid(); const int lane = tid & 63, wave = tid >> 6;
    const int stride = gridDim.x * 8;
    constexpr int NR = 4;
    for (int row0 = blockIdx.x * 8 + wave; row0 < T_; row0 += NR * stride) {
        float x[NR][16];
        if (xin_f) {
#pragma unroll
            for (int k = 0; k < NR; ++k) { const int row = min(row0 + k * stride, T_ - 1);
#pragma unroll
                for (int c = 0; c < 2; ++c) { const float4 a0 = ntload4(xin_f + (size_t)row * 1024 + c * 512 + lane * 8), a1 = ntload4(xin_f + (size_t)row * 1024 + c * 512 + lane * 8 + 4);
                    x[k][c * 8 + 0] = a0.x; x[k][c * 8 + 1] = a0.y; x[k][c * 8 + 2] = a0.z; x[k][c * 8 + 3] = a0.w; x[k][c * 8 + 4] = a1.x; x[k][c * 8 + 5] = a1.y; x[k][c * 8 + 6] = a1.z; x[k][c * 8 + 7] = a1.w; } }
        } else {
            u32x4 xr[NR][2], mr[NR][2];
#pragma unroll
            for (int k = 0; k < NR; ++k) { const int row = min(row0 + k * stride, T_ - 1);
#pragma unroll
                for (int c = 0; c < 2; ++c) { xr[k][c] = *(const u32x4*)(xb + (size_t)row * 1024 + c * 512 + lane * 8); mr[k][c] = __builtin_nontemporal_load((const u32x4*)(mix + (size_t)row * 1024 + c * 512 + lane * 8)); } }
            float g[16];
#pragma unroll
            for (int c = 0; c < 2; ++c) { const float4 a0 = *(const float4*)(gpost + c * 512 + lane * 8), a1 = *(const float4*)(gpost + c * 512 + lane * 8 + 4);
                g[c * 8 + 0] = a0.x; g[c * 8 + 1] = a0.y; g[c * 8 + 2] = a0.z; g[c * 8 + 3] = a0.w; g[c * 8 + 4] = a1.x; g[c * 8 + 5] = a1.y; g[c * 8 + 6] = a1.z; g[c * 8 + 7] = a1.w; }
#pragma unroll
            for (int k = 0; k < NR; ++k) { float m[16]; float ss = 0.f;
#pragma unroll
                for (int c = 0; c < 2; ++c) { float t8[8]; unpack8(mr[k][c], t8);
#pragma unroll
                    for (int e = 0; e < 8; ++e) { m[c * 8 + e] = t8[e]; ss += t8[e] * t8[e]; } }
                ss = wave_sum(ss); const float rstd = rsqrtf(ss * (1.0f / 1024.0f) + 1e-6f);
#pragma unroll
                for (int c = 0; c < 2; ++c) { float t8[8]; unpack8(xr[k][c], t8);
#pragma unroll
                    for (int e = 0; e < 8; ++e) x[k][c * 8 + e] = t8[e] + m[c * 8 + e] * rstd * g[c * 8 + e]; } }
        }
#pragma unroll
        for (int k = 0; k < NR; ++k) { const int row = row0 + k * stride;
            if (row < T_) {
                if (out_f) {
#pragma unroll
                    for (int c = 0; c < 2; ++c) { ntstore4(out_f + (size_t)row * 1024 + c * 512 + lane * 8, x[k][c * 8 + 0], x[k][c * 8 + 1], x[k][c * 8 + 2], x[k][c * 8 + 3]);
                        ntstore4(out_f + (size_t)row * 1024 + c * 512 + lane * 8 + 4, x[k][c * 8 + 4], x[k][c * 8 + 5], x[k][c * 8 + 6], x[k][c * 8 + 7]); }
                } else {
                    float ss = 0.f;
#pragma unroll
                    for (int e = 0; e < 16; ++e) ss += x[k][e] * x[k][e];
                    ss = wave_sum(ss);
                    if (lane == 0) rstd_out[row] = rsqrtf(ss * (1.0f / 1024.0f) + 1e-6f);
#pragma unroll
                    for (int c = 0; c < 2; ++c) { u32x4 w; w.x = cvt_pk_bf16(x[k][c * 8 + 0], x[k][c * 8 + 1]); w.y = cvt_pk_bf16(x[k][c * 8 + 2], x[k][c * 8 + 3]); w.z = cvt_pk_bf16(x[k][c * 8 + 4], x[k][c * 8 + 5]); w.w = cvt_pk_bf16(x[k][c * 8 + 6], x[k][c * 8 + 7]);
                        *(u32x4*)(xb + (size_t)row * 1024 + c * 512 + lane * 8) = w; }
                }
            }
        }
    }
}

constexpr int TRS = 66;
__device__ __forceinline__ void tr_tile8(LAS u16* tiles  , const u16* __restrict__ src, size_t lds_src, size_t src_ts, u16* __restrict__ dst, size_t ldd, size_t dst_ts) {
    const int tid = opaque_tid(), r = tid >> 3, ch = (tid & 7) * 8;
    u32x4 v[8];
#pragma unroll
    for (int k = 0; k < 8; ++k) v[k] = *(const u32x4*)(src + k * src_ts + (size_t)r * lds_src + ch);
#pragma unroll
    for (int k = 0; k < 8; ++k) { LAS u16* tile = tiles + k * 64 * TRS;
        tile[(ch + 0) * TRS + r] = (u16)(v[k].x & 0xffffu); tile[(ch + 1) * TRS + r] = (u16)(v[k].x >> 16);
        tile[(ch + 2) * TRS + r] = (u16)(v[k].y & 0xffffu); tile[(ch + 3) * TRS + r] = (u16)(v[k].y >> 16);
        tile[(ch + 4) * TRS + r] = (u16)(v[k].z & 0xffffu); tile[(ch + 5) * TRS + r] = (u16)(v[k].z >> 16);
        tile[(ch + 6) * TRS + r] = (u16)(v[k].w & 0xffffu); tile[(ch + 7) * TRS + r] = (u16)(v[k].w >> 16); }
    __syncthreads();
#pragma unroll
    for (int k = 0; k < 8; ++k) { const LAS unsigned* p = (const LAS unsigned*)(tiles + k * 64 * TRS + r * TRS + ch);
        u32x4 o; o.x = p[0]; o.y = p[1]; o.z = p[2]; o.w = p[3];
        *(u32x4*)(dst + k * dst_ts + (size_t)r * ldd + ch) = o; }
    __syncthreads();
}
__device__ void transpose_fwd_phase(LAS uchar* lds, const u16* __restrict__ proj, u16* __restrict__ pT) {
    LAS u16* tiles = (LAS u16*)lds;
    for (int it = blockIdx.x; it < NB * 32 * 3; it += gridDim.x) {
        const int c8 = it % 3, st = (it / 3) & 31, b = it / 96;
        tr_tile8(tiles, proj + (size_t)(b * SEQ + st * 64) * 2560 + 1024 + c8 * 512, 2560, 64, pT + ((size_t)(c8 * 512) * NB + b) * SEQ + st * 64, (size_t)NB * SEQ, (size_t)64 * NB * SEQ);
    }
}
__device__ void transpose_back_phase(LAS uchar* lds, const u16* __restrict__ yT, u16* __restrict__ ycat) {
    LAS u16* tiles = (LAS u16*)lds;
    for (int it = blockIdx.x; it < NB * 32; it += gridDim.x) {
        const int st = it & 31, b = it >> 5;
        tr_tile8(tiles, yT + (size_t)b * SEQ + st * 64, (size_t)NB * SEQ, (size_t)64 * NB * SEQ, ycat + (size_t)(b * SEQ + st * 64) * 1024 + 512, 1024, 64);
    }
}
__device__ void gating_phase(LAS uchar* lds, const u16* __restrict__ proj  , const float* __restrict__ ln_g  ,
                             const float* __restrict__ w_s  , const float* __restrict__ b_s  , u16* __restrict__ ycat  ) {
    LAS u16* vT = (LAS u16*)lds;
    LAS u16* wsb = vT + 128 * 136;
    LAS float* stats = (LAS float*)(wsb + 128 * 136);
    const int tid = opaque_tid(), lane = tid & 63, wave = tid >> 6, fr = lane & 15, fq = lane >> 4;
    for (int item = blockIdx.x; item < T_ / 128; item += gridDim.x) {
        const int tok0 = item * 128;
        { u32x4 vv[16];
#pragma unroll
          for (int tt = 0; tt < 16; ++tt) vv[tt] = *(const u32x4*)(proj + (size_t)(tok0 + wave * 16 + tt) * 1024 + 512 + lane * 8);
#pragma unroll
          for (int tt = 0; tt < 16; ++tt) { const int q = wave * 16 + tt; const u32x4 v = vv[tt];
            const float f0 = bflo(v.x), f1 = bfhi(v.x), f2 = bflo(v.y), f3 = bfhi(v.y), f4 = bflo(v.z), f5 = bfhi(v.z), f6 = bflo(v.w), f7 = bfhi(v.w);
            const float mean = wave_sum(f0 + f1 + f2 + f3 + f4 + f5 + f6 + f7) * (1.0f / 512.0f);
            const float d0 = f0 - mean, d1 = f1 - mean, d2 = f2 - mean, d3 = f3 - mean, d4 = f4 - mean, d5 = f5 - mean, d6 = f6 - mean, d7 = f7 - mean;
            const float var = wave_sum(d0 * d0 + d1 * d1 + d2 * d2 + d3 * d3 + d4 * d4 + d5 * d5 + d6 * d6 + d7 * d7) * (1.0f / 512.0f);
            if (lane == 0) { stats[q * 2] = mean; stats[q * 2 + 1] = rsqrtf(var + 1e-5f); } } }
        __syncthreads();
        u32x4 vreg[4]; float4 wreg[8];
#define GATE_LOAD(g) do { _Pragma("unroll") for (int i = 0; i < 4; ++i) { const int idx = tid + i * NTHR; vreg[i] = *(const u32x4*)(proj + (size_t)(tok0 + (idx >> 4)) * 1024 + 512 + (g) * 128 + (idx & 15) * 8); } \
                          _Pragma("unroll") for (int i = 0; i < 8; ++i) { const int idx = tid + i * NTHR; wreg[i] = *(const float4*)(w_s + (size_t)((g) * 128 + (idx >> 5)) * 128 + (idx & 31) * 4); } } while (0)
        GATE_LOAD(0);
#pragma unroll
        for (int g = 0; g < 4; ++g) {
#pragma unroll
            for (int i = 0; i < 4; ++i) { const int idx = tid + i * NTHR; const int q = idx >> 4, c0 = (idx & 15) * 8;
                const u32x4 v = vreg[i];
                const float mean = stats[q * 2], rstd = stats[q * 2 + 1];
                const float4 g0 = *(const float4*)(ln_g + g * 128 + c0), g1 = *(const float4*)(ln_g + g * 128 + c0 + 4);
                vT[(c0 + 0) * 136 + q] = f2bf((bflo(v.x) - mean) * rstd * g0.x); vT[(c0 + 1) * 136 + q] = f2bf((bfhi(v.x) - mean) * rstd * g0.y);
                vT[(c0 + 2) * 136 + q] = f2bf((bflo(v.y) - mean) * rstd * g0.z); vT[(c0 + 3) * 136 + q] = f2bf((bfhi(v.y) - mean) * rstd * g0.w);
                vT[(c0 + 4) * 136 + q] = f2bf((bflo(v.z) - mean) * rstd * g1.x); vT[(c0 + 5) * 136 + q] = f2bf((bfhi(v.z) - mean) * rstd * g1.y);
                vT[(c0 + 6) * 136 + q] = f2bf((bflo(v.w) - mean) * rstd * g1.z); vT[(c0 + 7) * 136 + q] = f2bf((bfhi(v.w) - mean) * rstd * g1.w); }
#pragma unroll
            for (int i = 0; i < 8; ++i) { const int idx = tid + i * NTHR; const int p = idx >> 5, q0 = (idx & 31) * 4;
                const float4 w = wreg[i];
                u32x2 o; o.x = cvt_pk_bf16(w.x, w.y); o.y = cvt_pk_bf16(w.z, w.w);
                *(LAS u32x2*)(wsb + p * 136 + q0) = o; }
            __syncthreads();
            if (g < 3) GATE_LOAD(g + 1);
            const int p = 16 * wave + fr; const size_t tok = (size_t)(tok0 + p); const float bias = b_s[g * 128 + p];
            u32x2 uu[8];
#pragma unroll
            for (int mi = 0; mi < 8; ++mi) uu[mi] = *(const u32x2*)(proj + tok * 1024 + g * 128 + 16 * mi + 4 * fq);
            f32x4 acc[8];
#pragma unroll
            for (int mi = 0; mi < 8; ++mi) acc[mi] = (f32x4){0.f, 0.f, 0.f, 0.f};
#pragma unroll
            for (int kk = 0; kk < 4; ++kk) {
                const bf16x8 bfrag = *(const LAS bf16x8*)(wsb + (16 * wave + fr) * 136 + 32 * kk + 8 * fq);
#pragma unroll
                for (int mi = 0; mi < 8; ++mi) { const bf16x8 afrag = *(const LAS bf16x8*)(vT + (16 * mi + fr) * 136 + 32 * kk + 8 * fq);
                    acc[mi] = __builtin_amdgcn_mfma_f32_16x16x32_bf16(afrag, bfrag, acc[mi], 0, 0, 0); }
            }
#pragma unroll
            for (int mi = 0; mi < 8; ++mi) { const int c = 16 * mi + 4 * fq;
                u32x2 o; o.x = cvt_pk_bf16(bflo(uu[mi].x) * (acc[mi][0] + bias), bfhi(uu[mi].x) * (acc[mi][1] + bias)); o.y = cvt_pk_bf16(bflo(uu[mi].y) * (acc[mi][2] + bias), bfhi(uu[mi].y) * (acc[mi][3] + bias));
                *(u32x2*)(ycat + tok * 1024 + g * 128 + c) = o; }
            __syncthreads();
        }
#undef GATE_LOAD
    }
}

constexpr int HZ_ROW = 4112;
constexpr int HZ_KR0 = NB * HZ_ROW;
constexpr int HZ_KRC = 8208;
static_assert(HZ_KR0 + 2 * HZ_KRC <= LDS_ST_OFF, "hyena LDS");

__device__ __forceinline__ void hy_load_kr(LAS uchar* lds, const u16* __restrict__ g) {
    const int tid = opaque_tid();
    const u32x4 w = *(const u32x4*)(g + tid * 8);
    const unsigned nxt = (tid < 511) ? (unsigned)g[tid * 8 + 8] : 0u;
    *(LAS u32x4*)(lds + HZ_KR0 + tid * 16) = w;
    u32x4 s; s.x = (w.x >> 16) | (w.y << 16); s.y = (w.y >> 16) | (w.z << 16); s.z = (w.z >> 16) | (w.w << 16); s.w = (w.w >> 16) | (nxt << 16);
    *(LAS u32x4*)(lds + HZ_KR0 + HZ_KRC + tid * 16) = s;
}
__device__ __forceinline__ void conv3_8(const u16* __restrict__ p, int s0, float w0, float w1, float w2, float (&o)[8]) {
    const u32x4 v = *(const u32x4*)(p + s0);
    const float prev = (s0 > 0) ? bf2f(p[s0 - 1]) : 0.f, next = (s0 + 8 < SEQ) ? bf2f(p[s0 + 8]) : 0.f;
    const float x0 = bflo(v.x), x1 = bfhi(v.x), x2 = bflo(v.y), x3 = bfhi(v.y), x4 = bflo(v.z), x5 = bfhi(v.z), x6 = bflo(v.w), x7 = bfhi(v.w);
    o[0] = w0 * prev + w1 * x0 + w2 * x1; o[1] = w0 * x0 + w1 * x1 + w2 * x2; o[2] = w0 * x1 + w1 * x2 + w2 * x3; o[3] = w0 * x2 + w1 * x3 + w2 * x4;
    o[4] = w0 * x3 + w1 * x4 + w2 * x5; o[5] = w0 * x4 + w1 * x5 + w2 * x6; o[6] = w0 * x5 + w1 * x6 + w2 * x7; o[7] = w0 * x6 + w1 * x7 + w2 * next;
}
__device__ void hyena_phase(LAS uchar* lds, const u16* __restrict__ pT  , const u16* __restrict__ G  , const float* __restrict__ conv_w  ,
                            const float* __restrict__ skip  , u16* __restrict__ yT  ) {
    const int tid = opaque_tid(), lane = tid & 63, wave = __builtin_amdgcn_readfirstlane(tid >> 6), r = lane & 31, h = lane >> 5;
    const int tbase = 256 * wave;
    const int e0 = 8 * h - r + 2048 - tbase, par = e0 & 1;
    const LAS uchar* abase = lds + HZ_KR0 + par * HZ_KRC + (e0 - par) * 2;
    const LAS uchar* bbase = lds + r * HZ_ROW + 16 * h;
    for (int c = blockIdx.x; c < 512; c += gridDim.x) {
        {
            const u16* src = pT + (size_t)c * NB * SEQ; const float w0 = conv_w[c], w1 = conv_w[1536 + c], w2 = conv_w[3072 + c];
#pragma unroll 8
            for (int it = 0; it < 16; ++it) { const int idx = tid + it * NTHR; const int b = idx >> 8, s0 = (idx & 255) * 8; float o[8];
                conv3_8(src + (size_t)b * SEQ, s0, w0, w1, w2, o);
                u32x4 w; w.x = cvt_pk_bf16(o[0], o[1]); w.y = cvt_pk_bf16(o[2], o[3]); w.z = cvt_pk_bf16(o[4], o[5]); w.w = cvt_pk_bf16(o[6], o[7]);
                *(LAS u32x4*)(lds + b * HZ_ROW + s0 * 2) = w; }
            hy_load_kr(lds, G + (size_t)c * 4096);
        }
        __syncthreads();
#pragma unroll 1
        for (int o = 0; o < 2; ++o) {
            f32x16 acc[8];
#pragma unroll
            for (int i = 0; i < 8; ++i)
#pragma unroll
                for (int k = 0; k < 16; ++k) acc[i][k] = 0.f;
#pragma unroll 1
            for (int p = 0; p < 2; ++p) {
                bf16x8 W[8];
#pragma unroll
                for (int k = 1; k < 8; ++k) { const LAS unsigned* ap = (const LAS unsigned*)(abase + (16 * p - 32 * k) * 2);
                    i32x4 av; av.x = (int)ap[0]; av.y = (int)ap[1]; av.z = (int)ap[2]; av.w = (int)ap[3]; W[8 - k] = __builtin_bit_cast(bf16x8, av); }
#pragma unroll 1
                for (int J = 0; J < 8; ++J) {
                    const LAS uchar* aj = abase + (16 * p + 256 * J) * 2;
                    const LAS uchar* bj = bbase + (16 * p + 256 * J) * 2;
#pragma unroll
                    for (int jj = 0; jj < 8; ++jj) {
                        const LAS unsigned* ap = (const LAS unsigned*)(aj + 64 * jj);
                        i32x4 av; av.x = (int)ap[0]; av.y = (int)ap[1]; av.z = (int)ap[2]; av.w = (int)ap[3]; W[jj] = __builtin_bit_cast(bf16x8, av);
                        const bf16x8 bb = *(const LAS bf16x8*)(bj + 64 * jj);
#pragma unroll
                        for (int i = 0; i < 8; ++i) acc[i] = __builtin_amdgcn_mfma_f32_32x32x16_bf16(W[(jj - i) & 7], bb, acc[i], 0, 0, 0);
                    }
                }
            }
            { const int cc = 512 * (o + 1) + c; const float w0 = conv_w[cc], w1 = conv_w[1536 + cc], w2 = conv_w[3072 + cc]; const float sk = skip[o * 512 + c];
              const u16* p0 = pT + ((size_t)cc * NB + r) * SEQ + tbase + 4 * h;
              const LAS uchar* z0 = lds + r * HZ_ROW + (tbase + 4 * h) * 2;
              const int tl = tbase + 4 * h;
#pragma unroll
              for (int i = 0; i < 8; ++i) {
                  if ((i & 3) == 0) __builtin_amdgcn_sched_barrier(0);
#pragma unroll
                  for (int q = 0; q < 4; ++q) { const int off = 32 * i + 8 * q;
                      const u32x2 zz = *(const LAS u32x2*)(z0 + off * 2);
                      const u32x2 gv = *(const u32x2*)(p0 + off);
                      const float um = bf2f(p0[off - 1]), up = bf2f(p0[off + 4]);
                      const float gm = (tl + off > 0) ? um : 0.f, gp = (tl + off + 4 < SEQ) ? up : 0.f;
                      const float g0 = bflo(gv.x), g1 = bfhi(gv.x), g2 = bflo(gv.y), g3 = bfhi(gv.y);
                      acc[i][4 * q + 0] = (w0 * gm + w1 * g0 + w2 * g1) * (acc[i][4 * q + 0] + sk * bflo(zz.x));
                      acc[i][4 * q + 1] = (w0 * g0 + w1 * g1 + w2 * g2) * (acc[i][4 * q + 1] + sk * bfhi(zz.x));
                      acc[i][4 * q + 2] = (w0 * g1 + w1 * g2 + w2 * g3) * (acc[i][4 * q + 2] + sk * bflo(zz.y));
                      acc[i][4 * q + 3] = (w0 * g2 + w1 * g3 + w2 * gp) * (acc[i][4 * q + 3] + sk * bfhi(zz.y)); } } }
            __syncthreads();
#pragma unroll
            for (int i = 0; i < 8; ++i)
#pragma unroll
                for (int q = 0; q < 4; ++q) {
                    u32x2 w; w.x = cvt_pk_bf16(acc[i][4 * q + 0], acc[i][4 * q + 1]); w.y = cvt_pk_bf16(acc[i][4 * q + 2], acc[i][4 * q + 3]);
                    *(LAS u32x2*)(lds + r * HZ_ROW + (tbase + 4 * h) * 2 + (32 * i + 8 * q) * 2) = w; }
            if (o == 0) hy_load_kr(lds, G + (size_t)(512 + c) * 4096);
            __syncthreads();
        }
        for (int idx = tid; idx < NB * 256; idx += NTHR) { const int b = idx >> 8, s0 = (idx & 255) * 8;
            *(u32x4*)(yT + ((size_t)c * NB + b) * SEQ + s0) = *(const LAS u32x4*)(lds + b * HZ_ROW + s0 * 2); }
        __syncthreads();
    }
}

__device__ __forceinline__ u32x4 pack8(const float (&o)[8]) { u32x4 w; w.x = cvt_pk_bf16(o[0], o[1]); w.y = cvt_pk_bf16(o[2], o[3]); w.z = cvt_pk_bf16(o[4], o[5]); w.w = cvt_pk_bf16(o[6], o[7]); return w; }
template <int W> __device__ __forceinline__ void pool_unit(const u16* __restrict__ seq  , int t0, u16* __restrict__ out  ) {
    constexpr int LEFT = W / 2, RIGHT = W - LEFT - 1, NR = 8 + W - 1;
    u32x4 rows[NR];
#pragma unroll
    for (int k = 0; k < NR; ++k) { const int p = t0 - LEFT + k; const int pc = min(max(p, 0), SEQ - 1);
        const u32x4 v = *(const u32x4*)(seq + (size_t)pc * 2048); const bool ok = (p >= 0 && p < SEQ);
        rows[k].x = ok ? v.x : 0u; rows[k].y = ok ? v.y : 0u; rows[k].z = ok ? v.z : 0u; rows[k].w = ok ? v.w : 0u; }
    float sm[8];
#pragma unroll
    for (int c = 0; c < 8; ++c) sm[c] = 0.f;
#pragma unroll
    for (int k = 0; k < W; ++k) { float f[8]; unpack8(rows[k], f);
#pragma unroll
        for (int c = 0; c < 8; ++c) sm[c] += f[c]; }
#pragma unroll
    for (int i = 0; i < 8; ++i) { const int t = t0 + i; const int lo = max(t - LEFT, 0), hi = min(t + RIGHT, SEQ - 1); const float inv = 1.0f / (float)(hi - lo + 1);
        float ctr[8], o[8]; unpack8(rows[i + LEFT], ctr);
#pragma unroll
        for (int c = 0; c < 8; ++c) o[c] = sm[c] * inv - ctr[c];
        *(u32x4*)(out + (size_t)t * 1024) = pack8(o);
        if (i < 7) { float fa[8], fs[8]; unpack8(rows[i + W], fa); unpack8(rows[i], fs);
#pragma unroll
            for (int c = 0; c < 8; ++c) sm[c] += fa[c] - fs[c]; } }
}
__device__ __forceinline__ void dconv_unit(const u16* __restrict__ seq  , int t0, const float* __restrict__ dconv  , u16* __restrict__ out  ) {
    u32x4 cr[10], hr[10], br[8];
#pragma unroll
    for (int k = 0; k < 10; ++k) { const int p = t0 - 1 + k; const int pc = min(max(p, 0), SEQ - 1);
        const u32x4 v = *(const u32x4*)(seq + (size_t)pc * 2048 + 1024); hr[k] = *(const u32x4*)(seq + (size_t)pc * 2048 + 1536); const bool ok = (p >= 0 && p < SEQ);
        cr[k].x = ok ? v.x : 0u; cr[k].y = ok ? v.y : 0u; cr[k].z = ok ? v.z : 0u; cr[k].w = ok ? v.w : 0u; }
#pragma unroll
    for (int i = 0; i < 8; ++i) br[i] = *(const u32x4*)(seq + (size_t)(t0 + i) * 2048 + 512);
    float w0[8], w1[8], w2[8];
    { const float4 a0 = *(const float4*)(dconv), a1 = *(const float4*)(dconv + 4), b0 = *(const float4*)(dconv + 512), b1 = *(const float4*)(dconv + 516), c0 = *(const float4*)(dconv + 1024), c1 = *(const float4*)(dconv + 1028);
      w0[0] = a0.x; w0[1] = a0.y; w0[2] = a0.z; w0[3] = a0.w; w0[4] = a1.x; w0[5] = a1.y; w0[6] = a1.z; w0[7] = a1.w;
      w1[0] = b0.x; w1[1] = b0.y; w1[2] = b0.z; w1[3] = b0.w; w1[4] = b1.x; w1[5] = b1.y; w1[6] = b1.z; w1[7] = b1.w;
      w2[0] = c0.x; w2[1] = c0.y; w2[2] = c0.z; w2[3] = c0.w; w2[4] = c1.x; w2[5] = c1.y; w2[6] = c1.z; w2[7] = c1.w; }
    float pm[8], pc_[8], pn[8];
    { float c[8], h[8]; unpack8(cr[0], c); unpack8(hr[0], h);
#pragma unroll
      for (int k = 0; k < 8; ++k) pm[k] = c[k] * h[k];
      unpack8(cr[1], c); unpack8(hr[1], h);
#pragma unroll
      for (int k = 0; k < 8; ++k) pc_[k] = c[k] * h[k]; }
#pragma unroll
    for (int i = 0; i < 8; ++i) { float c[8], h[8], bb[8], o[8]; unpack8(cr[i + 2], c); unpack8(hr[i + 2], h); unpack8(br[i], bb);
#pragma unroll
        for (int k = 0; k < 8; ++k) { pn[k] = c[k] * h[k]; o[k] = bb[k] * (w0[k] * pm[k] + w1[k] * pc_[k] + w2[k] * pn[k]); pm[k] = pc_[k]; pc_[k] = pn[k]; }
        *(u32x4*)(out + (size_t)(t0 + i) * 1024) = pack8(o); }
}
__device__ void stencil_phase(const u16* __restrict__ proj  , const float* __restrict__ dconv  , u16* __restrict__ ycat  ) {
    const int tid = opaque_tid(), lane = tid & 63, wave = __builtin_amdgcn_readfirstlane(tid >> 6);
    const int chl = (lane & 15) * 8, run = lane >> 4;
    for (int wu = blockIdx.x * 8 + wave; wu < (T_ / 32) * 8; wu += gridDim.x * 8) {
        const int rq = wu >> 3, kind = wu & 7; const int tok0 = rq * 32 + run * 8; const int t0 = tok0 & (SEQ - 1); const size_t s0 = (size_t)(tok0 - t0);
        if (kind < 4) { const int ch0 = kind * 128 + chl; const u16* seq = proj + s0 * 2048 + ch0; u16* out = ycat + s0 * 1024 + ch0;
            if (kind == 0) pool_unit<2>(seq, t0, out); else if (kind == 1) pool_unit<4>(seq, t0, out); else if (kind == 2) pool_unit<8>(seq, t0, out); else pool_unit<16>(seq, t0, out);
        } else { const int ch0 = (kind - 4) * 128 + chl; dconv_unit(proj + s0 * 2048 + ch0, t0, dconv + ch0, ycat + s0 * 1024 + 512 + ch0); }
    }
}


#define XB_TMO      128
#define XB_XCNT(j)  (256  + 64 * (j))
#define XB_XSUB(j)  (1280 + 64 * (j))
#define XB_XGEN(j)  (2304 + 64 * (j))
#define XB_TOP      3328
#define XB_TOPGEN   3392
#define XCD_BAR_WORDS 3456
#define XB_SPIN_CAP (1u << 20)
__device__ __forceinline__ unsigned xb_ld(unsigned* p)              { return __hip_atomic_load(p, __ATOMIC_RELAXED, __HIP_MEMORY_SCOPE_AGENT); }
__device__ __forceinline__ unsigned xb_add(unsigned* p, unsigned v) { return __hip_atomic_fetch_add(p, v, __ATOMIC_RELAXED, __HIP_MEMORY_SCOPE_AGENT); }
__device__ __forceinline__ unsigned xb_xcc_id() { return (unsigned)__builtin_amdgcn_s_getreg((3 << 11) | 20) & 0xFu; }
#define XB_SPIN(cond, bar) do { unsigned _sp = 0; while (cond) { __builtin_amdgcn_s_sleep(1); \
    if ((++_sp & 255u) == 0u) { if (xb_ld(&(bar)[XB_TMO])) break; if (_sp > XB_SPIN_CAP) { atomicAdd(&(bar)[XB_TMO], 1u); break; } } } } while (0)
struct XcdBarrier { unsigned* bar; unsigned x; volatile LAS unsigned* st; };
__device__ __forceinline__ XcdBarrier xcd_barrier_post(unsigned* bar, volatile LAS unsigned* st) {
    XcdBarrier b; b.bar = bar; b.x = xb_xcc_id(); b.st = st;
    if (threadIdx.x == 0) (void)xb_add(&bar[XB_XCNT(b.x)], 1u);
    return b;
}
__device__ __forceinline__ void xcd_barrier_complete(unsigned* bar, unsigned x, unsigned& nloc, unsigned& nx) {
    const unsigned G = gridDim.x * gridDim.y * gridDim.z;
    unsigned sum, cnt, mine, sp = 0u;
    for (;;) {
        sum = 0u; cnt = 0u; mine = 0u;
#pragma unroll
        for (unsigned j = 0; j < 16; ++j) { const unsigned c = xb_ld(&bar[XB_XCNT(j)]); sum += c; cnt += (c > 0u) ? 1u : 0u; mine = (j == x) ? c : mine; }
        if (sum == G) break;
        __builtin_amdgcn_s_sleep(1);
        if ((++sp & 255u) == 0u) { if (xb_ld(&bar[XB_TMO])) break; if (sp > XB_SPIN_CAP) { atomicAdd(&bar[XB_TMO], 1u); break; } }
    }
    nloc = mine > 0u ? mine : 1u; nx = cnt > 0u ? cnt : 1u;
}
__device__ __forceinline__ void xcd_barrier(const XcdBarrier& b) {
    asm volatile("s_waitcnt vmcnt(0)" ::: "memory");
    __syncthreads();
    if (threadIdx.x == 0) {
        unsigned* bar = b.bar;
        __builtin_amdgcn_s_waitcnt(0);
        unsigned nloc = b.st[0], nx = b.st[1];
        if (nloc == 0u) { xcd_barrier_complete(bar, b.x, nloc, nx); b.st[0] = nloc; b.st[1] = nx; }
        const unsigned old = xb_add(&bar[XB_XSUB(b.x)], 1u);
        const unsigned gen = old / nloc;
        if (old + 1u == (gen + 1u) * nloc) {
            __builtin_amdgcn_fence(__ATOMIC_RELEASE, "agent");
            asm volatile("s_waitcnt vmcnt(0)" ::: "memory");
            const unsigned og = xb_add(&bar[XB_TOP], 1u);
            const unsigned tg = og / nx;
            if (og + 1u == (tg + 1u) * nx) xb_add(&bar[XB_TOPGEN], 1u);
            else XB_SPIN(xb_ld(&bar[XB_TOPGEN]) == tg, bar);
            __builtin_amdgcn_fence(__ATOMIC_ACQUIRE, "agent");
            xb_add(&bar[XB_XGEN(b.x)], 1u);
            asm volatile("s_waitcnt vmcnt(0)" ::: "memory");
        } else {
            XB_SPIN(xb_ld(&bar[XB_XGEN(b.x)]) == gen, bar);
            __builtin_amdgcn_fence(__ATOMIC_ACQUIRE, "agent");
            asm volatile("s_waitcnt vmcnt(0)" ::: "memory");
        }
    }
    __syncthreads();
}

constexpr int NPH = 1 + 2 * 8 + 2 * 7;
struct Args { const float* in[23]; float* out; uchar* ws; int lo, hi; };

__global__ void __launch_bounds__(NTHR, 2) fwd_kernel(Args a) {
    extern __shared__ __attribute__((aligned(16))) uchar lds_raw[];
    LAS uchar* lds = (LAS uchar*)lds_raw;
    cg::grid_group grid = cg::this_grid();
    const int lo = a.lo, hi = a.hi; int ph = 0;
    volatile LAS unsigned* xst = (volatile LAS unsigned*)(lds + LDS_ST_OFF);
    if (threadIdx.x == 0) { xst[0] = 0u; xst[1] = 0u; }
    __syncthreads();
    XcdBarrier xb = xcd_barrier_post((unsigned*)(a.ws + WS_BAR), xst);
#define PH_BEGIN if (ph >= lo && ph < hi) {
#define PH_END } if (ph >= lo && ph + 1 < hi) { if (lo < 0) grid.sync();   xcd_barrier(xb); if (DBL(11) == 2) { xcd_barrier(xb); xcd_barrier(xb); } } ++ph;
    uchar* ws = a.ws;
    u16* Wabin = (u16*)(ws + WS_ABIN); u16* Wabout = (u16*)(ws + WS_ABOUT); u16* Wcdin = (u16*)(ws + WS_CDIN); u16* Wcdout = (u16*)(ws + WS_CDOUT);
    u16* Wgu = (u16*)(ws + WS_GU); u16* Wdown = (u16*)(ws + WS_DOWN); u16* Gf = (u16*)(ws + WS_G);
    u16* H = (u16*)(ws + WS_H); u16* PROJ = (u16*)(ws + WS_B); u16* YT = (u16*)(ws + WS_B + (size_t)T_ * 1024 * 2);     u16* ACT = (u16*)(ws + WS_B); u16* PT = (u16*)(ws + WS_C);
    u16* YCAT = (u16*)(ws + WS_D); u16* MIX = (u16*)(ws + WS_E); float* RSTD = (float*)(ws + WS_RSTD);
    const float* x_in = a.in[0]; const float* norm_g = a.in[1]; float* X = a.out;

    PH_BEGIN
      for (int rep = 0; rep < DBL(0); ++rep) {
        int rot = 0;
        filter_job(lds, a.in[10], a.in[11], a.in[12], a.in[13], a.in[14], a.in[15], a.in[16], Gf);
        for (int j = 0; j < 2; ++j) {
            wt_job(lds, a.in[4] + (size_t)j * 1024 * 2560, 2560, 1024, 2560, Wabin + (size_t)j * 2560 * 1024, 1024, 0, norm_g + (size_t)(2 * j) * 4 * 1024, rot);
            wt_job(lds, a.in[5] + (size_t)j * 1024 * 1024, 1024, 1024, 1024, Wabout + (size_t)j * 1024 * 1024, 1024, 0, nullptr, rot);
            wt_job(lds, a.in[18] + (size_t)j * 1024 * 2048, 2048, 1024, 2048, Wcdin + (size_t)j * 2048 * 1024, 1024, 0, norm_g + (size_t)(2 * j + 1) * 4 * 1024, rot);
            wt_job(lds, a.in[19] + (size_t)j * 1024 * 1024 + 512 * 1024, 1024, 512, 1024, Wcdout + (size_t)j * 1024 * 1024 + 512, 1024, 0, nullptr, rot);
            fold_job(a.in[20] + (size_t)j * 4 * 128 * 128, a.in[21] + j * 512, a.in[19] + (size_t)j * 1024 * 1024, Wcdout + (size_t)j * 1024 * 1024);
        }
        for (int i = 0; i < 4; ++i) {
            wt_job(lds, a.in[2] + (size_t)i * 1024 * 5632, 5632, 1024, 5632, Wgu + (size_t)i * 5632 * 1024, 1024, 1, norm_g + (size_t)(i * 4 + 2) * 1024, rot);
            wt_job(lds, a.in[3] + (size_t)i * 2816 * 1024, 1024, 2816, 1024, Wdown + (size_t)i * 1024 * 2816, 2816, 0, nullptr, rot);
        }
      }
        resid_pass(x_in, H, nullptr, nullptr, RSTD, nullptr);
    PH_END

#pragma unroll 1
    for (int i = 0; i < 4; ++i) {
        const int j = i >> 1; const bool even = (i & 1) == 0;
        const float* g4 = norm_g + (size_t)i * 4 * 1024;
        PH_BEGIN
            { const int N = even ? 1024 : 2048;
              pg8::Gemm g{H, even ? Wabin + (size_t)j * 2560 * 1024 : Wcdin + (size_t)j * 2048 * 1024, T_, N, 1024};
              pg8::StaticOrder S; S.init(T_, N, (int)gridDim.x, (int)blockIdx.x);
              pg8::EpiBf16G E{PROJ, N, even ? 4 : 0, RSTD};
#ifndef SKIP_G1
              for (int rep = 0; rep < DBL(6); ++rep) pg8::gemm_phase<pg8::EpiBf16G, pg8::StaticOrder, false>(lds, g, S, E, nullptr);
#endif
            }
            if (even) {
              pg8::Gemm g{H, Wabin + (size_t)j * 2560 * 1024 + (size_t)1024 * 1024, T_, 1536, 1024};
              pg8::StaticOrder S; S.init(T_, 1536, (int)gridDim.x, (int)blockIdx.x);
              pg8::EpiPT E{PT, RSTD};
              pg8::gemm_phase<pg8::EpiPT, pg8::StaticOrder, false>(lds, g, S, E, nullptr);
            }
        PH_END
        if (even) {
            PH_BEGIN
                for (int rep = 0; rep < DBL(1); ++rep) gating_phase(lds, PROJ, a.in[6] + j * 512, a.in[7] + (size_t)j * 4 * 128 * 128, a.in[8] + j * 512, YCAT);
                for (int rep = 0; rep < DBL(3); ++rep) hyena_phase(lds, PT, Gf + (size_t)j * 2 * 512 * 4096, a.in[9] + (size_t)j * 3 * 1536, a.in[17] + j * 1024, YT);
            PH_END
            PH_BEGIN
                for (int rep = 0; rep < DBL(4); ++rep) transpose_back_phase(lds, YT, YCAT);
            PH_END
        } else {
            PH_BEGIN
                for (int rep = 0; rep < DBL(5); ++rep) stencil_phase(PROJ, a.in[22] + (size_t)j * 3 * 512, YCAT);
            PH_END
        }
        PH_BEGIN
            pg8::Gemm g{YCAT, even ? Wabout + (size_t)j * 1024 * 1024 : Wcdout + (size_t)j * 1024 * 1024, T_, 1024, 1024};
            pg8::StaticOrder S; S.init(T_, 1024, (int)gridDim.x, (int)blockIdx.x);
            pg8::EpiBf16G E{MIX, 1024, 0, nullptr};

#ifndef SKIP_G2
            for (int rep = 0; rep < DBL(7); ++rep) pg8::gemm_phase<pg8::EpiBf16G, pg8::StaticOrder, false>(lds, g, S, E, nullptr);
#endif
        PH_END
        PH_BEGIN
            if (DBL(10) == 2) resid_pass(nullptr, (u16*)(ws + WS_C), MIX, g4 + 1024, (float*)(ws + WS_B), nullptr);
            resid_pass(nullptr, H, MIX, g4 + 1024, RSTD, nullptr);
        PH_END
        PH_BEGIN
            pg8::Gemm g{H, Wgu + (size_t)i * 5632 * 1024, T_, 5632, 1024};
            pg8::StaticOrder S; S.init(T_, 5632, (int)gridDim.x, (int)blockIdx.x);
            pg8::EpiSwiGLU E{ACT, DFF, RSTD};

#ifndef SKIP_G3
            for (int rep = 0; rep < DBL(8); ++rep) pg8::gemm_phase<pg8::EpiSwiGLU, pg8::StaticOrder, false>(lds, g, S, E, nullptr);
#endif
        PH_END
        PH_BEGIN
            pg8::Gemm g{ACT, Wdown + (size_t)i * 1024 * 2816, T_, 1024, DFF};
            pg8::StaticOrder S; S.init(T_, 1024, (int)gridDim.x, (int)blockIdx.x);
            pg8::EpiBf16G E{MIX, 1024, 0, nullptr};

#ifndef SKIP_G4
            for (int rep = 0; rep < DBL(9); ++rep) pg8::gemm_phase<pg8::EpiBf16G, pg8::StaticOrder, false>(lds, g, S, E, nullptr);
#endif
        PH_END
        PH_BEGIN
            if (DBL(10) == 2) resid_pass(nullptr, (u16*)(ws + WS_C), MIX, g4 + 3072, (float*)(ws + WS_B), nullptr);
            resid_pass(nullptr, H, MIX, g4 + 3072, RSTD, (i == 3) ? X : nullptr);
        PH_END
    }
#undef PH_BEGIN
#undef PH_END
}

extern "C" void kernel_launch(void* const* d_in, const int* in_sizes, int n_in, void* d_out, int out_size, void* d_ws, size_t ws_size, hipStream_t stream) {
    static int grid = 0;
    if (grid == 0) {
        if (n_in != 23 || out_size != T_ * DM || ws_size < WS_END) { fprintf(stderr, "kernel_launch: unexpected problem (n_in %d out %d ws %zu)\n", n_in, out_size, ws_size); grid = -1; return; }
        int dev = 0, cus = 0, per_cu = 0;
        (void)hipGetDevice(&dev); (void)hipDeviceGetAttribute(&cus, hipDeviceAttributeMultiprocessorCount, dev);
        if (hipFuncSetAttribute((const void*)fwd_kernel, hipFuncAttributeMaxDynamicSharedMemorySize, LDS_BYTES) != hipSuccess) { fprintf(stderr, "kernel_launch: hipFuncSetAttribute failed\n"); grid = -1; return; }
        if (hipOccupancyMaxActiveBlocksPerMultiprocessor(&per_cu, (const void*)fwd_kernel, NTHR, LDS_BYTES) != hipSuccess || per_cu < 1) { fprintf(stderr, "kernel_launch: occupancy query gave %d\n", per_cu); per_cu = 1; }
        (void)hipGetLastError();
        grid = cus * per_cu;
        fprintf(stderr, "kernel_launch: grid %d (cus %d x %d)\n", grid, cus, per_cu);
    }
    if (grid < 0) return;
    Args a{};
    for (int i = 0; i < 23; ++i) a.in[i] = (const float*)d_in[i];
    a.out = (float*)d_out; a.ws = (uchar*)d_ws;
#if ONE_LAUNCH
    (void)hipMemsetAsync((char*)d_ws + WS_BAR, 0, XCD_BAR_WORDS * 4, stream);
    a.lo = 0; a.hi = NPH;
    void* args[] = {&a};
    hipError_t e = hipLaunchCooperativeKernel((const void*)fwd_kernel, dim3(grid), dim3(NTHR), args, LDS_BYTES, stream);
    if (e != hipSuccess) fprintf(stderr, "kernel_launch: cooperative launch failed: %s (grid %d)\n", hipGetErrorString(e), grid);
#else
    for (int p = 0; p < NPH; ++p) { a.lo = p; a.hi = p + 1;
        hipLaunchKernelGGL(fwd_kernel, dim3(grid), dim3(NTHR), LDS_BYTES, stream, a); }
#endif
}
```

```cpp
#include <hip/hip_runtime.h>
#include <hip/hip_cooperative_groups.h>
#include <cstdio>
namespace cg = cooperative_groups;

#ifndef ONE_LAUNCH
#define ONE_LAUNCH 1
#endif
#ifndef DBL_MASK
#define DBL_MASK 0
#endif
#define DBL(bit) (((DBL_MASK >> (bit)) & 1) ? 2 : 1)

__device__ __forceinline__ int opaque_tid() { int t = (int)threadIdx.x; asm volatile("" : "+v"(t)); return t; }
namespace pg8 {
#define PG8_LAS __attribute__((address_space(3)))
typedef unsigned short bf16_t;
typedef short bf16x8 __attribute__((ext_vector_type(8)));
typedef float f32x4 __attribute__((ext_vector_type(4)));
typedef unsigned u32x4 __attribute__((ext_vector_type(4)));
constexpr int RS_LDS_OFF = 132096;
constexpr int EPI_LDS_OFF = 134144, EPI_LDS_WAVE = 2304;
constexpr int BM = 256, BK = 64, HALF = 128, HTB = HALF * BK * 2  , STAGE_BYTES = 8 * HTB, NXCD = 8, WGM = 8;

__host__ __device__ __forceinline__ int lds_byte(int r, int c) { const int st = (r >> 4) * 2 + (c >> 5), rr = r & 15, cc = c & 31, ob = rr * 64 + cc * 2; return st * 1024 + (ob ^ (((ob >> 9) & 1) << 5)); }
__host__ __device__ __forceinline__ void stage_rc(int b, int& R, int& C) { const int st = b / 1024, sb = b % 1024, swz = sb ^ (((sb >> 9) & 1) << 5); R = (st >> 1) * 16 + swz / 64; C = (st & 1) * 32 + (swz % 64) / 2; }
__host__ __device__ __forceinline__ int perm32(int rho) { const int n = rho >> 4, i = rho & 15; return 8 * (i >> 2) + 4 * n + (i & 3); }
struct Unit { int pm, pn; };
struct Gemm { const bf16_t* A; const bf16_t* Bt; int M, N, K; };

struct StaticOrder {
    int nM, nN, nwg, G, c;
    __host__ __device__ void init(int M, int N, int G_, int c_) { nM = M / BM; nN = N / BM; nwg = nM * nN; G = G_; c = c_; }
    __host__ __device__ bool next(int i, Unit& u) const {
        const long L = (long)i * G + c; if (L >= nwg) return false;
        int wgid = (int)L; { const int q = nwg / NXCD, r = nwg % NXCD, xcd = wgid % NXCD, off = wgid / NXCD; wgid = (xcd < r ? xcd * (q + 1) : r * (q + 1) + (xcd - r) * q) + off; }
        const int nig = WGM * nN, gid = wgid / nig, fm = gid * WGM, gsz = (nM - fm) < WGM ? (nM - fm) : WGM;
        u.pm = fm + ((wgid % nig) % gsz); u.pn = (wgid % nig) / gsz; return true;
    }
    __device__ __forceinline__ void a_ready(const Unit&) const {}
    __device__ __forceinline__ void done(const Unit&) const {}
};
__device__ __forceinline__ unsigned cvt_pk_bf16(float lo, float hi) { unsigned r; asm volatile("v_cvt_pk_bf16_f32 %0, %1, %2" : "=v"(r) : "v"(lo), "v"(hi)); return r; }

__device__ __forceinline__ float gelu_tanh_f(float x) { const float y = 1.5957691216f * (x + 0.044715f * x * x * x); return x * __builtin_amdgcn_rcpf(1.0f + __expf(-y)); }
__device__ __forceinline__ float silu_f(float x) { return x * __builtin_amdgcn_rcpf(1.0f + __expf(-x)); }

struct EpiBf16G {
    static constexpr bool PERM = true, AFTER_DRAIN = false, SWAP = false; static constexpr int NSTORES = 16;
    bf16_t* O; int ldc; int gelu_tiles; const float* rs;
    __device__ __forceinline__ void operator()(const f32x4 (&acc)[2][2][4][2], const Unit& u, int wr, int wc, int fr, int fq, const PG8_LAS float* rsl, PG8_LAS unsigned char* eslot) const {
        const int lane = fq * 16 + fr, lr = lane >> 2, lc = (lane & 3) * 8;
        const int rowb = u.pm * BM + wr * 64, colb = u.pn * BM + wc * 32;
        const bool act = u.pn < gelu_tiles;
#pragma unroll
        for (int ai = 0; ai < 2; ++ai)
#pragma unroll
            for (int m = 0; m < 4; ++m) {
                const float sc = rs ? rsl[wr * 64 + fr + ai * HALF + m * 16] : 1.0f;
#pragma unroll
                for (int bj = 0; bj < 2; ++bj) { f32x4 v0 = acc[ai][bj][m][0] * sc, v1 = acc[ai][bj][m][1] * sc;
                    if (act) {
#pragma unroll
                        for (int j = 0; j < 4; ++j) { v0[j] = gelu_tanh_f(v0[j]); v1[j] = gelu_tanh_f(v1[j]); } }
                    u32x4 w; w.x = cvt_pk_bf16(v0[0], v0[1]); w.y = cvt_pk_bf16(v0[2], v0[3]); w.z = cvt_pk_bf16(v1[0], v1[1]); w.w = cvt_pk_bf16(v1[2], v1[3]);
                    PG8_LAS unsigned char* sl = eslot;
                    *(PG8_LAS u32x4*)(sl + fr * 64 + fq * 16) = w;
                    const u32x4 w2 = *(const PG8_LAS u32x4*)(sl + lane * 16);
                    *(u32x4*)(O + (size_t)(rowb + ai * HALF + m * 16 + lr) * ldc + colb + bj * HALF + lc) = w2; } }
    }
};
struct EpiPT {
    static constexpr bool PERM = false, AFTER_DRAIN = false, SWAP = true; static constexpr int NSTORES = 16;
    bf16_t* O; const float* rs;
    __device__ __forceinline__ void operator()(const f32x4 (&acc)[2][2][4][2], const Unit& u, int wr, int wc, int fr, int fq, const PG8_LAS float* rsl, PG8_LAS unsigned char* eslot) const {
        typedef unsigned u32x2_t __attribute__((ext_vector_type(2)));
        const int lane = fq * 16 + fr;
        const int rowb = u.pm * BM + wr * 64; const int b = rowb >> 11, s0 = rowb & 2047;
#pragma unroll
        for (int ai = 0; ai < 2; ++ai)
#pragma unroll
            for (int bj = 0; bj < 2; ++bj)
#pragma unroll
                for (int n = 0; n < 2; ++n) { const int col0 = u.pn * BM + bj * HALF + wc * 32 + n * 16;
#pragma unroll
                    for (int m = 0; m < 4; ++m) { const f32x4 sc = *(const PG8_LAS f32x4*)(rsl + wr * 64 + 4 * fq + ai * HALF + m * 16);
                        const f32x4 v = acc[ai][bj][m][n] * sc;
                        u32x2_t w; w.x = cvt_pk_bf16(v[0], v[1]); w.y = cvt_pk_bf16(v[2], v[3]);
                        *(PG8_LAS u32x2_t*)(eslot + fr * 144 + (16 * m + 4 * fq) * 2) = w; }
#pragma unroll
                    for (int k = 0; k < 2; ++k) { const int c = lane + 64 * k, col = c >> 3, ch = c & 7;
                        const u32x4 w2 = *(const PG8_LAS u32x4*)(eslot + col * 144 + ch * 16);
                        *(u32x4*)(O + ((size_t)(col0 + col) * 32 + b) * 2048 + s0 + ai * HALF + ch * 8) = w2; } }
    }
};
struct EpiSwiGLU {
    static constexpr bool PERM = true, AFTER_DRAIN = false, SWAP = false; static constexpr int NSTORES = 8;
    bf16_t* O; int ldc; const float* rs;
    __device__ __forceinline__ void operator()(const f32x4 (&acc)[2][2][4][2], const Unit& u, int wr, int wc, int fr, int fq, const PG8_LAS float* rsl, PG8_LAS unsigned char* eslot) const {
        const int lane = fq * 16 + fr, lr = lane >> 2, lc = (lane & 3) * 8;
        const int rowb = u.pm * BM + wr * 64, colb = u.pn * HALF + wc * 32;
#pragma unroll
        for (int ai = 0; ai < 2; ++ai)
#pragma unroll
            for (int m = 0; m < 4; ++m) {
                const float sc = rsl[wr * 64 + fr + ai * HALF + m * 16];
                const f32x4 g0 = acc[ai][0][m][0] * sc, g1 = acc[ai][0][m][1] * sc, u0 = acc[ai][1][m][0] * sc, u1 = acc[ai][1][m][1] * sc;
                const f32x4 a0 = g0 * (-1.4426950408889634f), a1 = g1 * (-1.4426950408889634f);
                f32x4 e0, e1;
#pragma unroll
                for (int j = 0; j < 4; ++j) { e0[j] = __builtin_amdgcn_exp2f(a0[j]); e1[j] = __builtin_amdgcn_exp2f(a1[j]); }
                const f32x4 d0 = e0 + 1.0f, d1 = e1 + 1.0f;
                f32x4 r0, r1;
#pragma unroll
                for (int j = 0; j < 4; ++j) { r0[j] = __builtin_amdgcn_rcpf(d0[j]); r1[j] = __builtin_amdgcn_rcpf(d1[j]); }
                const f32x4 v0 = (g0 * u0) * r0, v1 = (g1 * u1) * r1;
                u32x4 w; w.x = cvt_pk_bf16(v0[0], v0[1]); w.y = cvt_pk_bf16(v0[2], v0[3]); w.z = cvt_pk_bf16(v1[0], v1[1]); w.w = cvt_pk_bf16(v1[2], v1[3]);
                PG8_LAS unsigned char* sl = eslot;
                *(PG8_LAS u32x4*)(sl + fr * 64 + fq * 16) = w;
                const u32x4 w2 = *(const PG8_LAS u32x4*)(sl + lane * 16);
                *(u32x4*)(O + (size_t)(rowb + ai * HALF + m * 16 + lr) * ldc + colb + lc) = w2; }
    }
};

template <class Epi, class Sched, bool STAMP = false>
__device__ __forceinline__ void gemm_phase(PG8_LAS unsigned char* lds, const Gemm g, const Sched& S, const Epi& E, unsigned long long* stamps) {
    const int tid = opaque_tid(), wid = __builtin_amdgcn_readfirstlane(tid >> 6), lane = tid & 63, wr = wid >> 2, wc = wid & 3, fr = lane & 15, fq = lane >> 4;
    const int K = g.K, nt = K / BK;
    int ts_lo = 0, ts_hi = 0, nts = 0; const unsigned long long rt_entry = STAMP ? (unsigned long long)wall_clock64() : 0ull;
#define PG8_STAMP() do { if (STAMP && wid == 0 && nts < 64) { const unsigned long long _c = (unsigned long long)clock64(); \
        ts_lo = (lane == nts) ? (int)(unsigned)_c : ts_lo; ts_hi = (lane == nts) ? (int)(unsigned)(_c >> 32) : ts_hi; ++nts; } } while (0)
    PG8_STAMP();
    unsigned voffA[2], voffB[2];
#pragma unroll
    for (int i = 0; i < 2; ++i) { int R, C; stage_rc(tid * 16 + i * 8192, R, C); const int Rb = Epi::PERM ? ((R & ~31) + perm32(R & 31)) : R;
        voffA[i] = (unsigned)(R * K + C) * 2u; voffB[i] = (unsigned)(Rb * K + C) * 2u; }
    const size_t kstep = (size_t)(BK * 2);
    const size_t hstep = (size_t)HALF * K * 2;
    const size_t tstep = 2 * hstep;
    const unsigned ldsw = (unsigned)wid * 1024u;
    const int aoff = lds_byte(wr * 64 + fr, fq * 8), boff = lds_byte(wc * 32 + fr, fq * 8);
#define PG8_SA(b, h) (((b) * 2 + (h)) * HTB)
#define PG8_SB(b, h) ((4 + (b) * 2 + (h)) * HTB)
#define PG8_STAGE(bufoff, gbase, voff) do { _Pragma("unroll") for (int _i = 0; _i < 2; ++_i) \
        __builtin_amdgcn_global_load_lds((const unsigned*)((const char*)(gbase) + (voff)[_i]), (PG8_LAS unsigned*)(lds + (bufoff) + ldsw + _i * 8192), 16, 0, 0); } while (0)
#define PG8_LDA(dst, b, h) do { _Pragma("unroll") for (int m = 0; m < 4; ++m) _Pragma("unroll") for (int k = 0; k < 2; ++k) dst[m][k] = *(const PG8_LAS bf16x8*)(lds + PG8_SA(b, h) + aoff + m * 2048 + k * 1024); } while (0)
#define PG8_LDB(dst, b, h) do { _Pragma("unroll") for (int n = 0; n < 2; ++n) _Pragma("unroll") for (int k = 0; k < 2; ++k) dst[n][k] = *(const PG8_LAS bf16x8*)(lds + PG8_SB(b, h) + boff + n * 2048 + k * 1024); } while (0)
#define PG8_MMA(ai, bj, At, Bt) do { __builtin_amdgcn_s_setprio(1); _Pragma("unroll") for (int m = 0; m < 4; ++m) _Pragma("unroll") for (int n = 0; n < 2; ++n) _Pragma("unroll") for (int k = 0; k < 2; ++k) \
        acc[ai][bj][m][n] = Epi::SWAP ? __builtin_amdgcn_mfma_f32_16x16x32_bf16(At[m][k], Bt[n][k], acc[ai][bj][m][n], 0, 0, 0) : __builtin_amdgcn_mfma_f32_16x16x32_bf16(Bt[n][k], At[m][k], acc[ai][bj][m][n], 0, 0, 0); __builtin_amdgcn_s_setprio(0); } while (0)
#define PG8_WAIT_V(n) asm volatile("s_waitcnt vmcnt(" #n ")" ::: "memory")
#define PG8_WAIT_L(n) asm volatile("s_waitcnt lgkmcnt(" #n ")" ::: "memory")
#define PG8_BAR __builtin_amdgcn_s_barrier()
#define PG8_SCHED __builtin_amdgcn_sched_barrier(0)
#define PG8_STAGE_RS(unit, buf) do { if (E.rs != nullptr && wid < 4) __builtin_amdgcn_global_load_lds((const unsigned*)(E.rs + (unit).pm * BM + wid * 64 + lane), (PG8_LAS unsigned*)(lds + RS_LDS_OFF + (buf) * 1024 + wid * 256), 4, 0, 0); } while (0)
    Unit cur, nxt; int ui = 0;
    if (!S.next(0, cur)) return;
    f32x4 acc[2][2][4][2];
#pragma unroll
    for (int a = 0; a < 2; ++a)
#pragma unroll
        for (int b = 0; b < 2; ++b)
#pragma unroll
            for (int m = 0; m < 4; ++m)
#pragma unroll
                for (int n = 0; n < 2; ++n) acc[a][b][m][n] = (f32x4){0.f, 0.f, 0.f, 0.f};
    bf16x8 At[4][2], B0[2][2], B1[2][2];
    const char* cA = (const char*)g.A + (size_t)cur.pm * tstep; const char* cB = (const char*)g.Bt + (size_t)cur.pn * tstep;
    S.a_ready(cur);
    PG8_STAGE_RS(cur, 0);
    PG8_STAGE(PG8_SB(0, 0), cB, voffB); PG8_STAGE(PG8_SA(0, 0), cA, voffA); PG8_STAGE(PG8_SB(0, 1), cB + hstep, voffB); PG8_STAGE(PG8_SA(0, 1), cA + hstep, voffA);
    if (wr == 1) PG8_BAR;
    PG8_WAIT_V(4); PG8_BAR;
    PG8_STAGE(PG8_SB(1, 0), cB + kstep, voffB); PG8_STAGE(PG8_SA(1, 0), cA + kstep, voffA); PG8_STAGE(PG8_SB(1, 1), cB + hstep + kstep, voffB); PG8_STAGE(PG8_SA(1, 1), cA + hstep + kstep, voffA);
    PG8_WAIT_V(8); PG8_BAR;
    PG8_STAMP();
    for (;;) {
        const bool has_next = S.next(ui + 1, nxt);
        const char* nA = has_next ? (const char*)g.A + (size_t)nxt.pm * tstep : cA; const char* nB = has_next ? (const char*)g.Bt + (size_t)nxt.pn * tstep : cB;
        for (int t = 0; t < nt; t += 2) {
            const bool last = (t == nt - 2);
            const char* a2 = last ? nA : cA + (size_t)(t + 2) * kstep; const char* b2 = last ? nB : cB + (size_t)(t + 2) * kstep;
            const char* a3 = a2 + kstep; const char* b3 = b2 + kstep;
            if (last && has_next) { S.a_ready(nxt); PG8_STAGE_RS(nxt, (ui + 1) & 1); }
            PG8_LDB(B0, 0, 0); PG8_SCHED; PG8_LDA(At, 0, 0);
            PG8_WAIT_L(8); PG8_BAR; PG8_WAIT_L(0); PG8_MMA(0, 0, At, B0); PG8_BAR; PG8_SCHED;
            PG8_LDB(B1, 0, 1); PG8_STAGE(PG8_SB(0, 0), b2, voffB);
            PG8_BAR; PG8_WAIT_L(0); PG8_MMA(0, 1, At, B1); PG8_BAR;
            PG8_LDA(At, 0, 1); PG8_STAGE(PG8_SA(0, 0), a2, voffA);
            PG8_BAR; PG8_WAIT_L(0); PG8_MMA(1, 0, At, B0); PG8_BAR; PG8_SCHED;
            PG8_STAGE(PG8_SB(0, 1), b2 + hstep, voffB);
            { const int relaxed = __builtin_amdgcn_readfirstlane((t == 0 && ui > 0) ? 1 : 0);
              asm volatile("s_cmp_lg_u32 %0, 0\n\ts_cbranch_scc1 .Lpg8rlx%=\n\ts_waitcnt vmcnt(6)\n\ts_branch .Lpg8end%=\n.Lpg8rlx%=:\n\ts_waitcnt vmcnt(%1)\n.Lpg8end%=:" :: "s"(relaxed), "n"(6 + Epi::NSTORES) : "memory", "scc"); }
            PG8_BAR; PG8_MMA(1, 1, At, B1); PG8_BAR;
            PG8_LDB(B0, 1, 0); PG8_SCHED; PG8_LDA(At, 1, 0); PG8_STAGE(PG8_SA(0, 1), a2 + hstep, voffA);
            PG8_WAIT_L(8); PG8_BAR; PG8_WAIT_L(0); PG8_MMA(0, 0, At, B0); PG8_BAR; PG8_SCHED;
            PG8_LDB(B1, 1, 1); PG8_STAGE(PG8_SB(1, 0), b3, voffB);
            PG8_BAR; PG8_WAIT_L(0); PG8_MMA(0, 1, At, B1); PG8_BAR;
            PG8_LDA(At, 1, 1); PG8_STAGE(PG8_SA(1, 0), a3, voffA);
            PG8_BAR; PG8_WAIT_L(0); PG8_MMA(1, 0, At, B0); PG8_BAR; PG8_SCHED;
            PG8_STAGE(PG8_SB(1, 1), b3 + hstep, voffB);
            PG8_WAIT_V(6); PG8_BAR; PG8_MMA(1, 1, At, B1); PG8_BAR;
            PG8_STAGE(PG8_SA(1, 1), a3 + hstep, voffA);
        }
        PG8_STAMP();
        if constexpr (!Epi::AFTER_DRAIN) { E(acc, cur, wr, wc, fr, fq, (const PG8_LAS float*)(lds + RS_LDS_OFF + (ui & 1) * 1024), lds + EPI_LDS_OFF + wid * EPI_LDS_WAVE); S.done(cur); }
        PG8_STAMP();
        if (!has_next) break;
#pragma unroll
        for (int a = 0; a < 2; ++a)
#pragma unroll
            for (int b = 0; b < 2; ++b)
#pragma unroll
                for (int m = 0; m < 4; ++m)
#pragma unroll
                    for (int n = 0; n < 2; ++n) acc[a][b][m][n] = (f32x4){0.f, 0.f, 0.f, 0.f};
        cur = nxt; cA = nA; cB = nB; ++ui;
    }
    PG8_WAIT_V(0);
    if (wr == 0) PG8_BAR;
    PG8_BAR;
    if constexpr (Epi::AFTER_DRAIN) { E.fused(acc, cur, wr, wc, fr, fq, lds, wid, lane); S.done(cur); }
    PG8_STAMP();
    if (STAMP && wid == 0) { stamps[lane] = lane < nts ? (((unsigned long long)(unsigned)ts_hi << 32) | (unsigned)ts_lo) : 0ull;
        if (lane == 62) stamps[62] = rt_entry; if (lane == 63) stamps[63] = (unsigned long long)wall_clock64(); }
#undef PG8_STAMP
#undef PG8_SA
#undef PG8_SB
#undef PG8_STAGE
#undef PG8_LDA
#undef PG8_LDB
#undef PG8_MMA
#undef PG8_WAIT_V
#undef PG8_WAIT_L
#undef PG8_BAR
#undef PG8_SCHED
#undef PG8_STAGE_RS
}
}

#define LAS PG8_LAS
typedef unsigned short u16;
typedef unsigned char uchar;
using pg8::bf16x8; using pg8::f32x4; using pg8::u32x4; using pg8::cvt_pk_bf16;
typedef float f32x16 __attribute__((ext_vector_type(16)));
typedef unsigned u32x2 __attribute__((ext_vector_type(2)));
typedef int i32x4 __attribute__((ext_vector_type(4)));

constexpr int T_ = 65536, DM = 1024, SEQ = 2048, NB = 32, DFF = 2816, NTHR = 512;
constexpr int LDS_ST_OFF = 155648;
constexpr int LDS_BYTES = LDS_ST_OFF + 16;
constexpr size_t SZ_ABIN = 2ull * 2560 * 1024 * 2, SZ_ABOUT = 2ull * 1024 * 1024 * 2, SZ_CDIN = 2ull * 2048 * 1024 * 2, SZ_CDOUT = 2ull * 1024 * 1024 * 2,
                 SZ_GU = 4ull * 5632 * 1024 * 2, SZ_DOWN = 4ull * 1024 * 2816 * 2, SZ_G = 2ull * 2 * 512 * 4096 * 2;
constexpr size_t WS_ABIN = 0, WS_ABOUT = WS_ABIN + SZ_ABIN, WS_CDIN = WS_ABOUT + SZ_ABOUT, WS_CDOUT = WS_CDIN + SZ_CDIN, WS_GU = WS_CDOUT + SZ_CDOUT, WS_DOWN = WS_GU + SZ_GU,
                 WS_G = WS_DOWN + SZ_DOWN,
                 WS_H = WS_G + SZ_G,
                 WS_B = WS_H + (size_t)T_ * 1024 * 2,
                 WS_C = WS_B + (size_t)T_ * 2560 * 2,
                 WS_D = WS_C + (size_t)1536 * 32 * 2048 * 2,
                 WS_E = WS_D + (size_t)T_ * 1024 * 2,
                 WS_BAR = WS_E + (size_t)T_ * 1024 * 2,
                 WS_RSTD = WS_BAR + 16384,
                 WS_END = WS_RSTD + (size_t)T_ * 4;
static_assert(WS_END <= (1ull << 30), "workspace map exceeds 1 GiB");
static_assert((size_t)T_ * DFF * 2 <= WS_D - WS_B, "act does not fit B + C");

__device__ __forceinline__ float bflo(unsigned w) { return __uint_as_float(w << 16); }
__device__ __forceinline__ float bfhi(unsigned w) { return __uint_as_float(w & 0xffff0000u); }
__device__ __forceinline__ float bf2f(u16 v) { return __uint_as_float(((unsigned)v) << 16); }
__device__ __forceinline__ u16 f2bf(float f) { return (u16)(cvt_pk_bf16(f, 0.f) & 0xffffu); }
__device__ __forceinline__ float wave_sum(float v) {
#pragma unroll
    for (int o = 32; o >= 1; o >>= 1) v += __shfl_xor(v, o, 64);
    return v;
}

__device__ void wt_job(LAS uchar* lds, const float* __restrict__ W, int ldw, int K, int N, u16* __restrict__ out, int ldo, int mode, const float* __restrict__ gain, int& rot) {
    LAS float* tile = (LAS float*)lds;
    const int tid = opaque_tid(); const int nkq = K / 256, nnt = N / 64, nsteps = nkq * nnt;
    const int G = (int)gridDim.x; const int first = ((int)blockIdx.x + G - (rot % G)) % G; rot += nsteps;
    for (int ti = first; ti < nsteps; ti += G) {
        const int kq = ti % nkq, nt = ti / nkq; const int k0 = kq * 256, n0 = nt * 64;
        int sc0 = n0; if (mode == 1) { const int pn = n0 >> 8, r = n0 & 255; sc0 = (r < 128) ? (pn * 128 + r) : (DFF + pn * 128 + (r - 128)); }
        float4 v[8];
#pragma unroll
        for (int i = 0; i < 8; ++i) { const int idx = tid + i * 512; const int kk = idx >> 4, c4 = (idx & 15) * 4;
            v[i] = *(const float4*)(W + (size_t)(k0 + kk) * ldw + sc0 + c4); }
#pragma unroll
        for (int i = 0; i < 8; ++i) { const int idx = tid + i * 512; const int kk = idx >> 4, c4 = (idx & 15) * 4;
            const float gk = gain ? gain[k0 + kk] : 1.0f;
            tile[kk * 65 + c4 + 0] = v[i].x * gk; tile[kk * 65 + c4 + 1] = v[i].y * gk; tile[kk * 65 + c4 + 2] = v[i].z * gk; tile[kk * 65 + c4 + 3] = v[i].w * gk; }
        __syncthreads();
#pragma unroll
        for (int q = 0; q < 4; ++q) { const int nn = tid >> 3, kc = q * 64 + (tid & 7) * 8;
          float f0 = tile[(kc + 0) * 65 + nn], f1 = tile[(kc + 1) * 65 + nn], f2 = tile[(kc + 2) * 65 + nn], f3 = tile[(kc + 3) * 65 + nn];
          float f4 = tile[(kc + 4) * 65 + nn], f5 = tile[(kc + 5) * 65 + nn], f6 = tile[(kc + 6) * 65 + nn], f7 = tile[(kc + 7) * 65 + nn];
          u32x4 w; w.x = cvt_pk_bf16(f0, f1); w.y = cvt_pk_bf16(f2, f3); w.z = cvt_pk_bf16(f4, f5); w.w = cvt_pk_bf16(f6, f7);
          *(u32x4*)(out + (size_t)(n0 + nn) * ldo + k0 + kc) = w; }
        __syncthreads();
    }
}
__device__ void fold_job(const float* __restrict__ cw, const float* __restrict__ scale, const float* __restrict__ Wout, u16* __restrict__ out) {
    for (int idx = blockIdx.x * NTHR + opaque_tid(); idx < 512 * 128; idx += gridDim.x * NTHR) {
        const int k = idx >> 7, n0 = (idx & 127) * 8; const int g = k >> 7;
        const float* cwr = cw + (size_t)k * 128; const float* sc = scale + g * 128; const float* wr = Wout + (size_t)(g * 128) * 1024 + n0;
        float acc[8];
#pragma unroll
        for (int u = 0; u < 8; ++u) acc[u] = 0.f;
#pragma unroll 8
        for (int c2 = 0; c2 < 128; ++c2) { const float cf = cwr[c2] * sc[c2]; const float4 w0 = *(const float4*)(wr + (size_t)c2 * 1024), w1 = *(const float4*)(wr + (size_t)c2 * 1024 + 4);
            acc[0] += cf * w0.x; acc[1] += cf * w0.y; acc[2] += cf * w0.z; acc[3] += cf * w0.w; acc[4] += cf * w1.x; acc[5] += cf * w1.y; acc[6] += cf * w1.z; acc[7] += cf * w1.w; }
#pragma unroll
        for (int u = 0; u < 8; ++u) out[(size_t)(n0 + u) * 1024 + k] = f2bf(acc[u]);
    }
}
__device__ void filter_job(LAS uchar* lds, const float* __restrict__ w1a, const float* __restrict__ b1a, const float* __restrict__ freqa, const float* __restrict__ w2a,
                           const float* __restrict__ b2a, const float* __restrict__ w3a, const float* __restrict__ decaya, u16* __restrict__ Gall) {
    LAS float* h2 = (LAS float*)lds;
    LAS float* zf = h2 + 64 * 64;
    LAS float* h1 = zf + 64 * 33;
    LAS float* w3s = h2 + 64 * 64;
    const int tid = opaque_tid(), lane = tid & 63, wave = __builtin_amdgcn_readfirstlane(tid >> 6);
    for (int item = blockIdx.x; item < 256; item += gridDim.x) {
        const int j = item >> 7, tg = (item >> 2) & 31, cq = item & 3, t0 = tg * 64;
        const float* w1 = w1a + j * 33 * 64; const float* b1 = b1a + j * 64; const float* freq = freqa + j * 128; const float* w2 = w2a + j * 4096; const float* b2 = b2a + j * 64;
        const float* w3 = w3a + (size_t)j * 64 * 2048; const float* decay = decaya + j * 2048; u16* Gj = Gall + (size_t)j * 2 * 512 * 4096;
        float4 wpre[16];
#pragma unroll
        for (int i = 0; i < 16; ++i) { const int idx = tid + i * NTHR; wpre[i] = *(const float4*)(w3 + (size_t)(idx >> 7) * 2048 + cq * 512 + (idx & 127) * 4); }
        for (int idx = tid; idx < 64 * 33; idx += NTHR) { const int tt = idx / 33, f = idx - tt * 33; const float t = (float)(t0 + tt);
            float val;
            if (f == 0) val = t / 2047.0f;
            else { const int fi = (f - 1) & 15; const float band = 1e-4f + (float)fi * ((15.0f - 1e-4f) / 15.0f); const float w = 6.283185307179586f * t / 2048.0f; const float fw = w * band;
                   val = (f <= 16) ? cosf(fw) : -sinf(fw); }
            zf[idx] = val; }
        __syncthreads();
        for (int idx = tid; idx < 4096; idx += NTHR) { const int tt = idx >> 6, k = idx & 63; float acc = 0.f;
            for (int f = 0; f < 33; ++f) acc += zf[tt * 33 + f] * w1[f * 64 + k];
            h1[tt * 64 + k] = sinf(freq[k] * (acc + b1[k])); }
        __syncthreads();
        for (int idx = tid; idx < 4096; idx += NTHR) { const int tt = idx >> 6, k = idx & 63; float acc = 0.f;
            for (int k2 = 0; k2 < 64; ++k2) acc += h1[tt * 64 + k2] * w2[k2 * 64 + k];
            h2[k * 64 + tt] = sinf(freq[64 + k] * (acc + b2[k])); }
        __syncthreads();
#pragma unroll
        for (int i = 0; i < 16; ++i) { const int idx = tid + i * NTHR; f32x4 wv; wv.x = wpre[i].x; wv.y = wpre[i].y; wv.z = wpre[i].z; wv.w = wpre[i].w; *(LAS f32x4*)(w3s + (idx >> 7) * 512 + (idx & 127) * 4) = wv; }
        __syncthreads();
        { const int t = t0 + lane; const float t01 = (float)t / 2047.0f;
          for (int ci = 0; ci < 64; ci += 4) { const int cl = wave * 64 + ci, col = cq * 512 + cl; float a0 = 0.f, a1 = 0.f, a2 = 0.f, a3 = 0.f;
#pragma unroll 16
              for (int k = 0; k < 64; ++k) { const f32x4 w = *(const LAS f32x4*)(w3s + k * 512 + cl); const float hv = h2[k * 64 + lane]; a0 += hv * w.x; a1 += hv * w.y; a2 += hv * w.z; a3 += hv * w.w; }
              const float4 dc = *(const float4*)(decay + col);
              a0 *= expf(-t01 * fabsf(dc.x)); a1 *= expf(-t01 * fabsf(dc.y)); a2 *= expf(-t01 * fabsf(dc.z)); a3 *= expf(-t01 * fabsf(dc.w));
              const int dir = col >> 10, o = (col >> 9) & 1, c = col & 511; u16* g = Gj + (size_t)(o * 512 + c) * 4096;
              if (dir == 0) { g[2048 - t] = f2bf(a0); g[4096 + 2048 - t] = f2bf(a1); g[8192 + 2048 - t] = f2bf(a2); g[12288 + 2048 - t] = f2bf(a3);
                              if (t == 0) { g[0] = 0; g[4096] = 0; g[8192] = 0; g[12288] = 0; } }
              else if (t <= 2046) { g[2049 + t] = f2bf(a0); g[4096 + 2049 + t] = f2bf(a1); g[8192 + 2049 + t] = f2bf(a2); g[12288 + 2049 + t] = f2bf(a3); } } }
        __syncthreads();
    }
}

__device__ __forceinline__ void unpack8(const u32x4 v, float (&f)[8]) { f[0] = bflo(v.x); f[1] = bfhi(v.x); f[2] = bflo(v.y); f[3] = bfhi(v.y); f[4] = bflo(v.z); f[5] = bfhi(v.z); f[6] = bflo(v.w); f[7] = bfhi(v.w); }
__device__ __forceinline__ float4 ntload4(const float* p) { const f32x4 v = __builtin_nontemporal_load((const f32x4*)p); float4 r; r.x = v.x; r.y = v.y; r.z = v.z; r.w = v.w; return r; }
__device__ __forceinline__ void ntstore4(float* p, float a, float b, float c, float d) { f32x4 w; w.x = a; w.y = b; w.z = c; w.w = d; __builtin_nontemporal_store(w, (f32x4*)p); }
__device__ __forceinline__ void resid_pass(const float* __restrict__ xin_f, u16* __restrict__ xb, const u16* __restrict__ mix, const float* __restrict__ gpost, float* __restrict__ rstd_out, float* __restrict__ out_f) {
    const int tid = opaque_tid(); const int lane = tid & 63, wave = tid >> 6;
    const int stride = gridDim.x * 8;
    constexpr int NR = 4;
    for (int row0 = blockIdx.x * 8 + wave; row0 < T_; row0 += NR * stride) {
        float x[NR][16];
        if (xin_f) {
#pragma unroll
            for (int k = 0; k < NR; ++k) { const int row = min(row0 + k * stride, T_ - 1);
#pragma unroll
                for (int c = 0; c < 2; ++c) { const float4 a0 = ntload4(xin_f + (size_t)row * 1024 + c * 512 + lane * 8), a1 = ntload4(xin_f + (size_t)row * 1024 + c * 512 + lane * 8 + 4);
                    x[k][c * 8 + 0] = a0.x; x[k][c * 8 + 1] = a0.y; x[k][c * 8 + 2] = a0.z; x[k][c * 8 + 3] = a0.w; x[k][c * 8 + 4] = a1.x; x[k][c * 8 + 5] = a1.y; x[k][c * 8 + 6] = a1.z; x[k][c * 8 + 7] = a1.w; } }
        } else {
            u32x4 xr[NR][2], mr[NR][2];
#pragma unroll
            for (int k = 0; k < NR; ++k) { const int row = min(row0 + k * stride, T_ - 1);
#pragma unroll
                for (int c = 0; c < 2; ++c) { xr[k][c] = *(const u32x4*)(xb + (size_t)row * 1024 + c * 512 + lane * 8); mr[k][c] = __builtin_nontemporal_load((const u32x4*)(mix + (size_t)row * 1024 + c * 512 + lane * 8)); } }
            float g[16];
#pragma unroll
            for (int c = 0; c < 2; ++c) { const float4 a0 = *(const float4*)(gpost + c * 512 + lane * 8), a1 = *(const float4*)(gpost + c * 512 + lane * 8 + 4);
                g[c * 8 + 0] = a0.x; g[c * 8 + 1] = a0.y; g[c * 8 + 2] = a0.z; g[c * 8 + 3] = a0.w; g[c * 8 + 4] = a1.x; g[c * 8 + 5] = a1.y; g[c * 8 + 6] = a1.z; g[c * 8 + 7] = a1.w; }
#pragma unroll
            for (int k = 0; k < NR; ++k) { float m[16]; float ss = 0.f;
#pragma unroll
                for (int c = 0; c < 2; ++c) { float t8[8]; unpack8(mr[k][c], t8);
#pragma unroll
                    for (int e = 0; e < 8; ++e) { m[c * 8 + e] = t8[e]; ss += t8[e] * t8[e]; } }
                ss = wave_sum(ss); const float rstd = rsqrtf(ss * (1.0f / 1024.0f) + 1e-6f);
#pragma unroll
                for (int c = 0; c < 2; ++c) { float t8[8]; unpack8(xr[k][c], t8);
#pragma unroll
                    for (int e = 0; e < 8; ++e) x[k][c * 8 + e] = t8[e] + m[c * 8 + e] * rstd * g[c * 8 + e]; } }
        }
#pragma unroll
        for (int k = 0; k < NR; ++k) { const int row = row0 + k * stride;
            if (row < T_) {
                if (out_f) {
#pragma unroll
                    for (int c = 0; c < 2; ++c) { ntstore4(out_f + (size_t)row * 1024 + c * 512 + lane * 8, x[k][c * 8 + 0], x[k][c * 8 + 1], x[k][c * 8 + 2], x[k][c * 8 + 3]);
                        ntstore4(out_f + (size_t)row * 1024 + c * 512 + lane * 8 + 4, x[k][c * 8 + 4], x[k][c * 8 + 5], x[k][c * 8 + 6], x[k][c * 8 + 7]); }
                } else {
                    float ss = 0.f;
#pragma unroll
                    for (int e = 0; e < 16; ++e) ss += x[k][e] * x[k][e];
                    ss = wave_sum(ss);
                    if (lane == 0) rstd_out[row] = rsqrtf(ss * (1.0f / 1024.0f) + 1e-6f);
#pragma unroll
                    for (int c = 0; c < 2; ++c) { u32x4 w; w.x = cvt_pk_bf16(x[k][c * 8 + 0], x[k][c * 8 + 1]); w.y = cvt_pk_bf16(x[k][c * 8 + 2], x[k][c * 8 + 3]); w.z = cvt_pk_bf16(x[k][c * 8 + 4], x[k][c * 8 + 5]); w.w = cvt_pk_bf16(x[k][c * 8 + 6], x[k][c * 8 + 7]);
                        *(u32x4*)(xb + (size_t)row * 1024 + c * 512 + lane * 8) = w; }
                }
            }
        }
    }
}

constexpr int TRS = 66;
__device__ __forceinline__ void tr_tile8(LAS u16* tiles  , const u16* __restrict__ src, size_t lds_src, size_t src_ts, u16* __restrict__ dst, size_t ldd, size_t dst_ts) {
    const int tid = opaque_tid(), r = tid >> 3, ch = (tid & 7) * 8;
    u32x4 v[8];
#pragma unroll
    for (int k = 0; k < 8; ++k) v[k] = *(const u32x4*)(src + k * src_ts + (size_t)r * lds_src + ch);
#pragma unroll
    for (int k = 0; k < 8; ++k) { LAS u16* tile = tiles + k * 64 * TRS;
        tile[(ch + 0) * TRS + r] = (u16)(v[k].x & 0xffffu); tile[(ch + 1) * TRS + r] = (u16)(v[k].x >> 16);
        tile[(ch + 2) * TRS + r] = (u16)(v[k].y & 0xffffu); tile[(ch + 3) * TRS + r] = (u16)(v[k].y >> 16);
        tile[(ch + 4) * TRS + r] = (u16)(v[k].z & 0xffffu); tile[(ch + 5) * TRS + r] = (u16)(v[k].z >> 16);
        tile[(ch + 6) * TRS + r] = (u16)(v[k].w & 0xffffu); tile[(ch + 7) * TRS + r] = (u16)(v[k].w >> 16); }
    __syncthreads();
#pragma unroll
    for (int k = 0; k < 8; ++k) { const LAS unsigned* p = (const LAS unsigned*)(tiles + k * 64 * TRS + r * TRS + ch);
        u32x4 o; o.x = p[0]; o.y = p[1]; o.z = p[2]; o.w = p[3];
        *(u32x4*)(dst + k * dst_ts + (size_t)r * ldd + ch) = o; }
    __syncthreads();
}
__device__ void transpose_fwd_phase(LAS uchar* lds, const u16* __restrict__ proj, u16* __restrict__ pT) {
    LAS u16* tiles = (LAS u16*)lds;
    for (int it = blockIdx.x; it < NB * 32 * 3; it += gridDim.x) {
        const int c8 = it % 3, st = (it / 3) & 31, b = it / 96;
        tr_tile8(tiles, proj + (size_t)(b * SEQ + st * 64) * 2560 + 1024 + c8 * 512, 2560, 64, pT + ((size_t)(c8 * 512) * NB + b) * SEQ + st * 64, (size_t)NB * SEQ, (size_t)64 * NB * SEQ);
    }
}
__device__ void transpose_back_phase(LAS uchar* lds, const u16* __restrict__ yT, u16* __restrict__ ycat) {
    LAS u16* tiles = (LAS u16*)lds;
    for (int it = blockIdx.x; it < NB * 32; it += gridDim.x) {
        const int st = it & 31, b = it >> 5;
        tr_tile8(tiles, yT + (size_t)b * SEQ + st * 64, (size_t)NB * SEQ, (size_t)64 * NB * SEQ, ycat + (size_t)(b * SEQ + st * 64) * 1024 + 512, 1024, 64);
    }
}
__device__ void gating_phase(LAS uchar* lds, const u16* __restrict__ proj  , const float* __restrict__ ln_g  ,
                             const float* __restrict__ w_s  , const float* __restrict__ b_s  , u16* __restrict__ ycat  ) {
    LAS u16* vT = (LAS u16*)lds;
    LAS u16* wsb = vT + 128 * 136;
    LAS float* stats = (LAS float*)(wsb + 128 * 136);
    const int tid = opaque_tid(), lane = tid & 63, wave = tid >> 6, fr = lane & 15, fq = lane >> 4;
    for (int item = blockIdx.x; item < T_ / 128; item += gridDim.x) {
        const int tok0 = item * 128;
        { u32x4 vv[16];
#pragma unroll
          for (int tt = 0; tt < 16; ++tt) vv[tt] = *(const u32x4*)(proj + (size_t)(tok0 + wave * 16 + tt) * 1024 + 512 + lane * 8);
#pragma unroll
          for (int tt = 0; tt < 16; ++tt) { const int q = wave * 16 + tt; const u32x4 v = vv[tt];
            const float f0 = bflo(v.x), f1 = bfhi(v.x), f2 = bflo(v.y), f3 = bfhi(v.y), f4 = bflo(v.z), f5 = bfhi(v.z), f6 = bflo(v.w), f7 = bfhi(v.w);
            const float mean = wave_sum(f0 + f1 + f2 + f3 + f4 + f5 + f6 + f7) * (1.0f / 512.0f);
            const float d0 = f0 - mean, d1 = f1 - mean, d2 = f2 - mean, d3 = f3 - mean, d4 = f4 - mean, d5 = f5 - mean, d6 = f6 - mean, d7 = f7 - mean;
            const float var = wave_sum(d0 * d0 + d1 * d1 + d2 * d2 + d3 * d3 + d4 * d4 + d5 * d5 + d6 * d6 + d7 * d7) * (1.0f / 512.0f);
            if (lane == 0) { stats[q * 2] = mean; stats[q * 2 + 1] = rsqrtf(var + 1e-5f); } } }
        __syncthreads();
        u32x4 vreg[4]; float4 wreg[8];
#define GATE_LOAD(g) do { _Pragma("unroll") for (int i = 0; i < 4; ++i) { const int idx = tid + i * NTHR; vreg[i] = *(const u32x4*)(proj + (size_t)(tok0 + (idx >> 4)) * 1024 + 512 + (g) * 128 + (idx & 15) * 8); } \
                          _Pragma("unroll") for (int i = 0; i < 8; ++i) { const int idx = tid + i * NTHR; wreg[i] = *(const float4*)(w_s + (size_t)((g) * 128 + (idx >> 5)) * 128 + (idx & 31) * 4); } } while (0)
        GATE_LOAD(0);
#pragma unroll
        for (int g = 0; g < 4; ++g) {
#pragma unroll
            for (int i = 0; i < 4; ++i) { const int idx = tid + i * NTHR; const int q = idx >> 4, c0 = (idx & 15) * 8;
                const u32x4 v = vreg[i];
                const float mean = stats[q * 2], rstd = stats[q * 2 + 1];
                const float4 g0 = *(const float4*)(ln_g + g * 128 + c0), g1 = *(const float4*)(ln_g + g * 128 + c0 + 4);
                vT[(c0 + 0) * 136 + q] = f2bf((bflo(v.x) - mean) * rstd * g0.x); vT[(c0 + 1) * 136 + q] = f2bf((bfhi(v.x) - mean) * rstd * g0.y);
                vT[(c0 + 2) * 136 + q] = f2bf((bflo(v.y) - mean) * rstd * g0.z); vT[(c0 + 3) * 136 + q] = f2bf((bfhi(v.y) - mean) * rstd * g0.w);
                vT[(c0 + 4) * 136 + q] = f2bf((bflo(v.z) - mean) * rstd * g1.x); vT[(c0 + 5) * 136 + q] = f2bf((bfhi(v.z) - mean) * rstd * g1.y);
                vT[(c0 + 6) * 136 + q] = f2bf((bflo(v.w) - mean) * rstd * g1.z); vT[(c0 + 7) * 136 + q] = f2bf((bfhi(v.w) - mean) * rstd * g1.w); }
#pragma unroll
            for (int i = 0; i < 8; ++i) { const int idx = tid + i * NTHR; const int p = idx >> 5, q0 = (idx & 31) * 4;
                const float4 w = wreg[i];
                u32x2 o; o.x = cvt_pk_bf16(w.x, w.y); o.y = cvt_pk_bf16(w.z, w.w);
                *(LAS u32x2*)(wsb + p * 136 + q0) = o; }
            __syncthreads();
            if (g < 3) GATE_LOAD(g + 1);
            const int p = 16 * wave + fr; const size_t tok = (size_t)(tok0 + p); const float bias = b_s[g * 128 + p];
            u32x2 uu[8];
#pragma unroll
            for (int mi = 0; mi < 8; ++mi) uu[mi] = *(const u32x2*)(proj + tok * 1024 + g * 128 + 16 * mi + 4 * fq);
            f32x4 acc[8];
#pragma unroll
            for (int mi = 0; mi < 8; ++mi) acc[mi] = (f32x4){0.f, 0.f, 0.f, 0.f};
#pragma unroll
            for (int kk = 0; kk < 4; ++kk) {
                const bf16x8 bfrag = *(const LAS bf16x8*)(wsb + (16 * wave + fr) * 136 + 32 * kk + 8 * fq);
#pragma unroll
                for (int mi = 0; mi < 8; ++mi) { const bf16x8 afrag = *(const LAS bf16x8*)(vT + (16 * mi + fr) * 136 + 32 * kk + 8 * fq);
                    acc[mi] = __builtin_amdgcn_mfma_f32_16x16x32_bf16(afrag, bfrag, acc[mi], 0, 0, 0); }
            }
#pragma unroll
            for (int mi = 0; mi < 8; ++mi) { const int c = 16 * mi + 4 * fq;
                u32x2 o; o.x = cvt_pk_bf16(bflo(uu[mi].x) * (acc[mi][0] + bias), bfhi(uu[mi].x) * (acc[mi][1] + bias)); o.y = cvt_pk_bf16(bflo(uu[mi].y) * (acc[mi][2] + bias), bfhi(uu[mi].y) * (acc[mi][3] + bias));
                *(u32x2*)(ycat + tok * 1024 + g * 128 + c) = o; }
            __syncthreads();
        }
#undef GATE_LOAD
    }
}

constexpr int HZ_ROW = 4112;
constexpr int HZ_KR0 = NB * HZ_ROW;
constexpr int HZ_KRC = 8208;
static_assert(HZ_KR0 + 2 * HZ_KRC <= LDS_ST_OFF, "hyena LDS");

__device__ __forceinline__ void hy_load_kr(LAS uchar* lds, const u16* __restrict__ g) {
    const int tid = opaque_tid();
    const u32x4 w = *(const u32x4*)(g + tid * 8);
    const unsigned nxt = (tid < 511) ? (unsigned)g[tid * 8 + 8] : 0u;
    *(LAS u32x4*)(lds + HZ_KR0 + tid * 16) = w;
    u32x4 s; s.x = (w.x >> 16) | (w.y << 16); s.y = (w.y >> 16) | (w.z << 16); s.z = (w.z >> 16) | (w.w << 16); s.w = (w.w >> 16) | (nxt << 16);
    *(LAS u32x4*)(lds + HZ_KR0 + HZ_KRC + tid * 16) = s;
}
__device__ __forceinline__ void conv3_8(const u16* __restrict__ p, int s0, float w0, float w1, float w2, float (&o)[8]) {
    const u32x4 v = *(const u32x4*)(p + s0);
    const float prev = (s0 > 0) ? bf2f(p[s0 - 1]) : 0.f, next = (s0 + 8 < SEQ) ? bf2f(p[s0 + 8]) : 0.f;
    const float x0 = bflo(v.x), x1 = bfhi(v.x), x2 = bflo(v.y), x3 = bfhi(v.y), x4 = bflo(v.z), x5 = bfhi(v.z), x6 = bflo(v.w), x7 = bfhi(v.w);
    o[0] = w0 * prev + w1 * x0 + w2 * x1; o[1] = w0 * x0 + w1 * x1 + w2 * x2; o[2] = w0 * x1 + w1 * x2 + w2 * x3; o[3] = w0 * x2 + w1 * x3 + w2 * x4;
    o[4] = w0 * x3 + w1 * x4 + w2 * x5; o[5] = w0 * x4 + w1 * x5 + w2 * x6; o[6] = w0 * x5 + w1 * x6 + w2 * x7; o[7] = w0 * x6 + w1 * x7 + w2 * next;
}
__device__ void hyena_phase(LAS uchar* lds, const u16* __restrict__ pT  , const u16* __restrict__ G  , const float* __restrict__ conv_w  ,
                            const float* __restrict__ skip  , u16* __restrict__ yT  ) {
    const int tid = opaque_tid(), lane = tid & 63, wave = __builtin_amdgcn_readfirstlane(tid >> 6), r = lane & 31, h = lane >> 5;
    const int tbase = 256 * wave;
    const int e0 = 8 * h - r + 2048 - tbase, par = e0 & 1;
    const LAS uchar* abase = lds + HZ_KR0 + par * HZ_KRC + (e0 - par) * 2;
    const LAS uchar* bbase = lds + r * HZ_ROW + 16 * h;
    for (int c = blockIdx.x; c < 512; c += gridDim.x) {
        {
            const u16* src = pT + (size_t)c * NB * SEQ; const float w0 = conv_w[c], w1 = conv_w[1536 + c], w2 = conv_w[3072 + c];
#pragma unroll 8
            for (int it = 0; it < 16; ++it) { const int idx = tid + it * NTHR; const int b = idx >> 8, s0 = (idx & 255) * 8; float o[8];
                conv3_8(src + (size_t)b * SEQ, s0, w0, w1, w2, o);
                u32x4 w; w.x = cvt_pk_bf16(o[0], o[1]); w.y = cvt_pk_bf16(o[2], o[3]); w.z = cvt_pk_bf16(o[4], o[5]); w.w = cvt_pk_bf16(o[6], o[7]);
                *(LAS u32x4*)(lds + b * HZ_ROW + s0 * 2) = w; }
            hy_load_kr(lds, G + (size_t)c * 4096);
        }
        __syncthreads();
#pragma unroll 1
        for (int o = 0; o < 2; ++o) {
            f32x16 acc[8];
#pragma unroll
            for (int i = 0; i < 8; ++i)
#pragma unroll
                for (int k = 0; k < 16; ++k) acc[i][k] = 0.f;
#pragma unroll 1
            for (int p = 0; p < 2; ++p) {
                bf16x8 W[8];
#pragma unroll
                for (int k = 1; k < 8; ++k) { const LAS unsigned* ap = (const LAS unsigned*)(abase + (16 * p - 32 * k) * 2);
                    i32x4 av; av.x = (int)ap[0]; av.y = (int)ap[1]; av.z = (int)ap[2]; av.w = (int)ap[3]; W[8 - k] = __builtin_bit_cast(bf16x8, av); }
#pragma unroll 1
                for (int J = 0; J < 8; ++J) {
                    const LAS uchar* aj = abase + (16 * p + 256 * J) * 2;
                    const LAS uchar* bj = bbase + (16 * p + 256 * J) * 2;
#pragma unroll
                    for (int jj = 0; jj < 8; ++jj) {
                        const LAS unsigned* ap = (const LAS unsigned*)(aj + 64 * jj);
                        i32x4 av; av.x = (int)ap[0]; av.y = (int)ap[1]; av.z = (int)ap[2]; av.w = (int)ap[3]; W[jj] = __builtin_bit_cast(bf16x8, av);
                        const bf16x8 bb = *(const LAS bf16x8*)(bj + 64 * jj);
#pragma unroll
                        for (int i = 0; i < 8; ++i) acc[i] = __builtin_amdgcn_mfma_f32_32x32x16_bf16(W[(jj - i) & 7], bb, acc[i], 0, 0, 0);
                    }
                }
            }
            { const int cc = 512 * (o + 1) + c; const float w0 = conv_w[cc], w1 = conv_w[1536 + cc], w2 = conv_w[3072 + cc]; const float sk = skip[o * 512 + c];
              const u16* p0 = pT + ((size_t)cc * NB + r) * SEQ + tbase + 4 * h;
              const LAS uchar* z0 = lds + r * HZ_ROW + (tbase + 4 * h) * 2;
              const int tl = tbase + 4 * h;
#pragma unroll
              for (int i = 0; i < 8; ++i) {
                  if ((i & 3) == 0) __builtin_amdgcn_sched_barrier(0);
#pragma unroll
                  for (int q = 0; q < 4; ++q) { const int off = 32 * i + 8 * q;
                      const u32x2 zz = *(const LAS u32x2*)(z0 + off * 2);
                      const u32x2 gv = *(const u32x2*)(p0 + off);
                      const float um = bf2f(p0[off - 1]), up = bf2f(p0[off + 4]);
                      const float gm = (tl + off > 0) ? um : 0.f, gp = (tl + off + 4 < SEQ) ? up : 0.f;
                      const float g0 = bflo(gv.x), g1 = bfhi(gv.x), g2 = bflo(gv.y), g3 = bfhi(gv.y);
                      acc[i][4 * q + 0] = (w0 * gm + w1 * g0 + w2 * g1) * (acc[i][4 * q + 0] + sk * bflo(zz.x));
                      acc[i][4 * q + 1] = (w0 * g0 + w1 * g1 + w2 * g2) * (acc[i][4 * q + 1] + sk * bfhi(zz.x));
                      acc[i][4 * q + 2] = (w0 * g1 + w1 * g2 + w2 * g3) * (acc[i][4 * q + 2] + sk * bflo(zz.y));
                      acc[i][4 * q + 3] = (w0 * g2 + w1 * g3 + w2 * gp) * (acc[i][4 * q + 3] + sk * bfhi(zz.y)); } } }
            __syncthreads();
#pragma unroll
            for (int i = 0; i < 8; ++i)
#pragma unroll
                for (int q = 0; q < 4; ++q) {
                    u32x2 w; w.x = cvt_pk_bf16(acc[i][4 * q + 0], acc[i][4 * q + 1]); w.y = cvt_pk_bf16(acc[i][4 * q + 2], acc[i][4 * q + 3]);
                    *(LAS u32x2*)(lds + r * HZ_ROW + (tbase + 4 * h) * 2 + (32 * i + 8 * q) * 2) = w; }
            if (o == 0) hy_load_kr(lds, G + (size_t)(512 + c) * 4096);
            __syncthreads();
        }
        for (int idx = tid; idx < NB * 256; idx += NTHR) { const int b = idx >> 8, s0 = (idx & 255) * 8;
            *(u32x4*)(yT + ((size_t)c * NB + b) * SEQ + s0) = *(const LAS u32x4*)(lds + b * HZ_ROW + s0 * 2); }
        __syncthreads();
    }
}

__device__ __forceinline__ u32x4 pack8(const float (&o)[8]) { u32x4 w; w.x = cvt_pk_bf16(o[0], o[1]); w.y = cvt_pk_bf16(o[2], o[3]); w.z = cvt_pk_bf16(o[4], o[5]); w.w = cvt_pk_bf16(o[6], o[7]); return w; }
template <int W> __device__ __forceinline__ void pool_unit(const u16* __restrict__ seq  , int t0, u16* __restrict__ out  ) {
    constexpr int LEFT = W / 2, RIGHT = W - LEFT - 1, NR = 8 + W - 1;
    u32x4 rows[NR];
#pragma unroll
    for (int k = 0; k < NR; ++k) { const int p = t0 - LEFT + k; const int pc = min(max(p, 0), SEQ - 1);
        const u32x4 v = *(const u32x4*)(seq + (size_t)pc * 2048); const bool ok = (p >= 0 && p < SEQ);
        rows[k].x = ok ? v.x : 0u; rows[k].y = ok ? v.y : 0u; rows[k].z = ok ? v.z : 0u; rows[k].w = ok ? v.w : 0u; }
    float sm[8];
#pragma unroll
    for (int c = 0; c < 8; ++c) sm[c] = 0.f;
#pragma unroll
    for (int k = 0; k < W; ++k) { float f[8]; unpack8(rows[k], f);
#pragma unroll
        for (int c = 0; c < 8; ++c) sm[c] += f[c]; }
#pragma unroll
    for (int i = 0; i < 8; ++i) { const int t = t0 + i; const int lo = max(t - LEFT, 0), hi = min(t + RIGHT, SEQ - 1); const float inv = 1.0f / (float)(hi - lo + 1);
        float ctr[8], o[8]; unpack8(rows[i + LEFT], ctr);
#pragma unroll
        for (int c = 0; c < 8; ++c) o[c] = sm[c] * inv - ctr[c];
        *(u32x4*)(out + (size_t)t * 1024) = pack8(o);
        if (i < 7) { float fa[8], fs[8]; unpack8(rows[i + W], fa); unpack8(rows[i], fs);
#pragma unroll
            for (int c = 0; c < 8; ++c) sm[c] += fa[c] - fs[c]; } }
}
__device__ __forceinline__ void dconv_unit(const u16* __restrict__ seq  , int t0, const float* __restrict__ dconv  , u16* __restrict__ out  ) {
    u32x4 cr[10], hr[10], br[8];
#pragma unroll
    for (int k = 0; k < 10; ++k) { const int p = t0 - 1 + k; const int pc = min(max(p, 0), SEQ - 1);
        const u32x4 v = *(const u32x4*)(seq + (size_t)pc * 2048 + 1024); hr[k] = *(const u32x4*)(seq + (size_t)pc * 2048 + 1536); const bool ok = (p >= 0 && p < SEQ);
        cr[k].x = ok ? v.x : 0u; cr[k].y = ok ? v.y : 0u; cr[k].z = ok ? v.z : 0u; cr[k].w = ok ? v.w : 0u; }
#pragma unroll
    for (int i = 0; i < 8; ++i) br[i] = *(const u32x4*)(seq + (size_t)(t0 + i) * 2048 + 512);
    float w0[8], w1[8], w2[8];
    { const float4 a0 = *(const float4*)(dconv), a1 = *(const float4*)(dconv + 4), b0 = *(const float4*)(dconv + 512), b1 = *(const float4*)(dconv + 516), c0 = *(const float4*)(dconv + 1024), c1 = *(const float4*)(dconv + 1028);
      w0[0] = a0.x; w0[1] = a0.y; w0[2] = a0.z; w0[3] = a0.w; w0[4] = a1.x; w0[5] = a1.y; w0[6] = a1.z; w0[7] = a1.w;
      w1[0] = b0.x; w1[1] = b0.y; w1[2] = b0.z; w1[3] = b0.w; w1[4] = b1.x; w1[5] = b1.y; w1[6] = b1.z; w1[7] = b1.w;
      w2[0] = c0.x; w2[1] = c0.y; w2[2] = c0.z; w2[3] = c0.w; w2[4] = c1.x; w2[5] = c1.y; w2[6] = c1.z; w2[7] = c1.w; }
    float pm[8], pc_[8], pn[8];
    { float c[8], h[8]; unpack8(cr[0], c); unpack8(hr[0], h);
#pragma unroll
      for (int k = 0; k < 8; ++k) pm[k] = c[k] * h[k];
      unpack8(cr[1], c); unpack8(hr[1], h);
#pragma unroll
      for (int k = 0; k < 8; ++k) pc_[k] = c[k] * h[k]; }
#pragma unroll
    for (int i = 0; i < 8; ++i) { float c[8], h[8], bb[8], o[8]; unpack8(cr[i + 2], c); unpack8(hr[i + 2], h); unpack8(br[i], bb);
#pragma unroll
        for (int k = 0; k < 8; ++k) { pn[k] = c[k] * h[k]; o[k] = bb[k] * (w0[k] * pm[k] + w1[k] * pc_[k] + w2[k] * pn[k]); pm[k] = pc_[k]; pc_[k] = pn[k]; }
        *(u32x4*)(out + (size_t)(t0 + i) * 1024) = pack8(o); }
}
__device__ void stencil_phase(const u16* __restrict__ proj  , const float* __restrict__ dconv  , u16* __restrict__ ycat  ) {
    const int tid = opaque_tid(), lane = tid & 63, wave = __builtin_amdgcn_readfirstlane(tid >> 6);
    const int chl = (lane & 15) * 8, run = lane >> 4;
    for (int wu = blockIdx.x * 8 + wave; wu < (T_ / 32) * 8; wu += gridDim.x * 8) {
        const int rq = wu >> 3, kind = wu & 7; const int tok0 = rq * 32 + run * 8; const int t0 = tok0 & (SEQ - 1); const size_t s0 = (size_t)(tok0 - t0);
        if (kind < 4) { const int ch0 = kind * 128 + chl; const u16* seq = proj + s0 * 2048 + ch0; u16* out = ycat + s0 * 1024 + ch0;
            if (kind == 0) pool_unit<2>(seq, t0, out); else if (kind == 1) pool_unit<4>(seq, t0, out); else if (kind == 2) pool_unit<8>(seq, t0, out); else pool_unit<16>(seq, t0, out);
        } else { const int ch0 = (kind - 4) * 128 + chl; dconv_unit(proj + s0 * 2048 + ch0, t0, dconv + ch0, ycat + s0 * 1024 + 512 + ch0); }
    }
}


#define XB_TMO      128
#define XB_XCNT(j)  (256  + 64 * (j))
#define XB_XSUB(j)  (1280 + 64 * (j))
#define XB_XGEN(j)  (2304 + 64 * (j))
#define XB_TOP      3328
#define XB_TOPGEN   3392
#define XCD_BAR_WORDS 3456
#define XB_SPIN_CAP (1u << 20)
__device__ __forceinline__ unsigned xb_ld(unsigned* p)              { return __hip_atomic_load(p, __ATOMIC_RELAXED, __HIP_MEMORY_SCOPE_AGENT); }
__device__ __forceinline__ unsigned xb_add(unsigned* p, unsigned v) { return __hip_atomic_fetch_add(p, v, __ATOMIC_RELAXED, __HIP_MEMORY_SCOPE_AGENT); }
__device__ __forceinline__ unsigned xb_xcc_id() { return (unsigned)__builtin_amdgcn_s_getreg((3 << 11) | 20) & 0xFu; }
#define XB_SPIN(cond, bar) do { unsigned _sp = 0; while (cond) { __builtin_amdgcn_s_sleep(1); \
    if ((++_sp & 255u) == 0u) { if (xb_ld(&(bar)[XB_TMO])) break; if (_sp > XB_SPIN_CAP) { atomicAdd(&(bar)[XB_TMO], 1u); break; } } } } while (0)
struct XcdBarrier { unsigned* bar; unsigned x; volatile LAS unsigned* st; };
__device__ __forceinline__ XcdBarrier xcd_barrier_post(unsigned* bar, volatile LAS unsigned* st) {
    XcdBarrier b; b.bar = bar; b.x = xb_xcc_id(); b.st = st;
    if (threadIdx.x == 0) (void)xb_add(&bar[XB_XCNT(b.x)], 1u);
    return b;
}
__device__ __forceinline__ void xcd_barrier_complete(unsigned* bar, unsigned x, unsigned& nloc, unsigned& nx) {
    const unsigned G = gridDim.x * gridDim.y * gridDim.z;
    unsigned sum, cnt, mine, sp = 0u;
    for (;;) {
        sum = 0u; cnt = 0u; mine = 0u;
#pragma unroll
        for (unsigned j = 0; j < 16; ++j) { const unsigned c = xb_ld(&bar[XB_XCNT(j)]); sum += c; cnt += (c > 0u) ? 1u : 0u; mine = (j == x) ? c : mine; }
        if (sum == G) break;
        __builtin_amdgcn_s_sleep(1);
        if ((++sp & 255u) == 0u) { if (xb_ld(&bar[XB_TMO])) break; if (sp > XB_SPIN_CAP) { atomicAdd(&bar[XB_TMO], 1u); break; } }
    }
    nloc = mine > 0u ? mine : 1u; nx = cnt > 0u ? cnt : 1u;
}
__device__ __forceinline__ void xcd_barrier(const XcdBarrier& b) {
    asm volatile("s_waitcnt vmcnt(0)" ::: "memory");
    __syncthreads();
    if (threadIdx.x == 0) {
        unsigned* bar = b.bar;
        __builtin_amdgcn_s_waitcnt(0);
        unsigned nloc = b.st[0], nx = b.st[1];
        if (nloc == 0u) { xcd_barrier_complete(bar, b.x, nloc, nx); b.st[0] = nloc; b.st[1] = nx; }
        const unsigned old = xb_add(&bar[XB_XSUB(b.x)], 1u);
        const unsigned gen = old / nloc;
        if (old + 1u == (gen + 1u) * nloc) {
            __builtin_amdgcn_fence(__ATOMIC_RELEASE, "agent");
            asm volatile("s_waitcnt vmcnt(0)" ::: "memory");
            const unsigned og = xb_add(&bar[XB_TOP], 1u);
            const unsigned tg = og / nx;
            if (og + 1u == (tg + 1u) * nx) xb_add(&bar[XB_TOPGEN], 1u);
            else XB_SPIN(xb_ld(&bar[XB_TOPGEN]) == tg, bar);
            __builtin_amdgcn_fence(__ATOMIC_ACQUIRE, "agent");
            xb_add(&bar[XB_XGEN(b.x)], 1u);
            asm volatile("s_waitcnt vmcnt(0)" ::: "memory");
        } else {
            XB_SPIN(xb_ld(&bar[XB_XGEN(b.x)]) == gen, bar);
            __builtin_amdgcn_fence(__ATOMIC_ACQUIRE, "agent");
            asm volatile("s_waitcnt vmcnt(0)" ::: "memory");
        }
    }
    __syncthreads();
}

constexpr int NPH = 1 + 2 * 8 + 2 * 7;
struct Args { const float* in[23]; float* out; uchar* ws; int lo, hi; };

__global__ void __launch_bounds__(NTHR, 2) fwd_kernel(Args a) {
    extern __shared__ __attribute__((aligned(16))) uchar lds_raw[];
    LAS uchar* lds = (LAS uchar*)lds_raw;
    cg::grid_group grid = cg::this_grid();
    const int lo = a.lo, hi = a.hi; int ph = 0;
    volatile LAS unsigned* xst = (volatile LAS unsigned*)(lds + LDS_ST_OFF);
    if (threadIdx.x == 0) { xst[0] = 0u; xst[1] = 0u; }
    __syncthreads();
    XcdBarrier xb = xcd_barrier_post((unsigned*)(a.ws + WS_BAR), xst);
#define PH_BEGIN if (ph >= lo && ph < hi) {
#define PH_END } if (ph >= lo && ph + 1 < hi) { if (lo < 0) grid.sync();   xcd_barrier(xb); if (DBL(11) == 2) { xcd_barrier(xb); xcd_barrier(xb); } } ++ph;
    uchar* ws = a.ws;
    u16* Wabin = (u16*)(ws + WS_ABIN); u16* Wabout = (u16*)(ws + WS_ABOUT); u16* Wcdin = (u16*)(ws + WS_CDIN); u16* Wcdout = (u16*)(ws + WS_CDOUT);
    u16* Wgu = (u16*)(ws + WS_GU); u16* Wdown = (u16*)(ws + WS_DOWN); u16* Gf = (u16*)(ws + WS_G);
    u16* H = (u16*)(ws + WS_H); u16* PROJ = (u16*)(ws + WS_B); u16* YT = (u16*)(ws + WS_B + (size_t)T_ * 1024 * 2);     u16* ACT = (u16*)(ws + WS_B); u16* PT = (u16*)(ws + WS_C);
    u16* YCAT = (u16*)(ws + WS_D); u16* MIX = (u16*)(ws + WS_E); float* RSTD = (float*)(ws + WS_RSTD);
    const float* x_in = a.in[0]; const float* norm_g = a.in[1]; float* X = a.out;

    PH_BEGIN
      for (int rep = 0; rep < DBL(0); ++rep) {
        int rot = 0;
        filter_job(lds, a.in[10], a.in[11], a.in[12], a.in[13], a.in[14], a.in[15], a.in[16], Gf);
        for (int j = 0; j < 2; ++j) {
            wt_job(lds, a.in[4] + (size_t)j * 1024 * 2560, 2560, 1024, 2560, Wabin + (size_t)j * 2560 * 1024, 1024, 0, norm_g + (size_t)(2 * j) * 4 * 1024, rot);
            wt_job(lds, a.in[5] + (size_t)j * 1024 * 1024, 1024, 1024, 1024, Wabout + (size_t)j * 1024 * 1024, 1024, 0, nullptr, rot);
            wt_job(lds, a.in[18] + (size_t)j * 1024 * 2048, 2048, 1024, 2048, Wcdin + (size_t)j * 2048 * 1024, 1024, 0, norm_g + (size_t)(2 * j + 1) * 4 * 1024, rot);
            wt_job(lds, a.in[19] + (size_t)j * 1024 * 1024 + 512 * 1024, 1024, 512, 1024, Wcdout + (size_t)j * 1024 * 1024 + 512, 1024, 0, nullptr, rot);
            fold_job(a.in[20] + (size_t)j * 4 * 128 * 128, a.in[21] + j * 512, a.in[19] + (size_t)j * 1024 * 1024, Wcdout + (size_t)j * 1024 * 1024);
        }
        for (int i = 0; i < 4; ++i) {
            wt_job(lds, a.in[2] + (size_t)i * 1024 * 5632, 5632, 1024, 5632, Wgu + (size_t)i * 5632 * 1024, 1024, 1, norm_g + (size_t)(i * 4 + 2) * 1024, rot);
            wt_job(lds, a.in[3] + (size_t)i * 2816 * 1024, 1024, 2816, 1024, Wdown + (size_t)i * 1024 * 2816, 2816, 0, nullptr, rot);
        }
      }
        resid_pass(x_in, H, nullptr, nullptr, RSTD, nullptr);
    PH_END

#pragma unroll 1
    for (int i = 0; i < 4; ++i) {
        const int j = i >> 1; const bool even = (i & 1) == 0;
        const float* g4 = norm_g + (size_t)i * 4 * 1024;
        PH_BEGIN
            { const int N = even ? 1024 : 2048;
              pg8::Gemm g{H, even ? Wabin + (size_t)j * 2560 * 1024 : Wcdin + (size_t)j * 2048 * 1024, T_, N, 1024};
              pg8::StaticOrder S; S.init(T_, N, (int)gridDim.x, (int)blockIdx.x);
              pg8::EpiBf16G E{PROJ, N, even ? 4 : 0, RSTD};
#ifndef SKIP_G1
              for (int rep = 0; rep < DBL(6); ++rep) pg8::gemm_phase<pg8::EpiBf16G, pg8::StaticOrder, false>(lds, g, S, E, nullptr);
#endif
            }
            if (even) {
              pg8::Gemm g{H, Wabin + (size_t)j * 2560 * 1024 + (size_t)1024 * 1024, T_, 1536, 1024};
              pg8::StaticOrder S; S.init(T_, 1536, (int)gridDim.x, (int)blockIdx.x);
              pg8::EpiPT E{PT, RSTD};
              pg8::gemm_phase<pg8::EpiPT, pg8::StaticOrder, false>(lds, g, S, E, nullptr);
            }
        PH_END
        if (even) {
            PH_BEGIN
                for (int rep = 0; rep < DBL(1); ++rep) gating_phase(lds, PROJ, a.in[6] + j * 512, a.in[7] + (size_t)j * 4 * 128 * 128, a.in[8] + j * 512, YCAT);
                for (int rep = 0; rep < DBL(3); ++rep) hyena_phase(lds, PT, Gf + (size_t)j * 2 * 512 * 4096, a.in[9] + (size_t)j * 3 * 1536, a.in[17] + j * 1024, YT);
            PH_END
            PH_BEGIN
                for (int rep = 0; rep < DBL(4); ++rep) transpose_back_phase(lds, YT, YCAT);
            PH_END
        } else {
            PH_BEGIN
                for (int rep = 0; rep < DBL(5); ++rep) stencil_phase(PROJ, a.in[22] + (size_t)j * 3 * 512, YCAT);
            PH_END
        }
        PH_BEGIN
            pg8::Gemm g{YCAT, even ? Wabout + (size_t)j * 1024 * 1024 : Wcdout + (size_t)j * 1024 * 1024, T_, 1024, 1024};
            pg8::StaticOrder S; S.init(T_, 1024, (int)gridDim.x, (int)blockIdx.x);
            pg8::EpiBf16G E{MIX, 1024, 0, nullptr};

#ifndef SKIP_G2
            for (int rep = 0; rep < DBL(7); ++rep) pg8::gemm_phase<pg8::EpiBf16G, pg8::StaticOrder, false>(lds, g, S, E, nullptr);
#endif
        PH_END
        PH_BEGIN
            if (DBL(10) == 2) resid_pass(nullptr, (u16*)(ws + WS_C), MIX, g4 + 1024, (float*)(ws + WS_B), nullptr);
            resid_pass(nullptr, H, MIX, g4 + 1024, RSTD, nullptr);
        PH_END
        PH_BEGIN
            pg8::Gemm g{H, Wgu + (size_t)i * 5632 * 1024, T_, 5632, 1024};
            pg8::StaticOrder S; S.init(T_, 5632, (int)gridDim.x, (int)blockIdx.x);
            pg8::EpiSwiGLU E{ACT, DFF, RSTD};

#ifndef SKIP_G3
            for (int rep = 0; rep < DBL(8); ++rep) pg8::gemm_phase<pg8::EpiSwiGLU, pg8::StaticOrder, false>(lds, g, S, E, nullptr);
#endif
        PH_END
        PH_BEGIN
            pg8::Gemm g{ACT, Wdown + (size_t)i * 1024 * 2816, T_, 1024, DFF};
            pg8::StaticOrder S; S.init(T_, 1024, (int)gridDim.x, (int)blockIdx.x);
            pg8::EpiBf16G E{MIX, 1024, 0, nullptr};

#ifndef SKIP_G4
            for (int rep = 0; rep < DBL(9); ++rep) pg8::gemm_phase<pg8::EpiBf16G, pg8::StaticOrder, false>(lds, g, S, E, nullptr);
#endif
        PH_END
        PH_BEGIN
            if (DBL(10) == 2) resid_pass(nullptr, (u16*)(ws + WS_C), MIX, g4 + 3072, (float*)(ws + WS_B), nullptr);
            resid_pass(nullptr, H, MIX, g4 + 3072, RSTD, (i == 3) ? X : nullptr);
        PH_END
    }
#undef PH_BEGIN
#undef PH_END
}

extern "C" void kernel_launch(void* const* d_in, const int* in_sizes, int n_in, void* d_out, int out_size, void* d_ws, size_t ws_size, hipStream_t stream) {
    static int grid = 0;
    if (grid == 0) {
        if (n_in != 23 || out_size != T_ * DM || ws_size < WS_END) { fprintf(stderr, "kernel_launch: unexpected problem (n_in %d out %d ws %zu)\n", n_in, out_size, ws_size); grid = -1; return; }
        int dev = 0, cus = 0, per_cu = 0;
        (void)hipGetDevice(&dev); (void)hipDeviceGetAttribute(&cus, hipDeviceAttributeMultiprocessorCount, dev);
        if (hipFuncSetAttribute((const void*)fwd_kernel, hipFuncAttributeMaxDynamicSharedMemorySize, LDS_BYTES) != hipSuccess) { fprintf(stderr, "kernel_launch: hipFuncSetAttribute failed\n"); grid = -1; return; }
        if (hipOccupancyMaxActiveBlocksPerMultiprocessor(&per_cu, (const void*)fwd_kernel, NTHR, LDS_BYTES) != hipSuccess || per_cu < 1) { fprintf(stderr, "kernel_launch: occupancy query gave %d\n", per_cu); per_cu = 1; }
        (void)hipGetLastError();
        grid = cus * per_cu;
        fprintf(stderr, "kernel_launch: grid %d (cus %d x %d)\n", grid, cus, per_cu);
    }
    if (grid < 0) return;
    Args a{};
    for (int i = 0; i < 23; ++i) a.in[i] = (const float*)d_in[i];
    a.out = (float*)d_out; a.ws = (uchar*)d_ws;
#if ONE_LAUNCH
    (void)hipMemsetAsync((char*)d_ws + WS_BAR, 0, XCD_BAR_WORDS * 4, stream);
    a.lo = 0; a.hi = NPH;
    void* args[] = {&a};
    hipError_t e = hipLaunchCooperativeKernel((const void*)fwd_kernel, dim3(grid), dim3(NTHR), args, LDS_BYTES, stream);
    if (e != hipSuccess) fprintf(stderr, "kernel_launch: cooperative launch failed: %s (grid %d)\n", hipGetErrorString(e), grid);
#else
    for (int p = 0; p < NPH; ++p) { a.lo = p; a.hi = p + 1;
        hipLaunchKernelGGL(fwd_kernel, dim3(grid), dim3(NTHR), LDS_BYTES, stream, a); }
#endif
}
```

```cpp
#include <hip/hip_runtime.h>
#include <hip/hip_cooperative_groups.h>
#include <cstdio>
namespace cg = cooperative_groups;

#ifndef ONE_LAUNCH
#define ONE_LAUNCH 1
#endif
#ifndef DBL_MASK
#define DBL_MASK 0
#endif
#ifndef ALIGN_EPI
#define ALIGN_EPI 1
#endif
#define DBL(bit) (((DBL_MASK >> (bit)) & 1) ? 2 : 1)

__device__ __forceinline__ int opaque_tid() { int t = (int)threadIdx.x; asm volatile("" : "+v"(t)); return t; }
namespace pg8 {
#define PG8_LAS __attribute__((address_space(3)))
typedef unsigned short bf16_t;
typedef short bf16x8 __attribute__((ext_vector_type(8)));
typedef float f32x4 __attribute__((ext_vector_type(4)));
typedef unsigned u32x4 __attribute__((ext_vector_type(4)));
constexpr int RS_LDS_OFF = 132096;
constexpr int EPI_LDS_OFF = 134144, EPI_LDS_WAVE = 2304;
constexpr int BM = 256, BK = 64, HALF = 128, HTB = HALF * BK * 2  , STAGE_BYTES = 8 * HTB, NXCD = 8, WGM = 8;

__host__ __device__ __forceinline__ int lds_byte(int r, int c) { const int st = (r >> 4) * 2 + (c >> 5), rr = r & 15, cc = c & 31, ob = rr * 64 + cc * 2; return st * 1024 + (ob ^ (((ob >> 9) & 1) << 5)); }
__host__ __device__ __forceinline__ void stage_rc(int b, int& R, int& C) { const int st = b / 1024, sb = b % 1024, swz = sb ^ (((sb >> 9) & 1) << 5); R = (st >> 1) * 16 + swz / 64; C = (st & 1) * 32 + (swz % 64) / 2; }
__host__ __device__ __forceinline__ int perm32(int rho) { const int n = rho >> 4, i = rho & 15; return 8 * (i >> 2) + 4 * n + (i & 3); }
struct Unit { int pm, pn; };
struct Gemm { const bf16_t* A; const bf16_t* Bt; int M, N, K; };

struct StaticOrder {
    int nM, nN, nwg, G, c;
    __host__ __device__ void init(int M, int N, int G_, int c_) { nM = M / BM; nN = N / BM; nwg = nM * nN; G = G_; c = c_; }
    __host__ __device__ bool next(int i, Unit& u) const {
        const long L = (long)i * G + c; if (L >= nwg) return false;
        int wgid = (int)L; { const int q = nwg / NXCD, r = nwg % NXCD, xcd = wgid % NXCD, off = wgid / NXCD; wgid = (xcd < r ? xcd * (q + 1) : r * (q + 1) + (xcd - r) * q) + off; }
        const int nig = WGM * nN, gid = wgid / nig, fm = gid * WGM, gsz = (nM - fm) < WGM ? (nM - fm) : WGM;
        u.pm = fm + ((wgid % nig) % gsz); u.pn = (wgid % nig) / gsz; return true;
    }
    __device__ __forceinline__ void a_ready(const Unit&) const {}
    __device__ __forceinline__ void done(const Unit&) const {}
};
__device__ __forceinline__ unsigned cvt_pk_bf16(float lo, float hi) { unsigned r; asm volatile("v_cvt_pk_bf16_f32 %0, %1, %2" : "=v"(r) : "v"(lo), "v"(hi)); return r; }

__device__ __forceinline__ float gelu_tanh_f(float x) { const float y = 1.5957691216f * (x + 0.044715f * x * x * x); return x * __builtin_amdgcn_rcpf(1.0f + __expf(-y)); }
__device__ __forceinline__ float silu_f(float x) { return x * __builtin_amdgcn_rcpf(1.0f + __expf(-x)); }

struct EpiBf16G {
    static constexpr bool PERM = true, AFTER_DRAIN = false, SWAP = false; static constexpr int NSTORES = 16;
    bf16_t* O; int ldc; int gelu_tiles; const float* rs;
    __device__ __forceinline__ void operator()(const f32x4 (&acc)[2][2][4][2], const Unit& u, int wr, int wc, int fr, int fq, const PG8_LAS float* rsl, PG8_LAS unsigned char* eslot) const {
        const int lane = fq * 16 + fr, lr = lane >> 2, lc = (lane & 3) * 8;
        const int rowb = u.pm * BM + wr * 64, colb = u.pn * BM + wc * 32;
        const bool act = u.pn < gelu_tiles;
#pragma unroll
        for (int ai = 0; ai < 2; ++ai)
#pragma unroll
            for (int m = 0; m < 4; ++m) {
                const float sc = rs ? rsl[wr * 64 + fr + ai * HALF + m * 16] : 1.0f;
#pragma unroll
                for (int bj = 0; bj < 2; ++bj) { f32x4 v0 = acc[ai][bj][m][0] * sc, v1 = acc[ai][bj][m][1] * sc;
                    if (act) {
#pragma unroll
                        for (int j = 0; j < 4; ++j) { v0[j] = gelu_tanh_f(v0[j]); v1[j] = gelu_tanh_f(v1[j]); } }
                    u32x4 w; w.x = cvt_pk_bf16(v0[0], v0[1]); w.y = cvt_pk_bf16(v0[2], v0[3]); w.z = cvt_pk_bf16(v1[0], v1[1]); w.w = cvt_pk_bf16(v1[2], v1[3]);
                    PG8_LAS unsigned char* sl = eslot;
                    *(PG8_LAS u32x4*)(sl + fr * 64 + fq * 16) = w;
                    const u32x4 w2 = *(const PG8_LAS u32x4*)(sl + lane * 16);
                    *(u32x4*)(O + (size_t)(rowb + ai * HALF + m * 16 + lr) * ldc + colb + bj * HALF + lc) = w2; } }
    }
};
struct EpiPT {
    static constexpr bool PERM = false, AFTER_DRAIN = false, SWAP = true; static constexpr int NSTORES = 16;
    bf16_t* O; const float* rs;
    __device__ __forceinline__ void operator()(const f32x4 (&acc)[2][2][4][2], const Unit& u, int wr, int wc, int fr, int fq, const PG8_LAS float* rsl, PG8_LAS unsigned char* eslot) const {
        typedef unsigned u32x2_t __attribute__((ext_vector_type(2)));
        const int lane = fq * 16 + fr;
        const int rowb = u.pm * BM + wr * 64; const int b = rowb >> 11, s0 = rowb & 2047;
#pragma unroll
        for (int ai = 0; ai < 2; ++ai)
#pragma unroll
            for (int bj = 0; bj < 2; ++bj)
#pragma unroll
                for (int n = 0; n < 2; ++n) { const int col0 = u.pn * BM + bj * HALF + wc * 32 + n * 16;
#pragma unroll
                    for (int m = 0; m < 4; ++m) { const f32x4 sc = *(const PG8_LAS f32x4*)(rsl + wr * 64 + 4 * fq + ai * HALF + m * 16);
                        const f32x4 v = acc[ai][bj][m][n] * sc;
                        u32x2_t w; w.x = cvt_pk_bf16(v[0], v[1]); w.y = cvt_pk_bf16(v[2], v[3]);
                        *(PG8_LAS u32x2_t*)(eslot + fr * 144 + (16 * m + 4 * fq) * 2) = w; }
#pragma unroll
                    for (int k = 0; k < 2; ++k) { const int c = lane + 64 * k, col = c >> 3, ch = c & 7;
                        const u32x4 w2 = *(const PG8_LAS u32x4*)(eslot + col * 144 + ch * 16);
                        *(u32x4*)(O + ((size_t)(col0 + col) * 32 + b) * 2048 + s0 + ai * HALF + ch * 8) = w2; } }
    }
};
struct EpiSwiGLU {
    static constexpr bool PERM = true, AFTER_DRAIN = false, SWAP = false; static constexpr int NSTORES = 8;
    bf16_t* O; int ldc; const float* rs;
    __device__ __forceinline__ void operator()(const f32x4 (&acc)[2][2][4][2], const Unit& u, int wr, int wc, int fr, int fq, const PG8_LAS float* rsl, PG8_LAS unsigned char* eslot) const {
        const int lane = fq * 16 + fr, lr = lane >> 2, lc = (lane & 3) * 8;
        const int rowb = u.pm * BM + wr * 64, colb = u.pn * HALF + wc * 32;
#pragma unroll
        for (int ai = 0; ai < 2; ++ai)
#pragma unroll
            for (int m = 0; m < 4; ++m) {
                const float sc = rsl[wr * 64 + fr + ai * HALF + m * 16];
                const f32x4 g0 = acc[ai][0][m][0] * sc, g1 = acc[ai][0][m][1] * sc, u0 = acc[ai][1][m][0] * sc, u1 = acc[ai][1][m][1] * sc;
                const f32x4 a0 = g0 * (-1.4426950408889634f), a1 = g1 * (-1.4426950408889634f);
                f32x4 e0, e1;
#pragma unroll
                for (int j = 0; j < 4; ++j) { e0[j] = __builtin_amdgcn_exp2f(a0[j]); e1[j] = __builtin_amdgcn_exp2f(a1[j]); }
                const f32x4 d0 = e0 + 1.0f, d1 = e1 + 1.0f;
                f32x4 r0, r1;
#pragma unroll
                for (int j = 0; j < 4; ++j) { r0[j] = __builtin_amdgcn_rcpf(d0[j]); r1[j] = __builtin_amdgcn_rcpf(d1[j]); }
                const f32x4 v0 = (g0 * u0) * r0, v1 = (g1 * u1) * r1;
                u32x4 w; w.x = cvt_pk_bf16(v0[0], v0[1]); w.y = cvt_pk_bf16(v0[2], v0[3]); w.z = cvt_pk_bf16(v1[0], v1[1]); w.w = cvt_pk_bf16(v1[2], v1[3]);
                PG8_LAS unsigned char* sl = eslot;
                *(PG8_LAS u32x4*)(sl + fr * 64 + fq * 16) = w;
                const u32x4 w2 = *(const PG8_LAS u32x4*)(sl + lane * 16);
                *(u32x4*)(O + (size_t)(rowb + ai * HALF + m * 16 + lr) * ldc + colb + lc) = w2; }
    }
};

template <class Epi, class Sched, bool STAMP = false>
__device__ __forceinline__ void gemm_phase(PG8_LAS unsigned char* lds, const Gemm g, const Sched& S, const Epi& E, unsigned long long* stamps) {
    const int tid = opaque_tid(), wid = __builtin_amdgcn_readfirstlane(tid >> 6), lane = tid & 63, wr = wid >> 2, wc = wid & 3, fr = lane & 15, fq = lane >> 4;
    const int K = g.K, nt = K / BK;
    int ts_lo = 0, ts_hi = 0, nts = 0; const unsigned long long rt_entry = STAMP ? (unsigned long long)wall_clock64() : 0ull;
#define PG8_STAMP() do { if (STAMP && wid == 0 && nts < 64) { const unsigned long long _c = (unsigned long long)clock64(); \
        ts_lo = (lane == nts) ? (int)(unsigned)_c : ts_lo; ts_hi = (lane == nts) ? (int)(unsigned)(_c >> 32) : ts_hi; ++nts; } } while (0)
    PG8_STAMP();
    unsigned voffA[2], voffB[2];
#pragma unroll
    for (int i = 0; i < 2; ++i) { int R, C; stage_rc(tid * 16 + i * 8192, R, C); const int Rb = Epi::PERM ? ((R & ~31) + perm32(R & 31)) : R;
        voffA[i] = (unsigned)(R * K + C) * 2u; voffB[i] = (unsigned)(Rb * K + C) * 2u; }
    const size_t kstep = (size_t)(BK * 2);
    const size_t hstep = (size_t)HALF * K * 2;
    const size_t tstep = 2 * hstep;
    const unsigned ldsw = (unsigned)wid * 1024u;
    const int aoff = lds_byte(wr * 64 + fr, fq * 8), boff = lds_byte(wc * 32 + fr, fq * 8);
#define PG8_SA(b, h) (((b) * 2 + (h)) * HTB)
#define PG8_SB(b, h) ((4 + (b) * 2 + (h)) * HTB)
#define PG8_STAGE(bufoff, gbase, voff) do { _Pragma("unroll") for (int _i = 0; _i < 2; ++_i) \
        __builtin_amdgcn_global_load_lds((const unsigned*)((const char*)(gbase) + (voff)[_i]), (PG8_LAS unsigned*)(lds + (bufoff) + ldsw + _i * 8192), 16, 0, 0); } while (0)
#define PG8_LDA(dst, b, h) do { _Pragma("unroll") for (int m = 0; m < 4; ++m) _Pragma("unroll") for (int k = 0; k < 2; ++k) dst[m][k] = *(const PG8_LAS bf16x8*)(lds + PG8_SA(b, h) + aoff + m * 2048 + k * 1024); } while (0)
#define PG8_LDB(dst, b, h) do { _Pragma("unroll") for (int n = 0; n < 2; ++n) _Pragma("unroll") for (int k = 0; k < 2; ++k) dst[n][k] = *(const PG8_LAS bf16x8*)(lds + PG8_SB(b, h) + boff + n * 2048 + k * 1024); } while (0)
#define PG8_MMA(ai, bj, At, Bt) do { __builtin_amdgcn_s_setprio(1); _Pragma("unroll") for (int m = 0; m < 4; ++m) _Pragma("unroll") for (int n = 0; n < 2; ++n) _Pragma("unroll") for (int k = 0; k < 2; ++k) \
        acc[ai][bj][m][n] = Epi::SWAP ? __builtin_amdgcn_mfma_f32_16x16x32_bf16(At[m][k], Bt[n][k], acc[ai][bj][m][n], 0, 0, 0) : __builtin_amdgcn_mfma_f32_16x16x32_bf16(Bt[n][k], At[m][k], acc[ai][bj][m][n], 0, 0, 0); __builtin_amdgcn_s_setprio(0); } while (0)
#define PG8_WAIT_V(n) asm volatile("s_waitcnt vmcnt(" #n ")" ::: "memory")
#define PG8_WAIT_L(n) asm volatile("s_waitcnt lgkmcnt(" #n ")" ::: "memory")
#define PG8_BAR __builtin_amdgcn_s_barrier()
#define PG8_SCHED __builtin_amdgcn_sched_barrier(0)
#define PG8_STAGE_RS(unit, buf) do { if (E.rs != nullptr && wid < 4) __builtin_amdgcn_global_load_lds((const unsigned*)(E.rs + (unit).pm * BM + wid * 64 + lane), (PG8_LAS unsigned*)(lds + RS_LDS_OFF + (buf) * 1024 + wid * 256), 4, 0, 0); } while (0)
    Unit cur, nxt; int ui = 0;
    if (!S.next(0, cur)) return;
    f32x4 acc[2][2][4][2];
#pragma unroll
    for (int a = 0; a < 2; ++a)
#pragma unroll
        for (int b = 0; b < 2; ++b)
#pragma unroll
            for (int m = 0; m < 4; ++m)
#pragma unroll
                for (int n = 0; n < 2; ++n) acc[a][b][m][n] = (f32x4){0.f, 0.f, 0.f, 0.f};
    bf16x8 At[4][2], B0[2][2], B1[2][2];
    const char* cA = (const char*)g.A + (size_t)cur.pm * tstep; const char* cB = (const char*)g.Bt + (size_t)cur.pn * tstep;
    S.a_ready(cur);
    PG8_STAGE_RS(cur, 0);
    PG8_STAGE(PG8_SB(0, 0), cB, voffB); PG8_STAGE(PG8_SA(0, 0), cA, voffA); PG8_STAGE(PG8_SB(0, 1), cB + hstep, voffB); PG8_STAGE(PG8_SA(0, 1), cA + hstep, voffA);
    if (wr == 1) PG8_BAR;
    PG8_WAIT_V(4); PG8_BAR;
    PG8_STAGE(PG8_SB(1, 0), cB + kstep, voffB); PG8_STAGE(PG8_SA(1, 0), cA + kstep, voffA); PG8_STAGE(PG8_SB(1, 1), cB + hstep + kstep, voffB); PG8_STAGE(PG8_SA(1, 1), cA + hstep + kstep, voffA);
    PG8_WAIT_V(8); PG8_BAR;
    PG8_STAMP();
    for (;;) {
        const bool has_next = S.next(ui + 1, nxt);
        const char* nA = has_next ? (const char*)g.A + (size_t)nxt.pm * tstep : cA; const char* nB = has_next ? (const char*)g.Bt + (size_t)nxt.pn * tstep : cB;
        for (int t = 0; t < nt; t += 2) {
            const bool last = (t == nt - 2);
            const char* a2 = last ? nA : cA + (size_t)(t + 2) * kstep; const char* b2 = last ? nB : cB + (size_t)(t + 2) * kstep;
            const char* a3 = a2 + kstep; const char* b3 = b2 + kstep;
            if (last && has_next) { S.a_ready(nxt); PG8_STAGE_RS(nxt, (ui + 1) & 1); }
            PG8_LDB(B0, 0, 0); PG8_SCHED; PG8_LDA(At, 0, 0);
            PG8_WAIT_L(8); PG8_BAR; PG8_WAIT_L(0); PG8_MMA(0, 0, At, B0); PG8_BAR; PG8_SCHED;
            PG8_LDB(B1, 0, 1); PG8_STAGE(PG8_SB(0, 0), b2, voffB);
            PG8_BAR; PG8_WAIT_L(0); PG8_MMA(0, 1, At, B1); PG8_BAR;
            PG8_LDA(At, 0, 1); PG8_STAGE(PG8_SA(0, 0), a2, voffA);
            PG8_BAR; PG8_WAIT_L(0); PG8_MMA(1, 0, At, B0); PG8_BAR; PG8_SCHED;
            PG8_STAGE(PG8_SB(0, 1), b2 + hstep, voffB);
            { const int relaxed = __builtin_amdgcn_readfirstlane((t == 0 && ui > 0) ? 1 : 0);
              asm volatile("s_cmp_lg_u32 %0, 0\n\ts_cbranch_scc1 .Lpg8rlx%=\n\ts_waitcnt vmcnt(6)\n\ts_branch .Lpg8end%=\n.Lpg8rlx%=:\n\ts_waitcnt vmcnt(%1)\n.Lpg8end%=:" :: "s"(relaxed), "n"(6 + Epi::NSTORES) : "memory", "scc"); }
            PG8_BAR; PG8_MMA(1, 1, At, B1); PG8_BAR;
            PG8_LDB(B0, 1, 0); PG8_SCHED; PG8_LDA(At, 1, 0); PG8_STAGE(PG8_SA(0, 1), a2 + hstep, voffA);
            PG8_WAIT_L(8); PG8_BAR; PG8_WAIT_L(0); PG8_MMA(0, 0, At, B0); PG8_BAR; PG8_SCHED;
            PG8_LDB(B1, 1, 1); PG8_STAGE(PG8_SB(1, 0), b3, voffB);
            PG8_BAR; PG8_WAIT_L(0); PG8_MMA(0, 1, At, B1); PG8_BAR;
            PG8_LDA(At, 1, 1); PG8_STAGE(PG8_SA(1, 0), a3, voffA);
            PG8_BAR; PG8_WAIT_L(0); PG8_MMA(1, 0, At, B0); PG8_BAR; PG8_SCHED;
            PG8_STAGE(PG8_SB(1, 1), b3 + hstep, voffB);
            PG8_WAIT_V(6); PG8_BAR; PG8_MMA(1, 1, At, B1); PG8_BAR;
            PG8_STAGE(PG8_SA(1, 1), a3 + hstep, voffA);
        }
        PG8_STAMP();
#if ALIGN_EPI
        if (wr == 0) PG8_BAR;
#endif
        if constexpr (!Epi::AFTER_DRAIN) { E(acc, cur, wr, wc, fr, fq, (const PG8_LAS float*)(lds + RS_LDS_OFF + (ui & 1) * 1024), lds + EPI_LDS_OFF + wid * EPI_LDS_WAVE); S.done(cur); }
        PG8_STAMP();
        if (!has_next) break;
#pragma unroll
        for (int a = 0; a < 2; ++a)
#pragma unroll
            for (int b = 0; b < 2; ++b)
#pragma unroll
                for (int m = 0; m < 4; ++m)
#pragma unroll
                    for (int n = 0; n < 2; ++n) acc[a][b][m][n] = (f32x4){0.f, 0.f, 0.f, 0.f};
        cur = nxt; cA = nA; cB = nB; ++ui;
#if ALIGN_EPI
        if (wr == 1) PG8_BAR;
#endif
    }
    PG8_WAIT_V(0);
#if !ALIGN_EPI
    if (wr == 0) PG8_BAR;
#endif
    PG8_BAR;
    if constexpr (Epi::AFTER_DRAIN) { E.fused(acc, cur, wr, wc, fr, fq, lds, wid, lane); S.done(cur); }
    PG8_STAMP();
    if (STAMP && wid == 0) { stamps[lane] = lane < nts ? (((unsigned long long)(unsigned)ts_hi << 32) | (unsigned)ts_lo) : 0ull;
        if (lane == 62) stamps[62] = rt_entry; if (lane == 63) stamps[63] = (unsigned long long)wall_clock64(); }
#undef PG8_STAMP
#undef PG8_SA
#undef PG8_SB
#undef PG8_STAGE
#undef PG8_LDA
#undef PG8_LDB
#undef PG8_MMA
#undef PG8_WAIT_V
#undef PG8_WAIT_L
#undef PG8_BAR
#undef PG8_SCHED
#undef PG8_STAGE_RS
}
}

#define LAS PG8_LAS
typedef unsigned short u16;
typedef unsigned char uchar;
using pg8::bf16x8; using pg8::f32x4; using pg8::u32x4; using pg8::cvt_pk_bf16;
typedef float f32x16 __attribute__((ext_vector_type(16)));
typedef unsigned u32x2 __attribute__((ext_vector_type(2)));
typedef int i32x4 __attribute__((ext_vector_type(4)));

constexpr int T_ = 65536, DM = 1024, SEQ = 2048, NB = 32, DFF = 2816, NTHR = 512;
constexpr int LDS_ST_OFF = 155648;
constexpr int LDS_BYTES = LDS_ST_OFF + 16;
constexpr size_t SZ_ABIN = 2ull * 2560 * 1024 * 2, SZ_ABOUT = 2ull * 1024 * 1024 * 2, SZ_CDIN = 2ull * 2048 * 1024 * 2, SZ_CDOUT = 2ull * 1024 * 1024 * 2,
                 SZ_GU = 4ull * 5632 * 1024 * 2, SZ_DOWN = 4ull * 1024 * 2816 * 2, SZ_G = 2ull * 2 * 512 * 4096 * 2;
constexpr size_t WS_ABIN = 0, WS_ABOUT = WS_ABIN + SZ_ABIN, WS_CDIN = WS_ABOUT + SZ_ABOUT, WS_CDOUT = WS_CDIN + SZ_CDIN, WS_GU = WS_CDOUT + SZ_CDOUT, WS_DOWN = WS_GU + SZ_GU,
                 WS_G = WS_DOWN + SZ_DOWN,
                 WS_H = WS_G + SZ_G,
                 WS_B = WS_H + (size_t)T_ * 1024 * 2,
                 WS_C = WS_B + (size_t)T_ * 2560 * 2,
                 WS_D = WS_C + (size_t)1536 * 32 * 2048 * 2,
                 WS_E = WS_D + (size_t)T_ * 1024 * 2,
                 WS_BAR = WS_E + (size_t)T_ * 1024 * 2,
                 WS_RSTD = WS_BAR + 16384,
                 WS_END = WS_RSTD + (size_t)T_ * 4;
static_assert(WS_END <= (1ull << 30), "workspace map exceeds 1 GiB");
static_assert((size_t)T_ * DFF * 2 <= WS_D - WS_B, "act does not fit B + C");

__device__ __forceinline__ float bflo(unsigned w) { return __uint_as_float(w << 16); }
__device__ __forceinline__ float bfhi(unsigned w) { return __uint_as_float(w & 0xffff0000u); }
__device__ __forceinline__ float bf2f(u16 v) { return __uint_as_float(((unsigned)v) << 16); }
__device__ __forceinline__ u16 f2bf(float f) { return (u16)(cvt_pk_bf16(f, 0.f) & 0xffffu); }
__device__ __forceinline__ float wave_sum(float v) {
#pragma unroll
    for (int o = 32; o >= 1; o >>= 1) v += __shfl_xor(v, o, 64);
    return v;
}

__device__ void wt_job(LAS uchar* lds, const float* __restrict__ W, int ldw, int K, int N, u16* __restrict__ out, int ldo, int mode, const float* __restrict__ gain, int& rot) {
    LAS float* tile = (LAS float*)lds;
    const int tid = opaque_tid(); const int nkq = K / 256, nnt = N / 64, nsteps = nkq * nnt;
    const int G = (int)gridDim.x; const int first = ((int)blockIdx.x + G - (rot % G)) % G; rot += nsteps;
    for (int ti = first; ti < nsteps; ti += G) {
        const int kq = ti % nkq, nt = ti / nkq; const int k0 = kq * 256, n0 = nt * 64;
        int sc0 = n0; if (mode == 1) { const int pn = n0 >> 8, r = n0 & 255; sc0 = (r < 128) ? (pn * 128 + r) : (DFF + pn * 128 + (r - 128)); }
        float4 v[8];
#pragma unroll
        for (int i = 0; i < 8; ++i) { const int idx = tid + i * 512; const int kk = idx >> 4, c4 = (idx & 15) * 4;
            v[i] = *(const float4*)(W + (size_t)(k0 + kk) * ldw + sc0 + c4); }
#pragma unroll
        for (int i = 0; i < 8; ++i) { const int idx = tid + i * 512; const int kk = idx >> 4, c4 = (idx & 15) * 4;
            const float gk = gain ? gain[k0 + kk] : 1.0f;
            tile[kk * 65 + c4 + 0] = v[i].x * gk; tile[kk * 65 + c4 + 1] = v[i].y * gk; tile[kk * 65 + c4 + 2] = v[i].z * gk; tile[kk * 65 + c4 + 3] = v[i].w * gk; }
        __syncthreads();
#pragma unroll
        for (int q = 0; q < 4; ++q) { const int nn = tid >> 3, kc = q * 64 + (tid & 7) * 8;
          float f0 = tile[(kc + 0) * 65 + nn], f1 = tile[(kc + 1) * 65 + nn], f2 = tile[(kc + 2) * 65 + nn], f3 = tile[(kc + 3) * 65 + nn];
          float f4 = tile[(kc + 4) * 65 + nn], f5 = tile[(kc + 5) * 65 + nn], f6 = tile[(kc + 6) * 65 + nn], f7 = tile[(kc + 7) * 65 + nn];
          u32x4 w; w.x = cvt_pk_bf16(f0, f1); w.y = cvt_pk_bf16(f2, f3); w.z = cvt_pk_bf16(f4, f5); w.w = cvt_pk_bf16(f6, f7);
          *(u32x4*)(out + (size_t)(n0 + nn) * ldo + k0 + kc) = w; }
        __syncthreads();
    }
}
__device__ void fold_job(const float* __restrict__ cw, const float* __restrict__ scale, const float* __restrict__ Wout, u16* __restrict__ out) {
    for (int idx = blockIdx.x * NTHR + opaque_tid(); idx < 512 * 128; idx += gridDim.x * NTHR) {
        const int k = idx >> 7, n0 = (idx & 127) * 8; const int g = k >> 7;
        const float* cwr = cw + (size_t)k * 128; const float* sc = scale + g * 128; const float* wr = Wout + (size_t)(g * 128) * 1024 + n0;
        float acc[8];
#pragma unroll
        for (int u = 0; u < 8; ++u) acc[u] = 0.f;
#pragma unroll 8
        for (int c2 = 0; c2 < 128; ++c2) { const float cf = cwr[c2] * sc[c2]; const float4 w0 = *(const float4*)(wr + (size_t)c2 * 1024), w1 = *(const float4*)(wr + (size_t)c2 * 1024 + 4);
            acc[0] += cf * w0.x; acc[1] += cf * w0.y; acc[2] += cf * w0.z; acc[3] += cf * w0.w; acc[4] += cf * w1.x; acc[5] += cf * w1.y; acc[6] += cf * w1.z; acc[7] += cf * w1.w; }
#pragma unroll
        for (int u = 0; u < 8; ++u) out[(size_t)(n0 + u) * 1024 + k] = f2bf(acc[u]);
    }
}
__device__ void filter_job(LAS uchar* lds, const float* __restrict__ w1a, const float* __restrict__ b1a, const float* __restrict__ freqa, const float* __restrict__ w2a,
                           const float* __restrict__ b2a, const float* __restrict__ w3a, const float* __restrict__ decaya, u16* __restrict__ Gall) {
    LAS float* h2 = (LAS float*)lds;
    LAS float* zf = h2 + 64 * 64;
    LAS float* h1 = zf + 64 * 33;
    LAS float* w3s = h2 + 64 * 64;
    const int tid = opaque_tid(), lane = tid & 63, wave = __builtin_amdgcn_readfirstlane(tid >> 6);
    for (int item = blockIdx.x; item < 256; item += gridDim.x) {
        const int j = item >> 7, tg = (item >> 2) & 31, cq = item & 3, t0 = tg * 64;
        const float* w1 = w1a + j * 33 * 64; const float* b1 = b1a + j * 64; const float* freq = freqa + j * 128; const float* w2 = w2a + j * 4096; const float* b2 = b2a + j * 64;
        const float* w3 = w3a + (size_t)j * 64 * 2048; const float* decay = decaya + j * 2048; u16* Gj = Gall + (size_t)j * 2 * 512 * 4096;
        float4 wpre[16];
#pragma unroll
        for (int i = 0; i < 16; ++i) { const int idx = tid + i * NTHR; wpre[i] = *(const float4*)(w3 + (size_t)(idx >> 7) * 2048 + cq * 512 + (idx & 127) * 4); }
        for (int idx = tid; idx < 64 * 33; idx += NTHR) { const int tt = idx / 33, f = idx - tt * 33; const float t = (float)(t0 + tt);
            float val;
            if (f == 0) val = t / 2047.0f;
            else { const int fi = (f - 1) & 15; const float band = 1e-4f + (float)fi * ((15.0f - 1e-4f) / 15.0f); const float w = 6.283185307179586f * t / 2048.0f; const float fw = w * band;
                   val = (f <= 16) ? cosf(fw) : -sinf(fw); }
            zf[idx] = val; }
        __syncthreads();
        for (int idx = tid; idx < 4096; idx += NTHR) { const int tt = idx >> 6, k = idx & 63; float acc = 0.f;
            for (int f = 0; f < 33; ++f) acc += zf[tt * 33 + f] * w1[f * 64 + k];
            h1[tt * 64 + k] = sinf(freq[k] * (acc + b1[k])); }
        __syncthreads();
        for (int idx = tid; idx < 4096; idx += NTHR) { const int tt = idx >> 6, k = idx & 63; float acc = 0.f;
            for (int k2 = 0; k2 < 64; ++k2) acc += h1[tt * 64 + k2] * w2[k2 * 64 + k];
            h2[k * 64 + tt] = sinf(freq[64 + k] * (acc + b2[k])); }
        __syncthreads();
#pragma unroll
        for (int i = 0; i < 16; ++i) { const int idx = tid + i * NTHR; f32x4 wv; wv.x = wpre[i].x; wv.y = wpre[i].y; wv.z = wpre[i].z; wv.w = wpre[i].w; *(LAS f32x4*)(w3s + (idx >> 7) * 512 + (idx & 127) * 4) = wv; }
        __syncthreads();
        { const int t = t0 + lane; const float t01 = (float)t / 2047.0f;
          for (int ci = 0; ci < 64; ci += 4) { const int cl = wave * 64 + ci, col = cq * 512 + cl; float a0 = 0.f, a1 = 0.f, a2 = 0.f, a3 = 0.f;
#pragma unroll 16
              for (int k = 0; k < 64; ++k) { const f32x4 w = *(const LAS f32x4*)(w3s + k * 512 + cl); const float hv = h2[k * 64 + lane]; a0 += hv * w.x; a1 += hv * w.y; a2 += hv * w.z; a3 += hv * w.w; }
              const float4 dc = *(const float4*)(decay + col);
              a0 *= expf(-t01 * fabsf(dc.x)); a1 *= expf(-t01 * fabsf(dc.y)); a2 *= expf(-t01 * fabsf(dc.z)); a3 *= expf(-t01 * fabsf(dc.w));
              const int dir = col >> 10, o = (col >> 9) & 1, c = col & 511; u16* g = Gj + (size_t)(o * 512 + c) * 4096;
              if (dir == 0) { g[2048 - t] = f2bf(a0); g[4096 + 2048 - t] = f2bf(a1); g[8192 + 2048 - t] = f2bf(a2); g[12288 + 2048 - t] = f2bf(a3);
                              if (t == 0) { g[0] = 0; g[4096] = 0; g[8192] = 0; g[12288] = 0; } }
              else if (t <= 2046) { g[2049 + t] = f2bf(a0); g[4096 + 2049 + t] = f2bf(a1); g[8192 + 2049 + t] = f2bf(a2); g[12288 + 2049 + t] = f2bf(a3); } } }
        __syncthreads();
    }
}

__device__ __forceinline__ void unpack8(const u32x4 v, float (&f)[8]) { f[0] = bflo(v.x); f[1] = bfhi(v.x); f[2] = bflo(v.y); f[3] = bfhi(v.y); f[4] = bflo(v.z); f[5] = bfhi(v.z); f[6] = bflo(v.w); f[7] = bfhi(v.w); }
__device__ __forceinline__ float4 ntload4(const float* p) { const f32x4 v = __builtin_nontemporal_load((const f32x4*)p); float4 r; r.x = v.x; r.y = v.y; r.z = v.z; r.w = v.w; return r; }
__device__ __forceinline__ void ntstore4(float* p, float a, float b, float c, float d) { f32x4 w; w.x = a; w.y = b; w.z = c; w.w = d; __builtin_nontemporal_store(w, (f32x4*)p); }
__device__ __forceinline__ void resid_pass(const float* __restrict__ xin_f, u16* __restrict__ xb, const u16* __restrict__ mix, const float* __restrict__ gpost, float* __restrict__ rstd_out, float* __restrict__ out_f) {
    const int tid = opaque_tid(); const int lane = tid & 63, wave = tid >> 6;
    const int stride = gridDim.x * 8;
    constexpr int NR = 4;
    for (int row0 = blockIdx.x * 8 + wave; row0 < T_; row0 += NR * stride) {
        float x[NR][16];
        if (xin_f) {
#pragma unroll
            for (int k = 0; k < NR; ++k) { const int row = min(row0 + k * stride, T_ - 1);
#pragma unroll
                for (int c = 0; c < 2; ++c) { const float4 a0 = ntload4(xin_f + (size_t)row * 1024 + c * 512 + lane * 8), a1 = ntload4(xin_f + (size_t)row * 1024 + c * 512 + lane * 8 + 4);
                    x[k][c * 8 + 0] = a0.x; x[k][c * 8 + 1] = a0.y; x[k][c * 8 + 2] = a0.z; x[k][c * 8 + 3] = a0.w; x[k][c * 8 + 4] = a1.x; x[k][c * 8 + 5] = a1.y; x[k][c * 8 + 6] = a1.z; x[k][c * 8 + 7] = a1.w; } }
        } else {
            u32x4 xr[NR][2], mr[NR][2];
#pragma unroll
            for (int k = 0; k < NR; ++k) { const int row = min(row0 + k * stride, T_ - 1);
#pragma unroll
                for (int c = 0; c < 2; ++c) { xr[k][c] = *(const u32x4*)(xb + (size_t)row * 1024 + c * 512 + lane * 8); mr[k][c] = __builtin_nontemporal_load((const u32x4*)(mix + (size_t)row * 1024 + c * 512 + lane * 8)); } }
            float g[16];
#pragma unroll
            for (int c = 0; c < 2; ++c) { const float4 a0 = *(const float4*)(gpost + c * 512 + lane * 8), a1 = *(const float4*)(gpost + c * 512 + lane * 8 + 4);
                g[c * 8 + 0] = a0.x; g[c * 8 + 1] = a0.y; g[c * 8 + 2] = a0.z; g[c * 8 + 3] = a0.w; g[c * 8 + 4] = a1.x; g[c * 8 + 5] = a1.y; g[c * 8 + 6] = a1.z; g[c * 8 + 7] = a1.w; }
#pragma unroll
            for (int k = 0; k < NR; ++k) { float m[16]; float ss = 0.f;
#pragma unroll
                for (int c = 0; c < 2; ++c) { float t8[8]; unpack8(mr[k][c], t8);
#pragma unroll
                    for (int e = 0; e < 8; ++e) { m[c * 8 + e] = t8[e]; ss += t8[e] * t8[e]; } }
                ss = wave_sum(ss); const float rstd = rsqrtf(ss * (1.0f / 1024.0f) + 1e-6f);
#pragma unroll
                for (int c = 0; c < 2; ++c) { float t8[8]; unpack8(xr[k][c], t8);
#pragma unroll
                    for (int e = 0; e < 8; ++e) x[k][c * 8 + e] = t8[e] + m[c * 8 + e] * rstd * g[c * 8 + e]; } }
        }
#pragma unroll
        for (int k = 0; k < NR; ++k) { const int row = row0 + k * stride;
            if (row < T_) {
                if (out_f) {
#pragma unroll
                    for (int c = 0; c < 2; ++c) { ntstore4(out_f + (size_t)row * 1024 + c * 512 + lane * 8, x[k][c * 8 + 0], x[k][c * 8 + 1], x[k][c * 8 + 2], x[k][c * 8 + 3]);
                        ntstore4(out_f + (size_t)row * 1024 + c * 512 + lane * 8 + 4, x[k][c * 8 + 4], x[k][c * 8 + 5], x[k][c * 8 + 6], x[k][c * 8 + 7]); }
                } else {
                    float ss = 0.f;
#pragma unroll
                    for (int e = 0; e < 16; ++e) ss += x[k][e] * x[k][e];
                    ss = wave_sum(ss);
                    if (lane == 0) rstd_out[row] = rsqrtf(ss * (1.0f / 1024.0f) + 1e-6f);
#pragma unroll
                    for (int c = 0; c < 2; ++c) { u32x4 w; w.x = cvt_pk_bf16(x[k][c * 8 + 0], x[k][c * 8 + 1]); w.y = cvt_pk_bf16(x[k][c * 8 + 2], x[k][c * 8 + 3]); w.z = cvt_pk_bf16(x[k][c * 8 + 4], x[k][c * 8 + 5]); w.w = cvt_pk_bf16(x[k][c * 8 + 6], x[k][c * 8 + 7]);
                        *(u32x4*)(xb + (size_t)row * 1024 + c * 512 + lane * 8) = w; }
                }
            }
        }
    }
}

constexpr int TRS = 66;
__device__ __forceinline__ void tr_tile8(LAS u16* tiles  , const u16* __restrict__ src, size_t lds_src, size_t src_ts, u16* __restrict__ dst, size_t ldd, size_t dst_ts) {
    const int tid = opaque_tid(), r = tid >> 3, ch = (tid & 7) * 8;
    u32x4 v[8];
#pragma unroll
    for (int k = 0; k < 8; ++k) v[k] = *(const u32x4*)(src + k * src_ts + (size_t)r * lds_src + ch);
#pragma unroll
    for (int k = 0; k < 8; ++k) { LAS u16* tile = tiles + k * 64 * TRS;
        tile[(ch + 0) * TRS + r] = (u16)(v[k].x & 0xffffu); tile[(ch + 1) * TRS + r] = (u16)(v[k].x >> 16);
        tile[(ch + 2) * TRS + r] = (u16)(v[k].y & 0xffffu); tile[(ch + 3) * TRS + r] = (u16)(v[k].y >> 16);
        tile[(ch + 4) * TRS + r] = (u16)(v[k].z & 0xffffu); tile[(ch + 5) * TRS + r] = (u16)(v[k].z >> 16);
        tile[(ch + 6) * TRS + r] = (u16)(v[k].w & 0xffffu); tile[(ch + 7) * TRS + r] = (u16)(v[k].w >> 16); }
    __syncthreads();
#pragma unroll
    for (int k = 0; k < 8; ++k) { const LAS unsigned* p = (const LAS unsigned*)(tiles + k * 64 * TRS + r * TRS + ch);
        u32x4 o; o.x = p[0]; o.y = p[1]; o.z = p[2]; o.w = p[3];
        *(u32x4*)(dst + k * dst_ts + (size_t)r * ldd + ch) = o; }
    __syncthreads();
}
__device__ void transpose_fwd_phase(LAS uchar* lds, const u16* __restrict__ proj, u16* __restrict__ pT) {
    LAS u16* tiles = (LAS u16*)lds;
    for (int it = blockIdx.x; it < NB * 32 * 3; it += gridDim.x) {
        const int c8 = it % 3, st = (it / 3) & 31, b = it / 96;
        tr_tile8(tiles, proj + (size_t)(b * SEQ + st * 64) * 2560 + 1024 + c8 * 512, 2560, 64, pT + ((size_t)(c8 * 512) * NB + b) * SEQ + st * 64, (size_t)NB * SEQ, (size_t)64 * NB * SEQ);
    }
}
__device__ void transpose_back_phase(LAS uchar* lds, const u16* __restrict__ yT, u16* __restrict__ ycat) {
    LAS u16* tiles = (LAS u16*)lds;
    for (int it = blockIdx.x; it < NB * 32; it += gridDim.x) {
        const int st = it & 31, b = it >> 5;
        tr_tile8(tiles, yT + (size_t)b * SEQ + st * 64, (size_t)NB * SEQ, (size_t)64 * NB * SEQ, ycat + (size_t)(b * SEQ + st * 64) * 1024 + 512, 1024, 64);
    }
}
__device__ void gating_phase(LAS uchar* lds, const u16* __restrict__ proj  , const float* __restrict__ ln_g  ,
                             const float* __restrict__ w_s  , const float* __restrict__ b_s  , u16* __restrict__ ycat  ) {
    LAS u16* vT = (LAS u16*)lds;
    LAS u16* wsb = vT + 128 * 136;
    LAS float* stats = (LAS float*)(wsb + 128 * 136);
    const int tid = opaque_tid(), lane = tid & 63, wave = tid >> 6, fr = lane & 15, fq = lane >> 4;
    for (int item = blockIdx.x; item < T_ / 128; item += gridDim.x) {
        const int tok0 = item * 128;
        { u32x4 vv[16];
#pragma unroll
          for (int tt = 0; tt < 16; ++tt) vv[tt] = *(const u32x4*)(proj + (size_t)(tok0 + wave * 16 + tt) * 1024 + 512 + lane * 8);
#pragma unroll
          for (int tt = 0; tt < 16; ++tt) { const int q = wave * 16 + tt; const u32x4 v = vv[tt];
            const float f0 = bflo(v.x), f1 = bfhi(v.x), f2 = bflo(v.y), f3 = bfhi(v.y), f4 = bflo(v.z), f5 = bfhi(v.z), f6 = bflo(v.w), f7 = bfhi(v.w);
            const float mean = wave_sum(f0 + f1 + f2 + f3 + f4 + f5 + f6 + f7) * (1.0f / 512.0f);
            const float d0 = f0 - mean, d1 = f1 - mean, d2 = f2 - mean, d3 = f3 - mean, d4 = f4 - mean, d5 = f5 - mean, d6 = f6 - mean, d7 = f7 - mean;
            const float var = wave_sum(d0 * d0 + d1 * d1 + d2 * d2 + d3 * d3 + d4 * d4 + d5 * d5 + d6 * d6 + d7 * d7) * (1.0f / 512.0f);
            if (lane == 0) { stats[q * 2] = mean; stats[q * 2 + 1] = rsqrtf(var + 1e-5f); } } }
        __syncthreads();
        u32x4 vreg[4]; float4 wreg[8];
#define GATE_LOAD(g) do { _Pragma("unroll") for (int i = 0; i < 4; ++i) { const int idx = tid + i * NTHR; vreg[i] = *(const u32x4*)(proj + (size_t)(tok0 + (idx >> 4)) * 1024 + 512 + (g) * 128 + (idx & 15) * 8); } \
                          _Pragma("unroll") for (int i = 0; i < 8; ++i) { const int idx = tid + i * NTHR; wreg[i] = *(const float4*)(w_s + (size_t)((g) * 128 + (idx >> 5)) * 128 + (idx & 31) * 4); } } while (0)
        GATE_LOAD(0);
#pragma unroll
        for (int g = 0; g < 4; ++g) {
#pragma unroll
            for (int i = 0; i < 4; ++i) { const int idx = tid + i * NTHR; const int q = idx >> 4, c0 = (idx & 15) * 8;
                const u32x4 v = vreg[i];
                const float mean = stats[q * 2], rstd = stats[q * 2 + 1];
                const float4 g0 = *(const float4*)(ln_g + g * 128 + c0), g1 = *(const float4*)(ln_g + g * 128 + c0 + 4);
                vT[(c0 + 0) * 136 + q] = f2bf((bflo(v.x) - mean) * rstd * g0.x); vT[(c0 + 1) * 136 + q] = f2bf((bfhi(v.x) - mean) * rstd * g0.y);
                vT[(c0 + 2) * 136 + q] = f2bf((bflo(v.y) - mean) * rstd * g0.z); vT[(c0 + 3) * 136 + q] = f2bf((bfhi(v.y) - mean) * rstd * g0.w);
                vT[(c0 + 4) * 136 + q] = f2bf((bflo(v.z) - mean) * rstd * g1.x); vT[(c0 + 5) * 136 + q] = f2bf((bfhi(v.z) - mean) * rstd * g1.y);
                vT[(c0 + 6) * 136 + q] = f2bf((bflo(v.w) - mean) * rstd * g1.z); vT[(c0 + 7) * 136 + q] = f2bf((bfhi(v.w) - mean) * rstd * g1.w); }
#pragma unroll
            for (int i = 0; i < 8; ++i) { const int idx = tid + i * NTHR; const int p = idx >> 5, q0 = (idx & 31) * 4;
                const float4 w = wreg[i];
                u32x2 o; o.x = cvt_pk_bf16(w.x, w.y); o.y = cvt_pk_bf16(w.z, w.w);
                *(LAS u32x2*)(wsb + p * 136 + q0) = o; }
            __syncthreads();
            if (g < 3) GATE_LOAD(g + 1);
            const int p = 16 * wave + fr; const size_t tok = (size_t)(tok0 + p); const float bias = b_s[g * 128 + p];
            u32x2 uu[8];
#pragma unroll
            for (int mi = 0; mi < 8; ++mi) uu[mi] = *(const u32x2*)(proj + tok * 1024 + g * 128 + 16 * mi + 4 * fq);
            f32x4 acc[8];
#pragma unroll
            for (int mi = 0; mi < 8; ++mi) acc[mi] = (f32x4){0.f, 0.f, 0.f, 0.f};
#pragma unroll
            for (int kk = 0; kk < 4; ++kk) {
                const bf16x8 bfrag = *(const LAS bf16x8*)(wsb + (16 * wave + fr) * 136 + 32 * kk + 8 * fq);
#pragma unroll
                for (int mi = 0; mi < 8; ++mi) { const bf16x8 afrag = *(const LAS bf16x8*)(vT + (16 * mi + fr) * 136 + 32 * kk + 8 * fq);
                    acc[mi] = __builtin_amdgcn_mfma_f32_16x16x32_bf16(afrag, bfrag, acc[mi], 0, 0, 0); }
            }
#pragma unroll
            for (int mi = 0; mi < 8; ++mi) { const int c = 16 * mi + 4 * fq;
                u32x2 o; o.x = cvt_pk_bf16(bflo(uu[mi].x) * (acc[mi][0] + bias), bfhi(uu[mi].x) * (acc[mi][1] + bias)); o.y = cvt_pk_bf16(bflo(uu[mi].y) * (acc[mi][2] + bias), bfhi(uu[mi].y) * (acc[mi][3] + bias));
                *(u32x2*)(ycat + tok * 1024 + g * 128 + c) = o; }
            __syncthreads();
        }
#undef GATE_LOAD
    }
}

constexpr int HZ_ROW = 4112;
constexpr int HZ_KR0 = NB * HZ_ROW;
constexpr int HZ_KRC = 8208;
static_assert(HZ_KR0 + 2 * HZ_KRC <= LDS_ST_OFF, "hyena LDS");

__device__ __forceinline__ void hy_load_kr(LAS uchar* lds, const u16* __restrict__ g) {
    const int tid = opaque_tid();
    const u32x4 w = *(const u32x4*)(g + tid * 8);
    const unsigned nxt = (tid < 511) ? (unsigned)g[tid * 8 + 8] : 0u;
    *(LAS u32x4*)(lds + HZ_KR0 + tid * 16) = w;
    u32x4 s; s.x = (w.x >> 16) | (w.y << 16); s.y = (w.y >> 16) | (w.z << 16); s.z = (w.z >> 16) | (w.w << 16); s.w = (w.w >> 16) | (nxt << 16);
    *(LAS u32x4*)(lds + HZ_KR0 + HZ_KRC + tid * 16) = s;
}
__device__ __forceinline__ void conv3_8(const u16* __restrict__ p, int s0, float w0, float w1, float w2, float (&o)[8]) {
    const u32x4 v = *(const u32x4*)(p + s0);
    const float prev = (s0 > 0) ? bf2f(p[s0 - 1]) : 0.f, next = (s0 + 8 < SEQ) ? bf2f(p[s0 + 8]) : 0.f;
    const float x0 = bflo(v.x), x1 = bfhi(v.x), x2 = bflo(v.y), x3 = bfhi(v.y), x4 = bflo(v.z), x5 = bfhi(v.z), x6 = bflo(v.w), x7 = bfhi(v.w);
    o[0] = w0 * prev + w1 * x0 + w2 * x1; o[1] = w0 * x0 + w1 * x1 + w2 * x2; o[2] = w0 * x1 + w1 * x2 + w2 * x3; o[3] = w0 * x2 + w1 * x3 + w2 * x4;
    o[4] = w0 * x3 + w1 * x4 + w2 * x5; o[5] = w0 * x4 + w1 * x5 + w2 * x6; o[6] = w0 * x5 + w1 * x6 + w2 * x7; o[7] = w0 * x6 + w1 * x7 + w2 * next;
}
__device__ void hyena_phase(LAS uchar* lds, const u16* __restrict__ pT  , const u16* __restrict__ G  , const float* __restrict__ conv_w  ,
                            const float* __restrict__ skip  , u16* __restrict__ yT  ) {
    const int tid = opaque_tid(), lane = tid & 63, wave = __builtin_amdgcn_readfirstlane(tid >> 6), r = lane & 31, h = lane >> 5;
    const int tbase = 256 * wave;
    const int e0 = 8 * h - r + 2048 - tbase, par = e0 & 1;
    const LAS uchar* abase = lds + HZ_KR0 + par * HZ_KRC + (e0 - par) * 2;
    const LAS uchar* bbase = lds + r * HZ_ROW + 16 * h;
    for (int c = blockIdx.x; c < 512; c += gridDim.x) {
        {
            const u16* src = pT + (size_t)c * NB * SEQ; const float w0 = conv_w[c], w1 = conv_w[1536 + c], w2 = conv_w[3072 + c];
#pragma unroll 8
            for (int it = 0; it < 16; ++it) { const int idx = tid + it * NTHR; const int b = idx >> 8, s0 = (idx & 255) * 8; float o[8];
                conv3_8(src + (size_t)b * SEQ, s0, w0, w1, w2, o);
                u32x4 w; w.x = cvt_pk_bf16(o[0], o[1]); w.y = cvt_pk_bf16(o[2], o[3]); w.z = cvt_pk_bf16(o[4], o[5]); w.w = cvt_pk_bf16(o[6], o[7]);
                *(LAS u32x4*)(lds + b * HZ_ROW + s0 * 2) = w; }
            hy_load_kr(lds, G + (size_t)c * 4096);
        }
        __syncthreads();
#pragma unroll 1
        for (int o = 0; o < 2; ++o) {
            f32x16 acc[8];
#pragma unroll
            for (int i = 0; i < 8; ++i)
#pragma unroll
                for (int k = 0; k < 16; ++k) acc[i][k] = 0.f;
#pragma unroll 1
            for (int p = 0; p < 2; ++p) {
                bf16x8 W[8];
#pragma unroll
                for (int k = 1; k < 8; ++k) { const LAS unsigned* ap = (const LAS unsigned*)(abase + (16 * p - 32 * k) * 2);
                    i32x4 av; av.x = (int)ap[0]; av.y = (int)ap[1]; av.z = (int)ap[2]; av.w = (int)ap[3]; W[8 - k] = __builtin_bit_cast(bf16x8, av); }
#pragma unroll 1
                for (int J = 0; J < 8; ++J) {
                    const LAS uchar* aj = abase + (16 * p + 256 * J) * 2;
                    const LAS uchar* bj = bbase + (16 * p + 256 * J) * 2;
#pragma unroll
                    for (int jj = 0; jj < 8; ++jj) {
                        const LAS unsigned* ap = (const LAS unsigned*)(aj + 64 * jj);
                        i32x4 av; av.x = (int)ap[0]; av.y = (int)ap[1]; av.z = (int)ap[2]; av.w = (int)ap[3]; W[jj] = __builtin_bit_cast(bf16x8, av);
                        const bf16x8 bb = *(const LAS bf16x8*)(bj + 64 * jj);
#pragma unroll
                        for (int i = 0; i < 8; ++i) acc[i] = __builtin_amdgcn_mfma_f32_32x32x16_bf16(W[(jj - i) & 7], bb, acc[i], 0, 0, 0);
                    }
                }
            }
            { const int cc = 512 * (o + 1) + c; const float w0 = conv_w[cc], w1 = conv_w[1536 + cc], w2 = conv_w[3072 + cc]; const float sk = skip[o * 512 + c];
              const u16* p0 = pT + ((size_t)cc * NB + r) * SEQ + tbase + 4 * h;
              const LAS uchar* z0 = lds + r * HZ_ROW + (tbase + 4 * h) * 2;
              const int tl = tbase + 4 * h;
#pragma unroll
              for (int i = 0; i < 8; ++i) {
                  if ((i & 3) == 0) __builtin_amdgcn_sched_barrier(0);
#pragma unroll
                  for (int q = 0; q < 4; ++q) { const int off = 32 * i + 8 * q;
                      const u32x2 zz = *(const LAS u32x2*)(z0 + off * 2);
                      const u32x2 gv = *(const u32x2*)(p0 + off);
                      const float um = bf2f(p0[off - 1]), up = bf2f(p0[off + 4]);
                      const float gm = (tl + off > 0) ? um : 0.f, gp = (tl + off + 4 < SEQ) ? up : 0.f;
                      const float g0 = bflo(gv.x), g1 = bfhi(gv.x), g2 = bflo(gv.y), g3 = bfhi(gv.y);
                      acc[i][4 * q + 0] = (w0 * gm + w1 * g0 + w2 * g1) * (acc[i][4 * q + 0] + sk * bflo(zz.x));
                      acc[i][4 * q + 1] = (w0 * g0 + w1 * g1 + w2 * g2) * (acc[i][4 * q + 1] + sk * bfhi(zz.x));
                      acc[i][4 * q + 2] = (w0 * g1 + w1 * g2 + w2 * g3) * (acc[i][4 * q + 2] + sk * bflo(zz.y));
                      acc[i][4 * q + 3] = (w0 * g2 + w1 * g3 + w2 * gp) * (acc[i][4 * q + 3] + sk * bfhi(zz.y)); } } }
            __syncthreads();
#pragma unroll
            for (int i = 0; i < 8; ++i)
#pragma unroll
                for (int q = 0; q < 4; ++q) {
                    u32x2 w; w.x = cvt_pk_bf16(acc[i][4 * q + 0], acc[i][4 * q + 1]); w.y = cvt_pk_bf16(acc[i][4 * q + 2], acc[i][4 * q + 3]);
                    *(LAS u32x2*)(lds + r * HZ_ROW + (tbase + 4 * h) * 2 + (32 * i + 8 * q) * 2) = w; }
            if (o == 0) hy_load_kr(lds, G + (size_t)(512 + c) * 4096);
            __syncthreads();
        }
        for (int idx = tid; idx < NB * 256; idx += NTHR) { const int b = idx >> 8, s0 = (idx & 255) * 8;
            *(u32x4*)(yT + ((size_t)c * NB + b) * SEQ + s0) = *(const LAS u32x4*)(lds + b * HZ_ROW + s0 * 2); }
        __syncthreads();
    }
}

__device__ __forceinline__ u32x4 pack8(const float (&o)[8]) { u32x4 w; w.x = cvt_pk_bf16(o[0], o[1]); w.y = cvt_pk_bf16(o[2], o[3]); w.z = cvt_pk_bf16(o[4], o[5]); w.w = cvt_pk_bf16(o[6], o[7]); return w; }
template <int W> __device__ __forceinline__ void pool_unit(const u16* __restrict__ seq  , int t0, u16* __restrict__ out  ) {
    constexpr int LEFT = W / 2, RIGHT = W - LEFT - 1, NR = 8 + W - 1;
    u32x4 rows[NR];
#pragma unroll
    for (int k = 0; k < NR; ++k) { const int p = t0 - LEFT + k; const int pc = min(max(p, 0), SEQ - 1);
        const u32x4 v = *(const u32x4*)(seq + (size_t)pc * 2048); const bool ok = (p >= 0 && p < SEQ);
        rows[k].x = ok ? v.x : 0u; rows[k].y = ok ? v.y : 0u; rows[k].z = ok ? v.z : 0u; rows[k].w = ok ? v.w : 0u; }
    float sm[8];
#pragma unroll
    for (int c = 0; c < 8; ++c) sm[c] = 0.f;
#pragma unroll
    for (int k = 0; k < W; ++k) { float f[8]; unpack8(rows[k], f);
#pragma unroll
        for (int c = 0; c < 8; ++c) sm[c] += f[c]; }
#pragma unroll
    for (int i = 0; i < 8; ++i) { const int t = t0 + i; const int lo = max(t - LEFT, 0), hi = min(t + RIGHT, SEQ - 1); const float inv = 1.0f / (float)(hi - lo + 1);
        float ctr[8], o[8]; unpack8(rows[i + LEFT], ctr);
#pragma unroll
        for (int c = 0; c < 8; ++c) o[c] = sm[c] * inv - ctr[c];
        *(u32x4*)(out + (size_t)t * 1024) = pack8(o);
        if (i < 7) { float fa[8], fs[8]; unpack8(rows[i + W], fa); unpack8(rows[i], fs);
#pragma unroll
            for (int c = 0; c < 8; ++c) sm[c] += fa[c] - fs[c]; } }
}
__device__ __forceinline__ void dconv_unit(const u16* __restrict__ seq  , int t0, const float* __restrict__ dconv  , u16* __restrict__ out  ) {
    u32x4 cr[10], hr[10], br[8];
#pragma unroll
    for (int k = 0; k < 10; ++k) { const int p = t0 - 1 + k; const int pc = min(max(p, 0), SEQ - 1);
        const u32x4 v = *(const u32x4*)(seq + (size_t)pc * 2048 + 1024); hr[k] = *(const u32x4*)(seq + (size_t)pc * 2048 + 1536); const bool ok = (p >= 0 && p < SEQ);
        cr[k].x = ok ? v.x : 0u; cr[k].y = ok ? v.y : 0u; cr[k].z = ok ? v.z : 0u; cr[k].w = ok ? v.w : 0u; }
#pragma unroll
    for (int i = 0; i < 8; ++i) br[i] = *(const u32x4*)(seq + (size_t)(t0 + i) * 2048 + 512);
    float w0[8], w1[8], w2[8];
    { const float4 a0 = *(const float4*)(dconv), a1 = *(const float4*)(dconv + 4), b0 = *(const float4*)(dconv + 512), b1 = *(const float4*)(dconv + 516), c0 = *(const float4*)(dconv + 1024), c1 = *(const float4*)(dconv + 1028);
      w0[0] = a0.x; w0[1] = a0.y; w0[2] = a0.z; w0[3] = a0.w; w0[4] = a1.x; w0[5] = a1.y; w0[6] = a1.z; w0[7] = a1.w;
      w1[0] = b0.x; w1[1] = b0.y; w1[2] = b0.z; w1[3] = b0.w; w1[4] = b1.x; w1[5] = b1.y; w1[6] = b1.z; w1[7] = b1.w;
      w2[0] = c0.x; w2[1] = c0.y; w2[2] = c0.z; w2[3] = c0.w; w2[4] = c1.x; w2[5] = c1.y; w2[6] = c1.z; w2[7] = c1.w; }
    float pm[8], pc_[8], pn[8];
    { float c[8], h[8]; unpack8(cr[0], c); unpack8(hr[0], h);
#pragma unroll
      for (int k = 0; k < 8; ++k) pm[k] = c[k] * h[k];
      unpack8(cr[1], c); unpack8(hr[1], h);
#pragma unroll
      for (int k = 0; k < 8; ++k) pc_[k] = c[k] * h[k]; }
#pragma unroll
    for (int i = 0; i < 8; ++i) { float c[8], h[8], bb[8], o[8]; unpack8(cr[i + 2], c); unpack8(hr[i + 2], h); unpack8(br[i], bb);
#pragma unroll
        for (int k = 0; k < 8; ++k) { pn[k] = c[k] * h[k]; o[k] = bb[k] * (w0[k] * pm[k] + w1[k] * pc_[k] + w2[k] * pn[k]); pm[k] = pc_[k]; pc_[k] = pn[k]; }
        *(u32x4*)(out + (size_t)(t0 + i) * 1024) = pack8(o); }
}
__device__ void stencil_phase(const u16* __restrict__ proj  , const float* __restrict__ dconv  , u16* __restrict__ ycat  ) {
    const int tid = opaque_tid(), lane = tid & 63, wave = __builtin_amdgcn_readfirstlane(tid >> 6);
    const int chl = (lane & 15) * 8, run = lane >> 4;
    for (int wu = blockIdx.x * 8 + wave; wu < (T_ / 32) * 8; wu += gridDim.x * 8) {
        const int rq = wu >> 3, kind = wu & 7; const int tok0 = rq * 32 + run * 8; const int t0 = tok0 & (SEQ - 1); const size_t s0 = (size_t)(tok0 - t0);
        if (kind < 4) { const int ch0 = kind * 128 + chl; const u16* seq = proj + s0 * 2048 + ch0; u16* out = ycat + s0 * 1024 + ch0;
            if (kind == 0) pool_unit<2>(seq, t0, out); else if (kind == 1) pool_unit<4>(seq, t0, out); else if (kind == 2) pool_unit<8>(seq, t0, out); else pool_unit<16>(seq, t0, out);
        } else { const int ch0 = (kind - 4) * 128 + chl; dconv_unit(proj + s0 * 2048 + ch0, t0, dconv + ch0, ycat + s0 * 1024 + 512 + ch0); }
    }
}


#define XB_TMO      128
#define XB_XCNT(j)  (256  + 64 * (j))
#define XB_XSUB(j)  (1280 + 64 * (j))
#define XB_XGEN(j)  (2304 + 64 * (j))
#define XB_TOP      3328
#define XB_TOPGEN   3392
#define XCD_BAR_WORDS 3456
#define XB_SPIN_CAP (1u << 20)
__device__ __forceinline__ unsigned xb_ld(unsigned* p)              { return __hip_atomic_load(p, __ATOMIC_RELAXED, __HIP_MEMORY_SCOPE_AGENT); }
__device__ __forceinline__ unsigned xb_add(unsigned* p, unsigned v) { return __hip_atomic_fetch_add(p, v, __ATOMIC_RELAXED, __HIP_MEMORY_SCOPE_AGENT); }
__device__ __forceinline__ unsigned xb_xcc_id() { return (unsigned)__builtin_amdgcn_s_getreg((3 << 11) | 20) & 0xFu; }
#define XB_SPIN(cond, bar) do { unsigned _sp = 0; while (cond) { __builtin_amdgcn_s_sleep(1); \
    if ((++_sp & 255u) == 0u) { if (xb_ld(&(bar)[XB_TMO])) break; if (_sp > XB_SPIN_CAP) { atomicAdd(&(bar)[XB_TMO], 1u); break; } } } } while (0)
struct XcdBarrier { unsigned* bar; unsigned x; volatile LAS unsigned* st; };
__device__ __forceinline__ XcdBarrier xcd_barrier_post(unsigned* bar, volatile LAS unsigned* st) {
    XcdBarrier b; b.bar = bar; b.x = xb_xcc_id(); b.st = st;
    if (threadIdx.x == 0) (void)xb_add(&bar[XB_XCNT(b.x)], 1u);
    return b;
}
__device__ __forceinline__ void xcd_barrier_complete(unsigned* bar, unsigned x, unsigned& nloc, unsigned& nx) {
    const unsigned G = gridDim.x * gridDim.y * gridDim.z;
    unsigned sum, cnt, mine, sp = 0u;
    for (;;) {
        sum = 0u; cnt = 0u; mine = 0u;
#pragma unroll
        for (unsigned j = 0; j < 16; ++j) { const unsigned c = xb_ld(&bar[XB_XCNT(j)]); sum += c; cnt += (c > 0u) ? 1u : 0u; mine = (j == x) ? c : mine; }
        if (sum == G) break;
        __builtin_amdgcn_s_sleep(1);
        if ((++sp & 255u) == 0u) { if (xb_ld(&bar[XB_TMO])) break; if (sp > XB_SPIN_CAP) { atomicAdd(&bar[XB_TMO], 1u); break; } }
    }
    nloc = mine > 0u ? mine : 1u; nx = cnt > 0u ? cnt : 1u;
}
__device__ __forceinline__ void xcd_barrier(const XcdBarrier& b) {
    asm volatile("s_waitcnt vmcnt(0)" ::: "memory");
    __syncthreads();
    if (threadIdx.x == 0) {
        unsigned* bar = b.bar;
        __builtin_amdgcn_s_waitcnt(0);
        unsigned nloc = b.st[0], nx = b.st[1];
        if (nloc == 0u) { xcd_barrier_complete(bar, b.x, nloc, nx); b.st[0] = nloc; b.st[1] = nx; }
        const unsigned old = xb_add(&bar[XB_XSUB(b.x)], 1u);
        const unsigned gen = old / nloc;
        if (old + 1u == (gen + 1u) * nloc) {
            __builtin_amdgcn_fence(__ATOMIC_RELEASE, "agent");
            asm volatile("s_waitcnt vmcnt(0)" ::: "memory");
            const unsigned og = xb_add(&bar[XB_TOP], 1u);
            const unsigned tg = og / nx;
            if (og + 1u == (tg + 1u) * nx) xb_add(&bar[XB_TOPGEN], 1u);
            else XB_SPIN(xb_ld(&bar[XB_TOPGEN]) == tg, bar);
            __builtin_amdgcn_fence(__ATOMIC_ACQUIRE, "agent");
            xb_add(&bar[XB_XGEN(b.x)], 1u);
            asm volatile("s_waitcnt vmcnt(0)" ::: "memory");
        } else {
            XB_SPIN(xb_ld(&bar[XB_XGEN(b.x)]) == gen, bar);
            __builtin_amdgcn_fence(__ATOMIC_ACQUIRE, "agent");
            asm volatile("s_waitcnt vmcnt(0)" ::: "memory");
        }
    }
    __syncthreads();
}

constexpr int NPH = 1 + 2 * 8 + 2 * 7;
struct Args { const float* in[23]; float* out; uchar* ws; int lo, hi; };

__global__ void __launch_bounds__(NTHR, 2) fwd_kernel(Args a) {
    extern __shared__ __attribute__((aligned(16))) uchar lds_raw[];
    LAS uchar* lds = (LAS uchar*)lds_raw;
    cg::grid_group grid = cg::this_grid();
    const int lo = a.lo, hi = a.hi; int ph = 0;
    volatile LAS unsigned* xst = (volatile LAS unsigned*)(lds + LDS_ST_OFF);
    if (threadIdx.x == 0) { xst[0] = 0u; xst[1] = 0u; }
    __syncthreads();
    XcdBarrier xb = xcd_barrier_post((unsigned*)(a.ws + WS_BAR), xst);
#define PH_BEGIN if (ph >= lo && ph < hi) {
#define PH_END } if (ph >= lo && ph + 1 < hi) { if (lo < 0) grid.sync();   xcd_barrier(xb); if (DBL(11) == 2) { xcd_barrier(xb); xcd_barrier(xb); } } ++ph;
    uchar* ws = a.ws;
    u16* Wabin = (u16*)(ws + WS_ABIN); u16* Wabout = (u16*)(ws + WS_ABOUT); u16* Wcdin = (u16*)(ws + WS_CDIN); u16* Wcdout = (u16*)(ws + WS_CDOUT);
    u16* Wgu = (u16*)(ws + WS_GU); u16* Wdown = (u16*)(ws + WS_DOWN); u16* Gf = (u16*)(ws + WS_G);
    u16* H = (u16*)(ws + WS_H); u16* PROJ = (u16*)(ws + WS_B); u16* YT = (u16*)(ws + WS_B + (size_t)T_ * 1024 * 2);     u16* ACT = (u16*)(ws + WS_B); u16* PT = (u16*)(ws + WS_C);
    u16* YCAT = (u16*)(ws + WS_D); u16* MIX = (u16*)(ws + WS_E); float* RSTD = (float*)(ws + WS_RSTD);
    const float* x_in = a.in[0]; const float* norm_g = a.in[1]; float* X = a.out;

    PH_BEGIN
      for (int rep = 0; rep < DBL(0); ++rep) {
        int rot = 0;
        filter_job(lds, a.in[10], a.in[11], a.in[12], a.in[13], a.in[14], a.in[15], a.in[16], Gf);
        for (int j = 0; j < 2; ++j) {
            wt_job(lds, a.in[4] + (size_t)j * 1024 * 2560, 2560, 1024, 2560, Wabin + (size_t)j * 2560 * 1024, 1024, 0, norm_g + (size_t)(2 * j) * 4 * 1024, rot);
            wt_job(lds, a.in[5] + (size_t)j * 1024 * 1024, 1024, 1024, 1024, Wabout + (size_t)j * 1024 * 1024, 1024, 0, nullptr, rot);
            wt_job(lds, a.in[18] + (size_t)j * 1024 * 2048, 2048, 1024, 2048, Wcdin + (size_t)j * 2048 * 1024, 1024, 0, norm_g + (size_t)(2 * j + 1) * 4 * 1024, rot);
            wt_job(lds, a.in[19] + (size_t)j * 1024 * 1024 + 512 * 1024, 1024, 512, 1024, Wcdout + (size_t)j * 1024 * 1024 + 512, 1024, 0, nullptr, rot);
            fold_job(a.in[20] + (size_t)j * 4 * 128 * 128, a.in[21] + j * 512, a.in[19] + (size_t)j * 1024 * 1024, Wcdout + (size_t)j * 1024 * 1024);
        }
        for (int i = 0; i < 4; ++i) {
            wt_job(lds, a.in[2] + (size_t)i * 1024 * 5632, 5632, 1024, 5632, Wgu + (size_t)i * 5632 * 1024, 1024, 1, norm_g + (size_t)(i * 4 + 2) * 1024, rot);
            wt_job(lds, a.in[3] + (size_t)i * 2816 * 1024, 1024, 2816, 1024, Wdown + (size_t)i * 1024 * 2816, 2816, 0, nullptr, rot);
        }
      }
        resid_pass(x_in, H, nullptr, nullptr, RSTD, nullptr);
    PH_END

#pragma unroll 1
    for (int i = 0; i < 4; ++i) {
        const int j = i >> 1; const bool even = (i & 1) == 0;
        const float* g4 = norm_g + (size_t)i * 4 * 1024;
        PH_BEGIN
            { const int N = even ? 1024 : 2048;
              pg8::Gemm g{H, even ? Wabin + (size_t)j * 2560 * 1024 : Wcdin + (size_t)j * 2048 * 1024, T_, N, 1024};
              pg8::StaticOrder S; S.init(T_, N, (int)gridDim.x, (int)blockIdx.x);
              pg8::EpiBf16G E{PROJ, N, even ? 4 : 0, RSTD};
#ifndef SKIP_G1
              for (int rep = 0; rep < DBL(6); ++rep) pg8::gemm_phase<pg8::EpiBf16G, pg8::StaticOrder, false>(lds, g, S, E, nullptr);
#endif
            }
            if (even) {
              pg8::Gemm g{H, Wabin + (size_t)j * 2560 * 1024 + (size_t)1024 * 1024, T_, 1536, 1024};
              pg8::StaticOrder S; S.init(T_, 1536, (int)gridDim.x, (int)blockIdx.x);
              pg8::EpiPT E{PT, RSTD};
              pg8::gemm_phase<pg8::EpiPT, pg8::StaticOrder, false>(lds, g, S, E, nullptr);
            }
        PH_END
        if (even) {
            PH_BEGIN
                for (int rep = 0; rep < DBL(1); ++rep) gating_phase(lds, PROJ, a.in[6] + j * 512, a.in[7] + (size_t)j * 4 * 128 * 128, a.in[8] + j * 512, YCAT);
                for (int rep = 0; rep < DBL(3); ++rep) hyena_phase(lds, PT, Gf + (size_t)j * 2 * 512 * 4096, a.in[9] + (size_t)j * 3 * 1536, a.in[17] + j * 1024, YT);
            PH_END
            PH_BEGIN
                for (int rep = 0; rep < DBL(4); ++rep) transpose_back_phase(lds, YT, YCAT);
            PH_END
        } else {
            PH_BEGIN
                for (int rep = 0; rep < DBL(5); ++rep) stencil_phase(PROJ, a.in[22] + (size_t)j * 3 * 512, YCAT);
            PH_END
        }
        PH_BEGIN
            pg8::Gemm g{YCAT, even ? Wabout + (size_t)j * 1024 * 1024 : Wcdout + (size_t)j * 1024 * 1024, T_, 1024, 1024};
            pg8::StaticOrder S; S.init(T_, 1024, (int)gridDim.x, (int)blockIdx.x);
            pg8::EpiBf16G E{MIX, 1024, 0, nullptr};

#ifndef SKIP_G2
            for (int rep = 0; rep < DBL(7); ++rep) pg8::gemm_phase<pg8::EpiBf16G, pg8::StaticOrder, false>(lds, g, S, E, nullptr);
#endif
        PH_END
        PH_BEGIN
            if (DBL(10) == 2) resid_pass(nullptr, (u16*)(ws + WS_C), MIX, g4 + 1024, (float*)(ws + WS_B), nullptr);
            resid_pass(nullptr, H, MIX, g4 + 1024, RSTD, nullptr);
        PH_END
        PH_BEGIN
            pg8::Gemm g{H, Wgu + (size_t)i * 5632 * 1024, T_, 5632, 1024};
            pg8::StaticOrder S; S.init(T_, 5632, (int)gridDim.x, (int)blockIdx.x);
            pg8::EpiSwiGLU E{ACT, DFF, RSTD};

#ifndef SKIP_G3
            for (int rep = 0; rep < DBL(8); ++rep) pg8::gemm_phase<pg8::EpiSwiGLU, pg8::StaticOrder, false>(lds, g, S, E, nullptr);
#endif
        PH_END
        PH_BEGIN
            pg8::Gemm g{ACT, Wdown + (size_t)i * 1024 * 2816, T_, 1024, DFF};
            pg8::StaticOrder S; S.init(T_, 1024, (int)gridDim.x, (int)blockIdx.x);
            pg8::EpiBf16G E{MIX, 1024, 0, nullptr};

#ifndef SKIP_G4
            for (int rep = 0; rep < DBL(9); ++rep) pg8::gemm_phase<pg8::EpiBf16G, pg8::StaticOrder, false>(lds, g, S, E, nullptr);
#endif
        PH_END
        PH_BEGIN
            if (DBL(10) == 2) resid_pass(nullptr, (u16*)(ws + WS_C), MIX, g4 + 3072, (float*)(ws + WS_B), nullptr);
            resid_pass(nullptr, H, MIX, g4 + 3072, RSTD, (i == 3) ? X : nullptr);
        PH_END
    }
#undef PH_BEGIN
#undef PH_END
}

extern "C" void kernel_launch(void* const* d_in, const int* in_sizes, int n_in, void* d_out, int out_size, void* d_ws, size_t ws_size, hipStream_t stream) {
    static int grid = 0;
    if (grid == 0) {
        if (n_in != 23 || out_size != T_ * DM || ws_size < WS_END) { fprintf(stderr, "kernel_launch: unexpected problem (n_in %d out %d ws %zu)\n", n_in, out_size, ws_size); grid = -1; return; }
        int dev = 0, cus = 0, per_cu = 0;
        (void)hipGetDevice(&dev); (void)hipDeviceGetAttribute(&cus, hipDeviceAttributeMultiprocessorCount, dev);
        if (hipFuncSetAttribute((const void*)fwd_kernel, hipFuncAttributeMaxDynamicSharedMemorySize, LDS_BYTES) != hipSuccess) { fprintf(stderr, "kernel_launch: hipFuncSetAttribute failed\n"); grid = -1; return; }
        if (hipOccupancyMaxActiveBlocksPerMultiprocessor(&per_cu, (const void*)fwd_kernel, NTHR, LDS_BYTES) != hipSuccess || per_cu < 1) { fprintf(stderr, "kernel_launch: occupancy query gave %d\n", per_cu); per_cu = 1; }
        (void)hipGetLastError();
        grid = cus * per_cu;
        fprintf(stderr, "kernel_launch: grid %d (cus %d x %d)\n", grid, cus, per_cu);
    }
    if (grid < 0) return;
    Args a{};
    for (int i = 0; i < 23; ++i) a.in[i] = (const float*)d_in[i];
    a.out = (float*)d_out; a.ws = (uchar*)d_ws;
#if ONE_LAUNCH
    (void)hipMemsetAsync((char*)d_ws + WS_BAR, 0, XCD_BAR_WORDS * 4, stream);
    a.lo = 0; a.hi = NPH;
    void* args[] = {&a};
    hipError_t e = hipLaunchCooperativeKernel((const void*)fwd_kernel, dim3(grid), dim3(NTHR), args, LDS_BYTES, stream);
    if (e != hipSuccess) fprintf(stderr, "kernel_launch: cooperative launch failed: %s (grid %d)\n", hipGetErrorString(e), grid);
#else
    for (int p = 0; p < NPH; ++p) { a.lo = p; a.hi = p + 1;
        hipLaunchKernelGGL(fwd_kernel, dim3(grid), dim3(NTHR), LDS_BYTES, stream, a); }
#endif
}
```

```cpp
#include <hip/hip_runtime.h>
#include <hip/hip_cooperative_groups.h>
#include <cstdio>
namespace cg = cooperative_groups;

#ifndef ONE_LAUNCH
#define ONE_LAUNCH 1
#endif
#ifndef DBL_MASK
#define DBL_MASK 0
#endif
#ifndef ALIGN_EPI
#define ALIGN_EPI 1
#endif
#ifndef USE_SP2
#define USE_SP2 1
#endif
#define DBL(bit) (((DBL_MASK >> (bit)) & 1) ? 2 : 1)

__device__ __forceinline__ int opaque_tid() { int t = (int)threadIdx.x; asm volatile("" : "+v"(t)); return t; }
namespace pg8 {
#define PG8_LAS __attribute__((address_space(3)))
typedef unsigned short bf16_t;
typedef short bf16x8 __attribute__((ext_vector_type(8)));
typedef float f32x4 __attribute__((ext_vector_type(4)));
typedef unsigned u32x4 __attribute__((ext_vector_type(4)));
constexpr int RS_LDS_OFF = 132096;
constexpr int EPI_LDS_OFF = 134144, EPI_LDS_WAVE = 2304;
constexpr int BM = 256, BK = 64, HALF = 128, HTB = HALF * BK * 2  , STAGE_BYTES = 8 * HTB, NXCD = 8, WGM = 8;

__host__ __device__ __forceinline__ int lds_byte(int r, int c) { const int st = (r >> 4) * 2 + (c >> 5), rr = r & 15, cc = c & 31, ob = rr * 64 + cc * 2; return st * 1024 + (ob ^ (((ob >> 9) & 1) << 5)); }
__host__ __device__ __forceinline__ void stage_rc(int b, int& R, int& C) { const int st = b / 1024, sb = b % 1024, swz = sb ^ (((sb >> 9) & 1) << 5); R = (st >> 1) * 16 + swz / 64; C = (st & 1) * 32 + (swz % 64) / 2; }
__host__ __device__ __forceinline__ int perm32(int rho) { const int n = rho >> 4, i = rho & 15; return 8 * (i >> 2) + 4 * n + (i & 3); }
struct Unit { int pm, pn; };
struct Gemm { const bf16_t* A; const bf16_t* Bt; int M, N, K; };

struct StaticOrder {
    int nM, nN, nwg, G, c;
    __host__ __device__ void init(int M, int N, int G_, int c_) { nM = M / BM; nN = N / BM; nwg = nM * nN; G = G_; c = c_; }
    __host__ __device__ bool next(int i, Unit& u) const {
        const long L = (long)i * G + c; if (L >= nwg) return false;
        int wgid = (int)L; { const int q = nwg / NXCD, r = nwg % NXCD, xcd = wgid % NXCD, off = wgid / NXCD; wgid = (xcd < r ? xcd * (q + 1) : r * (q + 1) + (xcd - r) * q) + off; }
        const int nig = WGM * nN, gid = wgid / nig, fm = gid * WGM, gsz = (nM - fm) < WGM ? (nM - fm) : WGM;
        u.pm = fm + ((wgid % nig) % gsz); u.pn = (wgid % nig) / gsz; return true;
    }
    __device__ __forceinline__ void a_ready(const Unit&) const {}
    __device__ __forceinline__ void done(const Unit&) const {}
};
__device__ __forceinline__ unsigned cvt_pk_bf16(float lo, float hi) { unsigned r; asm volatile("v_cvt_pk_bf16_f32 %0, %1, %2" : "=v"(r) : "v"(lo), "v"(hi)); return r; }

__device__ __forceinline__ float gelu_tanh_f(float x) { const float y = 1.5957691216f * (x + 0.044715f * x * x * x); return x * __builtin_amdgcn_rcpf(1.0f + __expf(-y)); }
__device__ __forceinline__ float silu_f(float x) { return x * __builtin_amdgcn_rcpf(1.0f + __expf(-x)); }

struct EpiBf16G {
    static constexpr bool PERM = true, AFTER_DRAIN = false, SWAP = false; static constexpr int NSTORES = 16;
    bf16_t* O; int ldc; int gelu_tiles; const float* rs;
    __device__ __forceinline__ void operator()(const f32x4 (&acc)[2][2][4][2], const Unit& u, int wr, int wc, int fr, int fq, const PG8_LAS float* rsl, PG8_LAS unsigned char* eslot) const {
        const int lane = fq * 16 + fr, lr = lane >> 2, lc = (lane & 3) * 8;
        const int rowb = u.pm * BM + wr * 64, colb = u.pn * BM + wc * 32;
        const bool act = u.pn < gelu_tiles;
#pragma unroll
        for (int ai = 0; ai < 2; ++ai)
#pragma unroll
            for (int m = 0; m < 4; ++m) {
                const float sc = rs ? rsl[wr * 64 + fr + ai * HALF + m * 16] : 1.0f;
#pragma unroll
                for (int bj = 0; bj < 2; ++bj) { f32x4 v0 = acc[ai][bj][m][0] * sc, v1 = acc[ai][bj][m][1] * sc;
                    if (act) {
#pragma unroll
                        for (int j = 0; j < 4; ++j) { v0[j] = gelu_tanh_f(v0[j]); v1[j] = gelu_tanh_f(v1[j]); } }
                    u32x4 w; w.x = cvt_pk_bf16(v0[0], v0[1]); w.y = cvt_pk_bf16(v0[2], v0[3]); w.z = cvt_pk_bf16(v1[0], v1[1]); w.w = cvt_pk_bf16(v1[2], v1[3]);
                    PG8_LAS unsigned char* sl = eslot;
                    *(PG8_LAS u32x4*)(sl + fr * 64 + fq * 16) = w;
                    const u32x4 w2 = *(const PG8_LAS u32x4*)(sl + lane * 16);
                    *(u32x4*)(O + (size_t)(rowb + ai * HALF + m * 16 + lr) * ldc + colb + bj * HALF + lc) = w2; } }
    }
};
struct EpiPT {
    static constexpr bool PERM = false, AFTER_DRAIN = false, SWAP = true; static constexpr int NSTORES = 16;
    bf16_t* O; const float* rs;
    __device__ __forceinline__ void operator()(const f32x4 (&acc)[2][2][4][2], const Unit& u, int wr, int wc, int fr, int fq, const PG8_LAS float* rsl, PG8_LAS unsigned char* eslot) const {
        typedef unsigned u32x2_t __attribute__((ext_vector_type(2)));
        const int lane = fq * 16 + fr;
        const int rowb = u.pm * BM + wr * 64; const int b = rowb >> 11, s0 = rowb & 2047;
#pragma unroll
        for (int ai = 0; ai < 2; ++ai)
#pragma unroll
            for (int bj = 0; bj < 2; ++bj)
#pragma unroll
                for (int n = 0; n < 2; ++n) { const int col0 = u.pn * BM + bj * HALF + wc * 32 + n * 16;
#pragma unroll
                    for (int m = 0; m < 4; ++m) { const f32x4 sc = *(const PG8_LAS f32x4*)(rsl + wr * 64 + 4 * fq + ai * HALF + m * 16);
                        const f32x4 v = acc[ai][bj][m][n] * sc;
                        u32x2_t w; w.x = cvt_pk_bf16(v[0], v[1]); w.y = cvt_pk_bf16(v[2], v[3]);
                        *(PG8_LAS u32x2_t*)(eslot + fr * 144 + (16 * m + 4 * fq) * 2) = w; }
#pragma unroll
                    for (int k = 0; k < 2; ++k) { const int c = lane + 64 * k, col = c >> 3, ch = c & 7;
                        const u32x4 w2 = *(const PG8_LAS u32x4*)(eslot + col * 144 + ch * 16);
                        *(u32x4*)(O + ((size_t)(col0 + col) * 32 + b) * 2048 + s0 + ai * HALF + ch * 8) = w2; } }
    }
};
struct EpiSwiGLU {
    static constexpr bool PERM = true, AFTER_DRAIN = false, SWAP = false; static constexpr int NSTORES = 8;
    bf16_t* O; int ldc; const float* rs;
    __device__ __forceinline__ void operator()(const f32x4 (&acc)[2][2][4][2], const Unit& u, int wr, int wc, int fr, int fq, const PG8_LAS float* rsl, PG8_LAS unsigned char* eslot) const {
        const int lane = fq * 16 + fr, lr = lane >> 2, lc = (lane & 3) * 8;
        const int rowb = u.pm * BM + wr * 64, colb = u.pn * HALF + wc * 32;
#pragma unroll
        for (int ai = 0; ai < 2; ++ai)
#pragma unroll
            for (int m = 0; m < 4; ++m) {
                const float sc = rsl[wr * 64 + fr + ai * HALF + m * 16];
                const f32x4 g0 = acc[ai][0][m][0] * sc, g1 = acc[ai][0][m][1] * sc, u0 = acc[ai][1][m][0] * sc, u1 = acc[ai][1][m][1] * sc;
                const f32x4 a0 = g0 * (-1.4426950408889634f), a1 = g1 * (-1.4426950408889634f);
                f32x4 e0, e1;
#pragma unroll
                for (int j = 0; j < 4; ++j) { e0[j] = __builtin_amdgcn_exp2f(a0[j]); e1[j] = __builtin_amdgcn_exp2f(a1[j]); }
                const f32x4 d0 = e0 + 1.0f, d1 = e1 + 1.0f;
                f32x4 r0, r1;
#pragma unroll
                for (int j = 0; j < 4; ++j) { r0[j] = __builtin_amdgcn_rcpf(d0[j]); r1[j] = __builtin_amdgcn_rcpf(d1[j]); }
                const f32x4 v0 = (g0 * u0) * r0, v1 = (g1 * u1) * r1;
                u32x4 w; w.x = cvt_pk_bf16(v0[0], v0[1]); w.y = cvt_pk_bf16(v0[2], v0[3]); w.z = cvt_pk_bf16(v1[0], v1[1]); w.w = cvt_pk_bf16(v1[2], v1[3]);
                PG8_LAS unsigned char* sl = eslot;
                *(PG8_LAS u32x4*)(sl + fr * 64 + fq * 16) = w;
                const u32x4 w2 = *(const PG8_LAS u32x4*)(sl + lane * 16);
                *(u32x4*)(O + (size_t)(rowb + ai * HALF + m * 16 + lr) * ldc + colb + lc) = w2; }
    }
};

template <class Epi, class Sched, bool STAMP = false>
__device__ __forceinline__ void gemm_phase(PG8_LAS unsigned char* lds, const Gemm g, const Sched& S, const Epi& E, unsigned long long* stamps) {
    const int tid = opaque_tid(), wid = __builtin_amdgcn_readfirstlane(tid >> 6), lane = tid & 63, wr = wid >> 2, wc = wid & 3, fr = lane & 15, fq = lane >> 4;
    const int K = g.K, nt = K / BK;
    int ts_lo = 0, ts_hi = 0, nts = 0; const unsigned long long rt_entry = STAMP ? (unsigned long long)wall_clock64() : 0ull;
#define PG8_STAMP() do { if (STAMP && wid == 0 && nts < 64) { const unsigned long long _c = (unsigned long long)clock64(); \
        ts_lo = (lane == nts) ? (int)(unsigned)_c : ts_lo; ts_hi = (lane == nts) ? (int)(unsigned)(_c >> 32) : ts_hi; ++nts; } } while (0)
    PG8_STAMP();
    unsigned voffA[2], voffB[2];
#pragma unroll
    for (int i = 0; i < 2; ++i) { int R, C; stage_rc(tid * 16 + i * 8192, R, C); const int Rb = Epi::PERM ? ((R & ~31) + perm32(R & 31)) : R;
        voffA[i] = (unsigned)(R * K + C) * 2u; voffB[i] = (unsigned)(Rb * K + C) * 2u; }
    const size_t kstep = (size_t)(BK * 2);
    const size_t hstep = (size_t)HALF * K * 2;
    const size_t tstep = 2 * hstep;
    const unsigned ldsw = (unsigned)wid * 1024u;
    const int aoff = lds_byte(wr * 64 + fr, fq * 8), boff = lds_byte(wc * 32 + fr, fq * 8);
#define PG8_SA(b, h) (((b) * 2 + (h)) * HTB)
#define PG8_SB(b, h) ((4 + (b) * 2 + (h)) * HTB)
#define PG8_STAGE(bufoff, gbase, voff) do { _Pragma("unroll") for (int _i = 0; _i < 2; ++_i) \
        __builtin_amdgcn_global_load_lds((const unsigned*)((const char*)(gbase) + (voff)[_i]), (PG8_LAS unsigned*)(lds + (bufoff) + ldsw + _i * 8192), 16, 0, 0); } while (0)
#define PG8_LDA(dst, b, h) do { _Pragma("unroll") for (int m = 0; m < 4; ++m) _Pragma("unroll") for (int k = 0; k < 2; ++k) dst[m][k] = *(const PG8_LAS bf16x8*)(lds + PG8_SA(b, h) + aoff + m * 2048 + k * 1024); } while (0)
#define PG8_LDB(dst, b, h) do { _Pragma("unroll") for (int n = 0; n < 2; ++n) _Pragma("unroll") for (int k = 0; k < 2; ++k) dst[n][k] = *(const PG8_LAS bf16x8*)(lds + PG8_SB(b, h) + boff + n * 2048 + k * 1024); } while (0)
#define PG8_MMA(ai, bj, At, Bt) do { __builtin_amdgcn_s_setprio(1); _Pragma("unroll") for (int m = 0; m < 4; ++m) _Pragma("unroll") for (int n = 0; n < 2; ++n) _Pragma("unroll") for (int k = 0; k < 2; ++k) \
        acc[ai][bj][m][n] = Epi::SWAP ? __builtin_amdgcn_mfma_f32_16x16x32_bf16(At[m][k], Bt[n][k], acc[ai][bj][m][n], 0, 0, 0) : __builtin_amdgcn_mfma_f32_16x16x32_bf16(Bt[n][k], At[m][k], acc[ai][bj][m][n], 0, 0, 0); __builtin_amdgcn_s_setprio(0); } while (0)
#define PG8_WAIT_V(n) asm volatile("s_waitcnt vmcnt(" #n ")" ::: "memory")
#define PG8_WAIT_L(n) asm volatile("s_waitcnt lgkmcnt(" #n ")" ::: "memory")
#define PG8_BAR __builtin_amdgcn_s_barrier()
#define PG8_SCHED __builtin_amdgcn_sched_barrier(0)
#define PG8_STAGE_RS(unit, buf) do { if (E.rs != nullptr && wid < 4) __builtin_amdgcn_global_load_lds((const unsigned*)(E.rs + (unit).pm * BM + wid * 64 + lane), (PG8_LAS unsigned*)(lds + RS_LDS_OFF + (buf) * 1024 + wid * 256), 4, 0, 0); } while (0)
    Unit cur, nxt; int ui = 0;
    if (!S.next(0, cur)) return;
    f32x4 acc[2][2][4][2];
#pragma unroll
    for (int a = 0; a < 2; ++a)
#pragma unroll
        for (int b = 0; b < 2; ++b)
#pragma unroll
            for (int m = 0; m < 4; ++m)
#pragma unroll
                for (int n = 0; n < 2; ++n) acc[a][b][m][n] = (f32x4){0.f, 0.f, 0.f, 0.f};
    bf16x8 At[4][2], B0[2][2], B1[2][2];
    const char* cA = (const char*)g.A + (size_t)cur.pm * tstep; const char* cB = (const char*)g.Bt + (size_t)cur.pn * tstep;
    S.a_ready(cur);
    PG8_STAGE_RS(cur, 0);
#if USE_SP2
    PG8_STAGE(PG8_SB(0, 0), cB, voffB); PG8_STAGE(PG8_SB(0, 1), cB + hstep, voffB); PG8_STAGE(PG8_SA(0, 0), cA, voffA); PG8_STAGE(PG8_SA(0, 1), cA + hstep, voffA);
    if (wr == 1) PG8_BAR;
    PG8_WAIT_V(2); PG8_BAR;
    PG8_STAGE(PG8_SB(1, 0), cB + kstep, voffB); PG8_STAGE(PG8_SA(1, 0), cA + kstep, voffA); PG8_STAGE(PG8_SB(1, 1), cB + hstep + kstep, voffB); PG8_STAGE(PG8_SA(1, 1), cA + hstep + kstep, voffA);
    PG8_WAIT_V(8); PG8_BAR;
#else
    PG8_STAGE(PG8_SB(0, 0), cB, voffB); PG8_STAGE(PG8_SA(0, 0), cA, voffA); PG8_STAGE(PG8_SB(0, 1), cB + hstep, voffB); PG8_STAGE(PG8_SA(0, 1), cA + hstep, voffA);
    if (wr == 1) PG8_BAR;
    PG8_WAIT_V(4); PG8_BAR;
    PG8_STAGE(PG8_SB(1, 0), cB + kstep, voffB); PG8_STAGE(PG8_SA(1, 0), cA + kstep, voffA); PG8_STAGE(PG8_SB(1, 1), cB + hstep + kstep, voffB); PG8_STAGE(PG8_SA(1, 1), cA + hstep + kstep, voffA);
    PG8_WAIT_V(8); PG8_BAR;
#endif
    PG8_STAMP();
    for (;;) {
        const bool has_next = S.next(ui + 1, nxt);
        const char* nA = has_next ? (const char*)g.A + (size_t)nxt.pm * tstep : cA; const char* nB = has_next ? (const char*)g.Bt + (size_t)nxt.pn * tstep : cB;
        for (int t = 0; t < nt; t += 2) {
            const bool last = (t == nt - 2);
            const char* a2 = last ? nA : cA + (size_t)(t + 2) * kstep; const char* b2 = last ? nB : cB + (size_t)(t + 2) * kstep;
            const char* a3 = a2 + kstep; const char* b3 = b2 + kstep;
            if (last && has_next) { S.a_ready(nxt); PG8_STAGE_RS(nxt, (ui + 1) & 1); }
#if USE_SP2
            const int relaxed = __builtin_amdgcn_readfirstlane((t == 0 && ui > 0) ? 1 : 0);
#define PG8_WAIT_V8R asm volatile("s_cmp_lg_u32 %0, 0\n\ts_cbranch_scc1 .Lpg8rlx%=\n\ts_waitcnt vmcnt(8)\n\ts_branch .Lpg8end%=\n.Lpg8rlx%=:\n\ts_waitcnt vmcnt(%1)\n.Lpg8end%=:" :: "s"(relaxed), "n"(8 + Epi::NSTORES) : "memory", "scc")
            PG8_LDB(B0, 0, 0); PG8_LDB(B1, 0, 1); PG8_SCHED; PG8_LDA(At, 0, 0);
            PG8_WAIT_V8R; PG8_WAIT_L(0); PG8_BAR; PG8_MMA(0, 0, At, B0); PG8_MMA(0, 1, At, B1); PG8_BAR; PG8_SCHED;
            PG8_LDA(At, 0, 1); PG8_STAGE(PG8_SB(0, 0), b2, voffB); PG8_STAGE(PG8_SB(0, 1), b2 + hstep, voffB); PG8_STAGE(PG8_SA(0, 0), a2, voffA);
            PG8_WAIT_V8R; PG8_WAIT_L(0); PG8_BAR; PG8_MMA(1, 0, At, B0); PG8_MMA(1, 1, At, B1); PG8_BAR; PG8_SCHED;
            PG8_LDB(B0, 1, 0); PG8_LDB(B1, 1, 1); PG8_SCHED; PG8_LDA(At, 1, 0); PG8_STAGE(PG8_SA(0, 1), a2 + hstep, voffA);
            PG8_WAIT_V8R; PG8_WAIT_L(0); PG8_BAR; PG8_MMA(0, 0, At, B0); PG8_MMA(0, 1, At, B1); PG8_BAR; PG8_SCHED;
            PG8_LDA(At, 1, 1); PG8_STAGE(PG8_SB(1, 0), b3, voffB); PG8_STAGE(PG8_SB(1, 1), b3 + hstep, voffB); PG8_STAGE(PG8_SA(1, 0), a3, voffA);
            PG8_WAIT_V(8); PG8_WAIT_L(0); PG8_BAR; PG8_MMA(1, 0, At, B0); PG8_MMA(1, 1, At, B1); PG8_BAR; PG8_SCHED;
            PG8_STAGE(PG8_SA(1, 1), a3 + hstep, voffA);
#undef PG8_WAIT_V8R
#else
            PG8_LDB(B0, 0, 0); PG8_SCHED; PG8_LDA(At, 0, 0);
            PG8_WAIT_L(8); PG8_BAR; PG8_WAIT_L(0); PG8_MMA(0, 0, At, B0); PG8_BAR; PG8_SCHED;
            PG8_LDB(B1, 0, 1); PG8_STAGE(PG8_SB(0, 0), b2, voffB);
            PG8_BAR; PG8_WAIT_L(0); PG8_MMA(0, 1, At, B1); PG8_BAR;
            PG8_LDA(At, 0, 1); PG8_STAGE(PG8_SA(0, 0), a2, voffA);
            PG8_BAR; PG8_WAIT_L(0); PG8_MMA(1, 0, At, B0); PG8_BAR; PG8_SCHED;
            PG8_STAGE(PG8_SB(0, 1), b2 + hstep, voffB);
            { const int relaxed = __builtin_amdgcn_readfirstlane((t == 0 && ui > 0) ? 1 : 0);
              asm volatile("s_cmp_lg_u32 %0, 0\n\ts_cbranch_scc1 .Lpg8rlx%=\n\ts_waitcnt vmcnt(6)\n\ts_branch .Lpg8end%=\n.Lpg8rlx%=:\n\ts_waitcnt vmcnt(%1)\n.Lpg8end%=:" :: "s"(relaxed), "n"(6 + Epi::NSTORES) : "memory", "scc"); }
            PG8_BAR; PG8_MMA(1, 1, At, B1); PG8_BAR;
            PG8_LDB(B0, 1, 0); PG8_SCHED; PG8_LDA(At, 1, 0); PG8_STAGE(PG8_SA(0, 1), a2 + hstep, voffA);
            PG8_WAIT_L(8); PG8_BAR; PG8_WAIT_L(0); PG8_MMA(0, 0, At, B0); PG8_BAR; PG8_SCHED;
            PG8_LDB(B1, 1, 1); PG8_STAGE(PG8_SB(1, 0), b3, voffB);
            PG8_BAR; PG8_WAIT_L(0); PG8_MMA(0, 1, At, B1); PG8_BAR;
            PG8_LDA(At, 1, 1); PG8_STAGE(PG8_SA(1, 0), a3, voffA);
            PG8_BAR; PG8_WAIT_L(0); PG8_MMA(1, 0, At, B0); PG8_BAR; PG8_SCHED;
            PG8_STAGE(PG8_SB(1, 1), b3 + hstep, voffB);
            PG8_WAIT_V(6); PG8_BAR; PG8_MMA(1, 1, At, B1); PG8_BAR;
            PG8_STAGE(PG8_SA(1, 1), a3 + hstep, voffA);
#endif
        }
        PG8_STAMP();
#if ALIGN_EPI
        if (wr == 0) PG8_BAR;
#endif
        if constexpr (!Epi::AFTER_DRAIN) { E(acc, cur, wr, wc, fr, fq, (const PG8_LAS float*)(lds + RS_LDS_OFF + (ui & 1) * 1024), lds + EPI_LDS_OFF + wid * EPI_LDS_WAVE); S.done(cur); }
        PG8_STAMP();
        if (!has_next) break;
#pragma unroll
        for (int a = 0; a < 2; ++a)
#pragma unroll
            for (int b = 0; b < 2; ++b)
#pragma unroll
                for (int m = 0; m < 4; ++m)
#pragma unroll
                    for (int n = 0; n < 2; ++n) acc[a][b][m][n] = (f32x4){0.f, 0.f, 0.f, 0.f};
        cur = nxt; cA = nA; cB = nB; ++ui;
#if ALIGN_EPI
        if (wr == 1) PG8_BAR;
#endif
    }
    PG8_WAIT_V(0);
#if !ALIGN_EPI
    if (wr == 0) PG8_BAR;
#endif
    PG8_BAR;
    if constexpr (Epi::AFTER_DRAIN) { E.fused(acc, cur, wr, wc, fr, fq, lds, wid, lane); S.done(cur); }
    PG8_STAMP();
    if (STAMP && wid == 0) { stamps[lane] = lane < nts ? (((unsigned long long)(unsigned)ts_hi << 32) | (unsigned)ts_lo) : 0ull;
        if (lane == 62) stamps[62] = rt_entry; if (lane == 63) stamps[63] = (unsigned long long)wall_clock64(); }
#undef PG8_STAMP
#undef PG8_SA
#undef PG8_SB
#undef PG8_STAGE
#undef PG8_LDA
#undef PG8_LDB
#undef PG8_MMA
#undef PG8_WAIT_V
#undef PG8_WAIT_L
#undef PG8_BAR
#undef PG8_SCHED
#undef PG8_STAGE_RS
}
}

#define LAS PG8_LAS
typedef unsigned short u16;
typedef unsigned char uchar;
using pg8::bf16x8; using pg8::f32x4; using pg8::u32x4; using pg8::cvt_pk_bf16;
typedef float f32x16 __attribute__((ext_vector_type(16)));
typedef unsigned u32x2 __attribute__((ext_vector_type(2)));
typedef int i32x4 __attribute__((ext_vector_type(4)));

constexpr int T_ = 65536, DM = 1024, SEQ = 2048, NB = 32, DFF = 2816, NTHR = 512;
constexpr int LDS_ST_OFF = 155648;
constexpr int LDS_BYTES = LDS_ST_OFF + 16;
constexpr size_t SZ_ABIN = 2ull * 2560 * 1024 * 2, SZ_ABOUT = 2ull * 1024 * 1024 * 2, SZ_CDIN = 2ull * 2048 * 1024 * 2, SZ_CDOUT = 2ull * 1024 * 1024 * 2,
                 SZ_GU = 4ull * 5632 * 1024 * 2, SZ_DOWN = 4ull * 1024 * 2816 * 2, SZ_G = 2ull * 2 * 512 * 4096 * 2;
constexpr size_t WS_ABIN = 0, WS_ABOUT = WS_ABIN + SZ_ABIN, WS_CDIN = WS_ABOUT + SZ_ABOUT, WS_CDOUT = WS_CDIN + SZ_CDIN, WS_GU = WS_CDOUT + SZ_CDOUT, WS_DOWN = WS_GU + SZ_GU,
                 WS_G = WS_DOWN + SZ_DOWN,
                 WS_H = WS_G + SZ_G,
                 WS_B = WS_H + (size_t)T_ * 1024 * 2,
                 WS_C = WS_B + (size_t)T_ * 2560 * 2,
                 WS_D = WS_C + (size_t)1536 * 32 * 2048 * 2,
                 WS_E = WS_D + (size_t)T_ * 1024 * 2,
                 WS_BAR = WS_E + (size_t)T_ * 1024 * 2,
                 WS_RSTD = WS_BAR + 16384,
                 WS_END = WS_RSTD + (size_t)T_ * 4;
static_assert(WS_END <= (1ull << 30), "workspace map exceeds 1 GiB");
static_assert((size_t)T_ * DFF * 2 <= WS_D - WS_B, "act does not fit B + C");

__device__ __forceinline__ float bflo(unsigned w) { return __uint_as_float(w << 16); }
__device__ __forceinline__ float bfhi(unsigned w) { return __uint_as_float(w & 0xffff0000u); }
__device__ __forceinline__ float bf2f(u16 v) { return __uint_as_float(((unsigned)v) << 16); }
__device__ __forceinline__ u16 f2bf(float f) { return (u16)(cvt_pk_bf16(f, 0.f) & 0xffffu); }
__device__ __forceinline__ float wave_sum(float v) {
#pragma unroll
    for (int o = 32; o >= 1; o >>= 1) v += __shfl_xor(v, o, 64);
    return v;
}

__device__ void wt_job(LAS uchar* lds, const float* __restrict__ W, int ldw, int K, int N, u16* __restrict__ out, int ldo, int mode, const float* __restrict__ gain, int& rot) {
    LAS float* tile = (LAS float*)lds;
    const int tid = opaque_tid(); const int nkq = K / 256, nnt = N / 64, nsteps = nkq * nnt;
    const int G = (int)gridDim.x; const int first = ((int)blockIdx.x + G - (rot % G)) % G; rot += nsteps;
    for (int ti = first; ti < nsteps; ti += G) {
        const int kq = ti % nkq, nt = ti / nkq; const int k0 = kq * 256, n0 = nt * 64;
        int sc0 = n0; if (mode == 1) { const int pn = n0 >> 8, r = n0 & 255; sc0 = (r < 128) ? (pn * 128 + r) : (DFF + pn * 128 + (r - 128)); }
        float4 v[8];
#pragma unroll
        for (int i = 0; i < 8; ++i) { const int idx = tid + i * 512; const int kk = idx >> 4, c4 = (idx & 15) * 4;
            v[i] = *(const float4*)(W + (size_t)(k0 + kk) * ldw + sc0 + c4); }
#pragma unroll
        for (int i = 0; i < 8; ++i) { const int idx = tid + i * 512; const int kk = idx >> 4, c4 = (idx & 15) * 4;
            const float gk = gain ? gain[k0 + kk] : 1.0f;
            tile[kk * 65 + c4 + 0] = v[i].x * gk; tile[kk * 65 + c4 + 1] = v[i].y * gk; tile[kk * 65 + c4 + 2] = v[i].z * gk; tile[kk * 65 + c4 + 3] = v[i].w * gk; }
        __syncthreads();
#pragma unroll
        for (int q = 0; q < 4; ++q) { const int nn = tid >> 3, kc = q * 64 + (tid & 7) * 8;
          float f0 = tile[(kc + 0) * 65 + nn], f1 = tile[(kc + 1) * 65 + nn], f2 = tile[(kc + 2) * 65 + nn], f3 = tile[(kc + 3) * 65 + nn];
          float f4 = tile[(kc + 4) * 65 + nn], f5 = tile[(kc + 5) * 65 + nn], f6 = tile[(kc + 6) * 65 + nn], f7 = tile[(kc + 7) * 65 + nn];
          u32x4 w; w.x = cvt_pk_bf16(f0, f1); w.y = cvt_pk_bf16(f2, f3); w.z = cvt_pk_bf16(f4, f5); w.w = cvt_pk_bf16(f6, f7);
          *(u32x4*)(out + (size_t)(n0 + nn) * ldo + k0 + kc) = w; }
        __syncthreads();
    }
}
__device__ void fold_job(const float* __restrict__ cw, const float* __restrict__ scale, const float* __restrict__ Wout, u16* __restrict__ out) {
    for (int idx = blockIdx.x * NTHR + opaque_tid(); idx < 512 * 128; idx += gridDim.x * NTHR) {
        const int k = idx >> 7, n0 = (idx & 127) * 8; const int g = k >> 7;
        const float* cwr = cw + (size_t)k * 128; const float* sc = scale + g * 128; const float* wr = Wout + (size_t)(g * 128) * 1024 + n0;
        float acc[8];
#pragma unroll
        for (int u = 0; u < 8; ++u) acc[u] = 0.f;
#pragma unroll 8
        for (int c2 = 0; c2 < 128; ++c2) { const float cf = cwr[c2] * sc[c2]; const float4 w0 = *(const float4*)(wr + (size_t)c2 * 1024), w1 = *(const float4*)(wr + (size_t)c2 * 1024 + 4);
            acc[0] += cf * w0.x; acc[1] += cf * w0.y; acc[2] += cf * w0.z; acc[3] += cf * w0.w; acc[4] += cf * w1.x; acc[5] += cf * w1.y; acc[6] += cf * w1.z; acc[7] += cf * w1.w; }
#pragma unroll
        for (int u = 0; u < 8; ++u) out[(size_t)(n0 + u) * 1024 + k] = f2bf(acc[u]);
    }
}
__device__ void filter_job(LAS uchar* lds, const float* __restrict__ w1a, const float* __restrict__ b1a, const float* __restrict__ freqa, const float* __restrict__ w2a,
                           const float* __restrict__ b2a, const float* __restrict__ w3a, const float* __restrict__ decaya, u16* __restrict__ Gall) {
    LAS float* h2 = (LAS float*)lds;
    LAS float* zf = h2 + 64 * 64;
    LAS float* h1 = zf + 64 * 33;
    LAS float* w3s = h2 + 64 * 64;
    const int tid = opaque_tid(), lane = tid & 63, wave = __builtin_amdgcn_readfirstlane(tid >> 6);
    for (int item = blockIdx.x; item < 256; item += gridDim.x) {
        const int j = item >> 7, tg = (item >> 2) & 31, cq = item & 3, t0 = tg * 64;
        const float* w1 = w1a + j * 33 * 64; const float* b1 = b1a + j * 64; const float* freq = freqa + j * 128; const float* w2 = w2a + j * 4096; const float* b2 = b2a + j * 64;
        const float* w3 = w3a + (size_t)j * 64 * 2048; const float* decay = decaya + j * 2048; u16* Gj = Gall + (size_t)j * 2 * 512 * 4096;
        float4 wpre[16];
#pragma unroll
        for (int i = 0; i < 16; ++i) { const int idx = tid + i * NTHR; wpre[i] = *(const float4*)(w3 + (size_t)(idx >> 7) * 2048 + cq * 512 + (idx & 127) * 4); }
        for (int idx = tid; idx < 64 * 33; idx += NTHR) { const int tt = idx / 33, f = idx - tt * 33; const float t = (float)(t0 + tt);
            float val;
            if (f == 0) val = t / 2047.0f;
            else { const int fi = (f - 1) & 15; const float band = 1e-4f + (float)fi * ((15.0f - 1e-4f) / 15.0f); const float w = 6.283185307179586f * t / 2048.0f; const float fw = w * band;
                   val = (f <= 16) ? cosf(fw) : -sinf(fw); }
            zf[idx] = val; }
        __syncthreads();
        for (int idx = tid; idx < 4096; idx += NTHR) { const int tt = idx >> 6, k = idx & 63; float acc = 0.f;
            for (int f = 0; f < 33; ++f) acc += zf[tt * 33 + f] * w1[f * 64 + k];
            h1[tt * 64 + k] = sinf(freq[k] * (acc + b1[k])); }
        __syncthreads();
        for (int idx = tid; idx < 4096; idx += NTHR) { const int tt = idx >> 6, k = idx & 63; float acc = 0.f;
            for (int k2 = 0; k2 < 64; ++k2) acc += h1[tt * 64 + k2] * w2[k2 * 64 + k];
            h2[k * 64 + tt] = sinf(freq[64 + k] * (acc + b2[k])); }
        __syncthreads();
#pragma unroll
        for (int i = 0; i < 16; ++i) { const int idx = tid + i * NTHR; f32x4 wv; wv.x = wpre[i].x; wv.y = wpre[i].y; wv.z = wpre[i].z; wv.w = wpre[i].w; *(LAS f32x4*)(w3s + (idx >> 7) * 512 + (idx & 127) * 4) = wv; }
        __syncthreads();
        { const int t = t0 + lane; const float t01 = (float)t / 2047.0f;
          for (int ci = 0; ci < 64; ci += 4) { const int cl = wave * 64 + ci, col = cq * 512 + cl; float a0 = 0.f, a1 = 0.f, a2 = 0.f, a3 = 0.f;
#pragma unroll 16
              for (int k = 0; k < 64; ++k) { const f32x4 w = *(const LAS f32x4*)(w3s + k * 512 + cl); const float hv = h2[k * 64 + lane]; a0 += hv * w.x; a1 += hv * w.y; a2 += hv * w.z; a3 += hv * w.w; }
              const float4 dc = *(const float4*)(decay + col);
              a0 *= expf(-t01 * fabsf(dc.x)); a1 *= expf(-t01 * fabsf(dc.y)); a2 *= expf(-t01 * fabsf(dc.z)); a3 *= expf(-t01 * fabsf(dc.w));
              const int dir = col >> 10, o = (col >> 9) & 1, c = col & 511; u16* g = Gj + (size_t)(o * 512 + c) * 4096;
              if (dir == 0) { g[2048 - t] = f2bf(a0); g[4096 + 2048 - t] = f2bf(a1); g[8192 + 2048 - t] = f2bf(a2); g[12288 + 2048 - t] = f2bf(a3);
                              if (t == 0) { g[0] = 0; g[4096] = 0; g[8192] = 0; g[12288] = 0; } }
              else if (t <= 2046) { g[2049 + t] = f2bf(a0); g[4096 + 2049 + t] = f2bf(a1); g[8192 + 2049 + t] = f2bf(a2); g[12288 + 2049 + t] = f2bf(a3); } } }
        __syncthreads();
    }
}

__device__ __forceinline__ void unpack8(const u32x4 v, float (&f)[8]) { f[0] = bflo(v.x); f[1] = bfhi(v.x); f[2] = bflo(v.y); f[3] = bfhi(v.y); f[4] = bflo(v.z); f[5] = bfhi(v.z); f[6] = bflo(v.w); f[7] = bfhi(v.w); }
__device__ __forceinline__ float4 ntload4(const float* p) { const f32x4 v = __builtin_nontemporal_load((const f32x4*)p); float4 r; r.x = v.x; r.y = v.y; r.z = v.z; r.w = v.w; return r; }
__device__ __forceinline__ void ntstore4(float* p, float a, float b, float c, float d) { f32x4 w; w.x = a; w.y = b; w.z = c; w.w = d; __builtin_nontemporal_store(w, (f32x4*)p); }
__device__ __forceinline__ void resid_pass(const float* __restrict__ xin_f, u16* __restrict__ xb, const u16* __restrict__ mix, const float* __restrict__ gpost, float* __restrict__ rstd_out, float* __restrict__ out_f) {
    const int tid = opaque_tid(); const int lane = tid & 63, wave = tid >> 6;
    const int stride = gridDim.x * 8;
    constexpr int NR = 4;
    for (int row0 = blockIdx.x * 8 + wave; row0 < T_; row0 += NR * stride) {
        float x[NR][16];
        if (xin_f) {
#pragma unroll
            for (int k = 0; k < NR; ++k) { const int row = min(row0 + k * stride, T_ - 1);
#pragma unroll
                for (int c = 0; c < 2; ++c) { const float4 a0 = ntload4(xin_f + (size_t)row * 1024 + c * 512 + lane * 8), a1 = ntload4(xin_f + (size_t)row * 1024 + c * 512 + lane * 8 + 4);
                    x[k][c * 8 + 0] = a0.x; x[k][c * 8 + 1] = a0.y; x[k][c * 8 + 2] = a0.z; x[k][c * 8 + 3] = a0.w; x[k][c * 8 + 4] = a1.x; x[k][c * 8 + 5] = a1.y; x[k][c * 8 + 6] = a1.z; x[k][c * 8 + 7] = a1.w; } }
        } else {
            u32x4 xr[NR][2], mr[NR][2];
#pragma unroll
            for (int k = 0; k < NR; ++k) { const int row = min(row0 + k * stride, T_ - 1);
#pragma unroll
                for (int c = 0; c < 2; ++c) { xr[k][c] = *(const u32x4*)(xb + (size_t)row * 1024 + c * 512 + lane * 8); mr[k][c] = __builtin_nontemporal_load((const u32x4*)(mix + (size_t)row * 1024 + c * 512 + lane * 8)); } }
            float g[16];
#pragma unroll
            for (int c = 0; c < 2; ++c) { const float4 a0 = *(const float4*)(gpost + c * 512 + lane * 8), a1 = *(const float4*)(gpost + c * 512 + lane * 8 + 4);
                g[c * 8 + 0] = a0.x; g[c * 8 + 1] = a0.y; g[c * 8 + 2] = a0.z; g[c * 8 + 3] = a0.w; g[c * 8 + 4] = a1.x; g[c * 8 + 5] = a1.y; g[c * 8 + 6] = a1.z; g[c * 8 + 7] = a1.w; }
#pragma unroll
            for (int k = 0; k < NR; ++k) { float m[16]; float ss = 0.f;
#pragma unroll
                for (int c = 0; c < 2; ++c) { float t8[8]; unpack8(mr[k][c], t8);
#pragma unroll
                    for (int e = 0; e < 8; ++e) { m[c * 8 + e] = t8[e]; ss += t8[e] * t8[e]; } }
                ss = wave_sum(ss); const float rstd = rsqrtf(ss * (1.0f / 1024.0f) + 1e-6f);
#pragma unroll
                for (int c = 0; c < 2; ++c) { float t8[8]; unpack8(xr[k][c], t8);
#pragma unroll
                    for (int e = 0; e < 8; ++e) x[k][c * 8 + e] = t8[e] + m[c * 8 + e] * rstd * g[c * 8 + e]; } }
        }
#pragma unroll
        for (int k = 0; k < NR; ++k) { const int row = row0 + k * stride;
            if (row < T_) {
                if (out_f) {
#pragma unroll
                    for (int c = 0; c < 2; ++c) { ntstore4(out_f + (size_t)row * 1024 + c * 512 + lane * 8, x[k][c * 8 + 0], x[k][c * 8 + 1], x[k][c * 8 + 2], x[k][c * 8 + 3]);
                        ntstore4(out_f + (size_t)row * 1024 + c * 512 + lane * 8 + 4, x[k][c * 8 + 4], x[k][c * 8 + 5], x[k][c * 8 + 6], x[k][c * 8 + 7]); }
                } else {
                    float ss = 0.f;
#pragma unroll
                    for (int e = 0; e < 16; ++e) ss += x[k][e] * x[k][e];
                    ss = wave_sum(ss);
                    if (lane == 0) rstd_out[row] = rsqrtf(ss * (1.0f / 1024.0f) + 1e-6f);
#pragma unroll
                    for (int c = 0; c < 2; ++c) { u32x4 w; w.x = cvt_pk_bf16(x[k][c * 8 + 0], x[k][c * 8 + 1]); w.y = cvt_pk_bf16(x[k][c * 8 + 2], x[k][c * 8 + 3]); w.z = cvt_pk_bf16(x[k][c * 8 + 4], x[k][c * 8 + 5]); w.w = cvt_pk_bf16(x[k][c * 8 + 6], x[k][c * 8 + 7]);
                        *(u32x4*)(xb + (size_t)row * 1024 + c * 512 + lane * 8) = w; }
                }
            }
        }
    }
}

constexpr int TRS = 66;
__device__ __forceinline__ void tr_tile8(LAS u16* tiles  , const u16* __restrict__ src, size_t lds_src, size_t src_ts, u16* __restrict__ dst, size_t ldd, size_t dst_ts) {
    const int tid = opaque_tid(), r = tid >> 3, ch = (tid & 7) * 8;
    u32x4 v[8];
#pragma unroll
    for (int k = 0; k < 8; ++k) v[k] = *(const u32x4*)(src + k * src_ts + (size_t)r * lds_src + ch);
#pragma unroll
    for (int k = 0; k < 8; ++k) { LAS u16* tile = tiles + k * 64 * TRS;
        tile[(ch + 0) * TRS + r] = (u16)(v[k].x & 0xffffu); tile[(ch + 1) * TRS + r] = (u16)(v[k].x >> 16);
        tile[(ch + 2) * TRS + r] = (u16)(v[k].y & 0xffffu); tile[(ch + 3) * TRS + r] = (u16)(v[k].y >> 16);
        tile[(ch + 4) * TRS + r] = (u16)(v[k].z & 0xffffu); tile[(ch + 5) * TRS + r] = (u16)(v[k].z >> 16);
        tile[(ch + 6) * TRS + r] = (u16)(v[k].w & 0xffffu); tile[(ch + 7) * TRS + r] = (u16)(v[k].w >> 16); }
    __syncthreads();
#pragma unroll
    for (int k = 0; k < 8; ++k) { const LAS unsigned* p = (const LAS unsigned*)(tiles + k * 64 * TRS + r * TRS + ch);
        u32x4 o; o.x = p[0]; o.y = p[1]; o.z = p[2]; o.w = p[3];
        *(u32x4*)(dst + k * dst_ts + (size_t)r * ldd + ch) = o; }
    __syncthreads();
}
__device__ void transpose_fwd_phase(LAS uchar* lds, const u16* __restrict__ proj, u16* __restrict__ pT) {
    LAS u16* tiles = (LAS u16*)lds;
    for (int it = blockIdx.x; it < NB * 32 * 3; it += gridDim.x) {
        const int c8 = it % 3, st = (it / 3) & 31, b = it / 96;
        tr_tile8(tiles, proj + (size_t)(b * SEQ + st * 64) * 2560 + 1024 + c8 * 512, 2560, 64, pT + ((size_t)(c8 * 512) * NB + b) * SEQ + st * 64, (size_t)NB * SEQ, (size_t)64 * NB * SEQ);
    }
}
__device__ void transpose_back_phase(LAS uchar* lds, const u16* __restrict__ yT, u16* __restrict__ ycat) {
    LAS u16* tiles = (LAS u16*)lds;
    for (int it = blockIdx.x; it < NB * 32; it += gridDim.x) {
        const int st = it & 31, b = it >> 5;
        tr_tile8(tiles, yT + (size_t)b * SEQ + st * 64, (size_t)NB * SEQ, (size_t)64 * NB * SEQ, ycat + (size_t)(b * SEQ + st * 64) * 1024 + 512, 1024, 64);
    }
}
__device__ void gating_phase(LAS uchar* lds, const u16* __restrict__ proj  , const float* __restrict__ ln_g  ,
                             const float* __restrict__ w_s  , const float* __restrict__ b_s  , u16* __restrict__ ycat  ) {
    LAS u16* vT = (LAS u16*)lds;
    LAS u16* wsb = vT + 128 * 136;
    LAS float* stats = (LAS float*)(wsb + 128 * 136);
    const int tid = opaque_tid(), lane = tid & 63, wave = tid >> 6, fr = lane & 15, fq = lane >> 4;
    for (int item = blockIdx.x; item < T_ / 128; item += gridDim.x) {
        const int tok0 = item * 128;
        { u32x4 vv[16];
#pragma unroll
          for (int tt = 0; tt < 16; ++tt) vv[tt] = *(const u32x4*)(proj + (size_t)(tok0 + wave * 16 + tt) * 1024 + 512 + lane * 8);
#pragma unroll
          for (int tt = 0; tt < 16; ++tt) { const int q = wave * 16 + tt; const u32x4 v = vv[tt];
            const float f0 = bflo(v.x), f1 = bfhi(v.x), f2 = bflo(v.y), f3 = bfhi(v.y), f4 = bflo(v.z), f5 = bfhi(v.z), f6 = bflo(v.w), f7 = bfhi(v.w);
            const float mean = wave_sum(f0 + f1 + f2 + f3 + f4 + f5 + f6 + f7) * (1.0f / 512.0f);
            const float d0 = f0 - mean, d1 = f1 - mean, d2 = f2 - mean, d3 = f3 - mean, d4 = f4 - mean, d5 = f5 - mean, d6 = f6 - mean, d7 = f7 - mean;
            const float var = wave_sum(d0 * d0 + d1 * d1 + d2 * d2 + d3 * d3 + d4 * d4 + d5 * d5 + d6 * d6 + d7 * d7) * (1.0f / 512.0f);
            if (lane == 0) { stats[q * 2] = mean; stats[q * 2 + 1] = rsqrtf(var + 1e-5f); } } }
        __syncthreads();
        u32x4 vreg[4]; float4 wreg[8];
#define GATE_LOAD(g) do { _Pragma("unroll") for (int i = 0; i < 4; ++i) { const int idx = tid + i * NTHR; vreg[i] = *(const u32x4*)(proj + (size_t)(tok0 + (idx >> 4)) * 1024 + 512 + (g) * 128 + (idx & 15) * 8); } \
                          _Pragma("unroll") for (int i = 0; i < 8; ++i) { const int idx = tid + i * NTHR; wreg[i] = *(const float4*)(w_s + (size_t)((g) * 128 + (idx >> 5)) * 128 + (idx & 31) * 4); } } while (0)
        GATE_LOAD(0);
#pragma unroll
        for (int g = 0; g < 4; ++g) {
#pragma unroll
            for (int i = 0; i < 4; ++i) { const int idx = tid + i * NTHR; const int q = idx >> 4, c0 = (idx & 15) * 8;
                const u32x4 v = vreg[i];
                const float mean = stats[q * 2], rstd = stats[q * 2 + 1];
                const float4 g0 = *(const float4*)(ln_g + g * 128 + c0), g1 = *(const float4*)(ln_g + g * 128 + c0 + 4);
                vT[(c0 + 0) * 136 + q] = f2bf((bflo(v.x) - mean) * rstd * g0.x); vT[(c0 + 1) * 136 + q] = f2bf((bfhi(v.x) - mean) * rstd * g0.y);
                vT[(c0 + 2) * 136 + q] = f2bf((bflo(v.y) - mean) * rstd * g0.z); vT[(c0 + 3) * 136 + q] = f2bf((bfhi(v.y) - mean) * rstd * g0.w);
                vT[(c0 + 4) * 136 + q] = f2bf((bflo(v.z) - mean) * rstd * g1.x); vT[(c0 + 5) * 136 + q] = f2bf((bfhi(v.z) - mean) * rstd * g1.y);
                vT[(c0 + 6) * 136 + q] = f2bf((bflo(v.w) - mean) * rstd * g1.z); vT[(c0 + 7) * 136 + q] = f2bf((bfhi(v.w) - mean) * rstd * g1.w); }
#pragma unroll
            for (int i = 0; i < 8; ++i) { const int idx = tid + i * NTHR; const int p = idx >> 5, q0 = (idx & 31) * 4;
                const float4 w = wreg[i];
                u32x2 o; o.x = cvt_pk_bf16(w.x, w.y); o.y = cvt_pk_bf16(w.z, w.w);
                *(LAS u32x2*)(wsb + p * 136 + q0) = o; }
            __syncthreads();
            if (g < 3) GATE_LOAD(g + 1);
            const int p = 16 * wave + fr; const size_t tok = (size_t)(tok0 + p); const float bias = b_s[g * 128 + p];
            u32x2 uu[8];
#pragma unroll
            for (int mi = 0; mi < 8; ++mi) uu[mi] = *(const u32x2*)(proj + tok * 1024 + g * 128 + 16 * mi + 4 * fq);
            f32x4 acc[8];
#pragma unroll
            for (int mi = 0; mi < 8; ++mi) acc[mi] = (f32x4){0.f, 0.f, 0.f, 0.f};
#pragma unroll
            for (int kk = 0; kk < 4; ++kk) {
                const bf16x8 bfrag = *(const LAS bf16x8*)(wsb + (16 * wave + fr) * 136 + 32 * kk + 8 * fq);
#pragma unroll
                for (int mi = 0; mi < 8; ++mi) { const bf16x8 afrag = *(const LAS bf16x8*)(vT + (16 * mi + fr) * 136 + 32 * kk + 8 * fq);
                    acc[mi] = __builtin_amdgcn_mfma_f32_16x16x32_bf16(afrag, bfrag, acc[mi], 0, 0, 0); }
            }
#pragma unroll
            for (int mi = 0; mi < 8; ++mi) { const int c = 16 * mi + 4 * fq;
                u32x2 o; o.x = cvt_pk_bf16(bflo(uu[mi].x) * (acc[mi][0] + bias), bfhi(uu[mi].x) * (acc[mi][1] + bias)); o.y = cvt_pk_bf16(bflo(uu[mi].y) * (acc[mi][2] + bias), bfhi(uu[mi].y) * (acc[mi][3] + bias));
                *(u32x2*)(ycat + tok * 1024 + g * 128 + c) = o; }
            __syncthreads();
        }
#undef GATE_LOAD
    }
}

constexpr int HZ_ROW = 4112;
constexpr int HZ_KR0 = NB * HZ_ROW;
constexpr int HZ_KRC = 8208;
static_assert(HZ_KR0 + 2 * HZ_KRC <= LDS_ST_OFF, "hyena LDS");

__device__ __forceinline__ void hy_load_kr(LAS uchar* lds, const u16* __restrict__ g) {
    const int tid = opaque_tid();
    const u32x4 w = *(const u32x4*)(g + tid * 8);
    const unsigned nxt = (tid < 511) ? (unsigned)g[tid * 8 + 8] : 0u;
    *(LAS u32x4*)(lds + HZ_KR0 + tid * 16) = w;
    u32x4 s; s.x = (w.x >> 16) | (w.y << 16); s.y = (w.y >> 16) | (w.z << 16); s.z = (w.z >> 16) | (w.w << 16); s.w = (w.w >> 16) | (nxt << 16);
    *(LAS u32x4*)(lds + HZ_KR0 + HZ_KRC + tid * 16) = s;
}
__device__ __forceinline__ void conv3_8(const u16* __restrict__ p, int s0, float w0, float w1, float w2, float (&o)[8]) {
    const u32x4 v = *(const u32x4*)(p + s0);
    const float prev = (s0 > 0) ? bf2f(p[s0 - 1]) : 0.f, next = (s0 + 8 < SEQ) ? bf2f(p[s0 + 8]) : 0.f;
    const float x0 = bflo(v.x), x1 = bfhi(v.x), x2 = bflo(v.y), x3 = bfhi(v.y), x4 = bflo(v.z), x5 = bfhi(v.z), x6 = bflo(v.w), x7 = bfhi(v.w);
    o[0] = w0 * prev + w1 * x0 + w2 * x1; o[1] = w0 * x0 + w1 * x1 + w2 * x2; o[2] = w0 * x1 + w1 * x2 + w2 * x3; o[3] = w0 * x2 + w1 * x3 + w2 * x4;
    o[4] = w0 * x3 + w1 * x4 + w2 * x5; o[5] = w0 * x4 + w1 * x5 + w2 * x6; o[6] = w0 * x5 + w1 * x6 + w2 * x7; o[7] = w0 * x6 + w1 * x7 + w2 * next;
}
__device__ void hyena_phase(LAS uchar* lds, const u16* __restrict__ pT  , const u16* __restrict__ G  , const float* __restrict__ conv_w  ,
                            const float* __restrict__ skip  , u16* __restrict__ yT  ) {
    const int tid = opaque_tid(), lane = tid & 63, wave = __builtin_amdgcn_readfirstlane(tid >> 6), r = lane & 31, h = lane >> 5;
    const int tbase = 256 * wave;
    const int e0 = 8 * h - r + 2048 - tbase, par = e0 & 1;
    const LAS uchar* abase = lds + HZ_KR0 + par * HZ_KRC + (e0 - par) * 2;
    const LAS uchar* bbase = lds + r * HZ_ROW + 16 * h;
    for (int c = blockIdx.x; c < 512; c += gridDim.x) {
        {
            const u16* src = pT + (size_t)c * NB * SEQ; const float w0 = conv_w[c], w1 = conv_w[1536 + c], w2 = conv_w[3072 + c];
#pragma unroll 8
            for (int it = 0; it < 16; ++it) { const int idx = tid + it * NTHR; const int b = idx >> 8, s0 = (idx & 255) * 8; float o[8];
                conv3_8(src + (size_t)b * SEQ, s0, w0, w1, w2, o);
                u32x4 w; w.x = cvt_pk_bf16(o[0], o[1]); w.y = cvt_pk_bf16(o[2], o[3]); w.z = cvt_pk_bf16(o[4], o[5]); w.w = cvt_pk_bf16(o[6], o[7]);
                *(LAS u32x4*)(lds + b * HZ_ROW + s0 * 2) = w; }
            hy_load_kr(lds, G + (size_t)c * 4096);
        }
        __syncthreads();
#pragma unroll 1
        for (int o = 0; o < 2; ++o) {
            f32x16 acc[8];
#pragma unroll
            for (int i = 0; i < 8; ++i)
#pragma unroll
                for (int k = 0; k < 16; ++k) acc[i][k] = 0.f;
#pragma unroll 1
            for (int p = 0; p < 2; ++p) {
                bf16x8 W[8];
#pragma unroll
                for (int k = 1; k < 8; ++k) { const LAS unsigned* ap = (const LAS unsigned*)(abase + (16 * p - 32 * k) * 2);
                    i32x4 av; av.x = (int)ap[0]; av.y = (int)ap[1]; av.z = (int)ap[2]; av.w = (int)ap[3]; W[8 - k] = __builtin_bit_cast(bf16x8, av); }
#pragma unroll 1
                for (int J = 0; J < 8; ++J) {
                    const LAS uchar* aj = abase + (16 * p + 256 * J) * 2;
                    const LAS uchar* bj = bbase + (16 * p + 256 * J) * 2;
#pragma unroll
                    for (int jj = 0; jj < 8; ++jj) {
                        const LAS unsigned* ap = (const LAS unsigned*)(aj + 64 * jj);
                        i32x4 av; av.x = (int)ap[0]; av.y = (int)ap[1]; av.z = (int)ap[2]; av.w = (int)ap[3]; W[jj] = __builtin_bit_cast(bf16x8, av);
                        const bf16x8 bb = *(const LAS bf16x8*)(bj + 64 * jj);
#pragma unroll
                        for (int i = 0; i < 8; ++i) acc[i] = __builtin_amdgcn_mfma_f32_32x32x16_bf16(W[(jj - i) & 7], bb, acc[i], 0, 0, 0);
                    }
                }
            }
            { const int cc = 512 * (o + 1) + c; const float w0 = conv_w[cc], w1 = conv_w[1536 + cc], w2 = conv_w[3072 + cc]; const float sk = skip[o * 512 + c];
              const u16* p0 = pT + ((size_t)cc * NB + r) * SEQ + tbase + 4 * h;
              const LAS uchar* z0 = lds + r * HZ_ROW + (tbase + 4 * h) * 2;
              const int tl = tbase + 4 * h;
#pragma unroll
              for (int i = 0; i < 8; ++i) {
                  if ((i & 3) == 0) __builtin_amdgcn_sched_barrier(0);
#pragma unroll
                  for (int q = 0; q < 4; ++q) { const int off = 32 * i + 8 * q;
                      const u32x2 zz = *(const LAS u32x2*)(z0 + off * 2);
                      const u32x2 gv = *(const u32x2*)(p0 + off);
                      const float um = bf2f(p0[off - 1]), up = bf2f(p0[off + 4]);
                      const float gm = (tl + off > 0) ? um : 0.f, gp = (tl + off + 4 < SEQ) ? up : 0.f;
                      const float g0 = bflo(gv.x), g1 = bfhi(gv.x), g2 = bflo(gv.y), g3 = bfhi(gv.y);
                      acc[i][4 * q + 0] = (w0 * gm + w1 * g0 + w2 * g1) * (acc[i][4 * q + 0] + sk * bflo(zz.x));
                      acc[i][4 * q + 1] = (w0 * g0 + w1 * g1 + w2 * g2) * (acc[i][4 * q + 1] + sk * bfhi(zz.x));
                      acc[i][4 * q + 2] = (w0 * g1 + w1 * g2 + w2 * g3) * (acc[i][4 * q + 2] + sk * bflo(zz.y));
                      acc[i][4 * q + 3] = (w0 * g2 + w1 * g3 + w2 * gp) * (acc[i][4 * q + 3] + sk * bfhi(zz.y)); } } }
            __syncthreads();
#pragma unroll
            for (int i = 0; i < 8; ++i)
#pragma unroll
                for (int q = 0; q < 4; ++q) {
                    u32x2 w; w.x = cvt_pk_bf16(acc[i][4 * q + 0], acc[i][4 * q + 1]); w.y = cvt_pk_bf16(acc[i][4 * q + 2], acc[i][4 * q + 3]);
                    *(LAS u32x2*)(lds + r * HZ_ROW + (tbase + 4 * h) * 2 + (32 * i + 8 * q) * 2) = w; }
            if (o == 0) hy_load_kr(lds, G + (size_t)(512 + c) * 4096);
            __syncthreads();
        }
        for (int idx = tid; idx < NB * 256; idx += NTHR) { const int b = idx >> 8, s0 = (idx & 255) * 8;
            *(u32x4*)(yT + ((size_t)c * NB + b) * SEQ + s0) = *(const LAS u32x4*)(lds + b * HZ_ROW + s0 * 2); }
        __syncthreads();
    }
}

__device__ __forceinline__ u32x4 pack8(const float (&o)[8]) { u32x4 w; w.x = cvt_pk_bf16(o[0], o[1]); w.y = cvt_pk_bf16(o[2], o[3]); w.z = cvt_pk_bf16(o[4], o[5]); w.w = cvt_pk_bf16(o[6], o[7]); return w; }
template <int W> __device__ __forceinline__ void pool_unit(const u16* __restrict__ seq  , int t0, u16* __restrict__ out  ) {
    constexpr int LEFT = W / 2, RIGHT = W - LEFT - 1, NR = 8 + W - 1;
    u32x4 rows[NR];
#pragma unroll
    for (int k = 0; k < NR; ++k) { const int p = t0 - LEFT + k; const int pc = min(max(p, 0), SEQ - 1);
        const u32x4 v = *(const u32x4*)(seq + (size_t)pc * 2048); const bool ok = (p >= 0 && p < SEQ);
        rows[k].x = ok ? v.x : 0u; rows[k].y = ok ? v.y : 0u; rows[k].z = ok ? v.z : 0u; rows[k].w = ok ? v.w : 0u; }
    float sm[8];
#pragma unroll
    for (int c = 0; c < 8; ++c) sm[c] = 0.f;
#pragma unroll
    for (int k = 0; k < W; ++k) { float f[8]; unpack8(rows[k], f);
#pragma unroll
        for (int c = 0; c < 8; ++c) sm[c] += f[c]; }
#pragma unroll
    for (int i = 0; i < 8; ++i) { const int t = t0 + i; const int lo = max(t - LEFT, 0), hi = min(t + RIGHT, SEQ - 1); const float inv = 1.0f / (float)(hi - lo + 1);
        float ctr[8], o[8]; unpack8(rows[i + LEFT], ctr);
#pragma unroll
        for (int c = 0; c < 8; ++c) o[c] = sm[c] * inv - ctr[c];
        *(u32x4*)(out + (size_t)t * 1024) = pack8(o);
        if (i < 7) { float fa[8], fs[8]; unpack8(rows[i + W], fa); unpack8(rows[i], fs);
#pragma unroll
            for (int c = 0; c < 8; ++c) sm[c] += fa[c] - fs[c]; } }
}
__device__ __forceinline__ void dconv_unit(const u16* __restrict__ seq  , int t0, const float* __restrict__ dconv  , u16* __restrict__ out  ) {
    u32x4 cr[10], hr[10], br[8];
#pragma unroll
    for (int k = 0; k < 10; ++k) { const int p = t0 - 1 + k; const int pc = min(max(p, 0), SEQ - 1);
        const u32x4 v = *(const u32x4*)(seq + (size_t)pc * 2048 + 1024); hr[k] = *(const u32x4*)(seq + (size_t)pc * 2048 + 1536); const bool ok = (p >= 0 && p < SEQ);
        cr[k].x = ok ? v.x : 0u; cr[k].y = ok ? v.y : 0u; cr[k].z = ok ? v.z : 0u; cr[k].w = ok ? v.w : 0u; }
#pragma unroll
    for (int i = 0; i < 8; ++i) br[i] = *(const u32x4*)(seq + (size_t)(t0 + i) * 2048 + 512);
    float w0[8], w1[8], w2[8];
    { const float4 a0 = *(const float4*)(dconv), a1 = *(const float4*)(dconv + 4), b0 = *(const float4*)(dconv + 512), b1 = *(const float4*)(dconv + 516), c0 = *(const float4*)(dconv + 1024), c1 = *(const float4*)(dconv + 1028);
      w0[0] = a0.x; w0[1] = a0.y; w0[2] = a0.z; w0[3] = a0.w; w0[4] = a1.x; w0[5] = a1.y; w0[6] = a1.z; w0[7] = a1.w;
      w1[0] = b0.x; w1[1] = b0.y; w1[2] = b0.z; w1[3] = b0.w; w1[4] = b1.x; w1[5] = b1.y; w1[6] = b1.z; w1[7] = b1.w;
      w2[0] = c0.x; w2[1] = c0.y; w2[2] = c0.z; w2[3] = c0.w; w2[4] = c1.x; w2[5] = c1.y; w2[6] = c1.z; w2[7] = c1.w; }
    float pm[8], pc_[8], pn[8];
    { float c[8], h[8]; unpack8(cr[0], c); unpack8(hr[0], h);
#pragma unroll
      for (int k = 0; k < 8; ++k) pm[k] = c[k] * h[k];
      unpack8(cr[1], c); unpack8(hr[1], h);
#pragma unroll
      for (int k = 0; k < 8; ++k) pc_[k] = c[k] * h[k]; }
#pragma unroll
    for (int i = 0; i < 8; ++i) { float c[8], h[8], bb[8], o[8]; unpack8(cr[i + 2], c); unpack8(hr[i + 2], h); unpack8(br[i], bb);
#pragma unroll
        for (int k = 0; k < 8; ++k) { pn[k] = c[k] * h[k]; o[k] = bb[k] * (w0[k] * pm[k] + w1[k] * pc_[k] + w2[k] * pn[k]); pm[k] = pc_[k]; pc_[k] = pn[k]; }
        *(u32x4*)(out + (size_t)(t0 + i) * 1024) = pack8(o); }
}
__device__ void stencil_phase(const u16* __restrict__ proj  , const float* __restrict__ dconv  , u16* __restrict__ ycat  ) {
    const int tid = opaque_tid(), lane = tid & 63, wave = __builtin_amdgcn_readfirstlane(tid >> 6);
    const int chl = (lane & 15) * 8, run = lane >> 4;
    for (int wu = blockIdx.x * 8 + wave; wu < (T_ / 32) * 8; wu += gridDim.x * 8) {
        const int rq = wu >> 3, kind = wu & 7; const int tok0 = rq * 32 + run * 8; const int t0 = tok0 & (SEQ - 1); const size_t s0 = (size_t)(tok0 - t0);
        if (kind < 4) { const int ch0 = kind * 128 + chl; const u16* seq = proj + s0 * 2048 + ch0; u16* out = ycat + s0 * 1024 + ch0;
            if (kind == 0) pool_unit<2>(seq, t0, out); else if (kind == 1) pool_unit<4>(seq, t0, out); else if (kind == 2) pool_unit<8>(seq, t0, out); else pool_unit<16>(seq, t0, out);
        } else { const int ch0 = (kind - 4) * 128 + chl; dconv_unit(proj + s0 * 2048 + ch0, t0, dconv + ch0, ycat + s0 * 1024 + 512 + ch0); }
    }
}


#define XB_TMO      128
#define XB_XCNT(j)  (256  + 64 * (j))
#define XB_XSUB(j)  (1280 + 64 * (j))
#define XB_XGEN(j)  (2304 + 64 * (j))
#define XB_TOP      3328
#define XB_TOPGEN   3392
#define XCD_BAR_WORDS 3456
#define XB_SPIN_CAP (1u << 20)
__device__ __forceinline__ unsigned xb_ld(unsigned* p)              { return __hip_atomic_load(p, __ATOMIC_RELAXED, __HIP_MEMORY_SCOPE_AGENT); }
__device__ __forceinline__ unsigned xb_add(unsigned* p, unsigned v) { return __hip_atomic_fetch_add(p, v, __ATOMIC_RELAXED, __HIP_MEMORY_SCOPE_AGENT); }
__device__ __forceinline__ unsigned xb_xcc_id() { return (unsigned)__builtin_amdgcn_s_getreg((3 << 11) | 20) & 0xFu; }
#define XB_SPIN(cond, bar) do { unsigned _sp = 0; while (cond) { __builtin_amdgcn_s_sleep(1); \
    if ((++_sp & 255u) == 0u) { if (xb_ld(&(bar)[XB_TMO])) break; if (_sp > XB_SPIN_CAP) { atomicAdd(&(bar)[XB_TMO], 1u); break; } } } } while (0)
struct XcdBarrier { unsigned* bar; unsigned x; volatile LAS unsigned* st; };
__device__ __forceinline__ XcdBarrier xcd_barrier_post(unsigned* bar, volatile LAS unsigned* st) {
    XcdBarrier b; b.bar = bar; b.x = xb_xcc_id(); b.st = st;
    if (threadIdx.x == 0) (void)xb_add(&bar[XB_XCNT(b.x)], 1u);
    return b;
}
__device__ __forceinline__ void xcd_barrier_complete(unsigned* bar, unsigned x, unsigned& nloc, unsigned& nx) {
    const unsigned G = gridDim.x * gridDim.y * gridDim.z;
    unsigned sum, cnt, mine, sp = 0u;
    for (;;) {
        sum = 0u; cnt = 0u; mine = 0u;
#pragma unroll
        for (unsigned j = 0; j < 16; ++j) { const unsigned c = xb_ld(&bar[XB_XCNT(j)]); sum += c; cnt += (c > 0u) ? 1u : 0u; mine = (j == x) ? c : mine; }
        if (sum == G) break;
        __builtin_amdgcn_s_sleep(1);
        if ((++sp & 255u) == 0u) { if (xb_ld(&bar[XB_TMO])) break; if (sp > XB_SPIN_CAP) { atomicAdd(&bar[XB_TMO], 1u); break; } }
    }
    nloc = mine > 0u ? mine : 1u; nx = cnt > 0u ? cnt : 1u;
}
__device__ __forceinline__ void xcd_barrier(const XcdBarrier& b) {
    asm volatile("s_waitcnt vmcnt(0)" ::: "memory");
    __syncthreads();
    if (threadIdx.x == 0) {
        unsigned* bar = b.bar;
        __builtin_amdgcn_s_waitcnt(0);
        unsigned nloc = b.st[0], nx = b.st[1];
        if (nloc == 0u) { xcd_barrier_complete(bar, b.x, nloc, nx); b.st[0] = nloc; b.st[1] = nx; }
        const unsigned old = xb_add(&bar[XB_XSUB(b.x)], 1u);
        const unsigned gen = old / nloc;
        if (old + 1u == (gen + 1u) * nloc) {
            __builtin_amdgcn_fence(__ATOMIC_RELEASE, "agent");
            asm volatile("s_waitcnt vmcnt(0)" ::: "memory");
            const unsigned og = xb_add(&bar[XB_TOP], 1u);
            const unsigned tg = og / nx;
            if (og + 1u == (tg + 1u) * nx) xb_add(&bar[XB_TOPGEN], 1u);
            else XB_SPIN(xb_ld(&bar[XB_TOPGEN]) == tg, bar);
            __builtin_amdgcn_fence(__ATOMIC_ACQUIRE, "agent");
            xb_add(&bar[XB_XGEN(b.x)], 1u);
            asm volatile("s_waitcnt vmcnt(0)" ::: "memory");
        } else {
            XB_SPIN(xb_ld(&bar[XB_XGEN(b.x)]) == gen, bar);
            __builtin_amdgcn_fence(__ATOMIC_ACQUIRE, "agent");
            asm volatile("s_waitcnt vmcnt(0)" ::: "memory");
        }
    }
    __syncthreads();
}

constexpr int NPH = 1 + 2 * 8 + 2 * 7;
struct Args { const float* in[23]; float* out; uchar* ws; int lo, hi; };

__global__ void __launch_bounds__(NTHR, 2) fwd_kernel(Args a) {
    extern __shared__ __attribute__((aligned(16))) uchar lds_raw[];
    LAS uchar* lds = (LAS uchar*)lds_raw;
    cg::grid_group grid = cg::this_grid();
    const int lo = a.lo, hi = a.hi; int ph = 0;
    volatile LAS unsigned* xst = (volatile LAS unsigned*)(lds + LDS_ST_OFF);
    if (threadIdx.x == 0) { xst[0] = 0u; xst[1] = 0u; }
    __syncthreads();
    XcdBarrier xb = xcd_barrier_post((unsigned*)(a.ws + WS_BAR), xst);
#define PH_BEGIN if (ph >= lo && ph < hi) {
#define PH_END } if (ph >= lo && ph + 1 < hi) { if (lo < 0) grid.sync();   xcd_barrier(xb); if (DBL(11) == 2) { xcd_barrier(xb); xcd_barrier(xb); } } ++ph;
    uchar* ws = a.ws;
    u16* Wabin = (u16*)(ws + WS_ABIN); u16* Wabout = (u16*)(ws + WS_ABOUT); u16* Wcdin = (u16*)(ws + WS_CDIN); u16* Wcdout = (u16*)(ws + WS_CDOUT);
    u16* Wgu = (u16*)(ws + WS_GU); u16* Wdown = (u16*)(ws + WS_DOWN); u16* Gf = (u16*)(ws + WS_G);
    u16* H = (u16*)(ws + WS_H); u16* PROJ = (u16*)(ws + WS_B); u16* YT = (u16*)(ws + WS_B + (size_t)T_ * 1024 * 2);     u16* ACT = (u16*)(ws + WS_B); u16* PT = (u16*)(ws + WS_C);
    u16* YCAT = (u16*)(ws + WS_D); u16* MIX = (u16*)(ws + WS_E); float* RSTD = (float*)(ws + WS_RSTD);
    const float* x_in = a.in[0]; const float* norm_g = a.in[1]; float* X = a.out;

    PH_BEGIN
      for (int rep = 0; rep < DBL(0); ++rep) {
        int rot = 0;
        filter_job(lds, a.in[10], a.in[11], a.in[12], a.in[13], a.in[14], a.in[15], a.in[16], Gf);
        for (int j = 0; j < 2; ++j) {
            wt_job(lds, a.in[4] + (size_t)j * 1024 * 2560, 2560, 1024, 2560, Wabin + (size_t)j * 2560 * 1024, 1024, 0, norm_g + (size_t)(2 * j) * 4 * 1024, rot);
            wt_job(lds, a.in[5] + (size_t)j * 1024 * 1024, 1024, 1024, 1024, Wabout + (size_t)j * 1024 * 1024, 1024, 0, nullptr, rot);
            wt_job(lds, a.in[18] + (size_t)j * 1024 * 2048, 2048, 1024, 2048, Wcdin + (size_t)j * 2048 * 1024, 1024, 0, norm_g + (size_t)(2 * j + 1) * 4 * 1024, rot);
            wt_job(lds, a.in[19] + (size_t)j * 1024 * 1024 + 512 * 1024, 1024, 512, 1024, Wcdout + (size_t)j * 1024 * 1024 + 512, 1024, 0, nullptr, rot);
            fold_job(a.in[20] + (size_t)j * 4 * 128 * 128, a.in[21] + j * 512, a.in[19] + (size_t)j * 1024 * 1024, Wcdout + (size_t)j * 1024 * 1024);
        }
        for (int i = 0; i < 4; ++i) {
            wt_job(lds, a.in[2] + (size_t)i * 1024 * 5632, 5632, 1024, 5632, Wgu + (size_t)i * 5632 * 1024, 1024, 1, norm_g + (size_t)(i * 4 + 2) * 1024, rot);
            wt_job(lds, a.in[3] + (size_t)i * 2816 * 1024, 1024, 2816, 1024, Wdown + (size_t)i * 1024 * 2816, 2816, 0, nullptr, rot);
        }
      }
        resid_pass(x_in, H, nullptr, nullptr, RSTD, nullptr);
    PH_END

#pragma unroll 1
    for (int i = 0; i < 4; ++i) {
        const int j = i >> 1; const bool even = (i & 1) == 0;
        const float* g4 = norm_g + (size_t)i * 4 * 1024;
        PH_BEGIN
            { const int N = even ? 1024 : 2048;
              pg8::Gemm g{H, even ? Wabin + (size_t)j * 2560 * 1024 : Wcdin + (size_t)j * 2048 * 1024, T_, N, 1024};
              pg8::StaticOrder S; S.init(T_, N, (int)gridDim.x, (int)blockIdx.x);
              pg8::EpiBf16G E{PROJ, N, even ? 4 : 0, RSTD};
#ifndef SKIP_G1
              for (int rep = 0; rep < DBL(6); ++rep) pg8::gemm_phase<pg8::EpiBf16G, pg8::StaticOrder, false>(lds, g, S, E, nullptr);
#endif
            }
            if (even) {
              pg8::Gemm g{H, Wabin + (size_t)j * 2560 * 1024 + (size_t)1024 * 1024, T_, 1536, 1024};
              pg8::StaticOrder S; S.init(T_, 1536, (int)gridDim.x, (int)blockIdx.x);
              pg8::EpiPT E{PT, RSTD};
              pg8::gemm_phase<pg8::EpiPT, pg8::StaticOrder, false>(lds, g, S, E, nullptr);
            }
        PH_END
        if (even) {
            PH_BEGIN
                for (int rep = 0; rep < DBL(1); ++rep) gating_phase(lds, PROJ, a.in[6] + j * 512, a.in[7] + (size_t)j * 4 * 128 * 128, a.in[8] + j * 512, YCAT);
                for (int rep = 0; rep < DBL(3); ++rep) hyena_phase(lds, PT, Gf + (size_t)j * 2 * 512 * 4096, a.in[9] + (size_t)j * 3 * 1536, a.in[17] + j * 1024, YT);
            PH_END
            PH_BEGIN
                for (int rep = 0; rep < DBL(4); ++rep) transpose_back_phase(lds, YT, YCAT);
            PH_END
        } else {
            PH_BEGIN
                for (int rep = 0; rep < DBL(5); ++rep) stencil_phase(PROJ, a.in[22] + (size_t)j * 3 * 512, YCAT);
            PH_END
        }
        PH_BEGIN
            pg8::Gemm g{YCAT, even ? Wabout + (size_t)j * 1024 * 1024 : Wcdout + (size_t)j * 1024 * 1024, T_, 1024, 1024};
            pg8::StaticOrder S; S.init(T_, 1024, (int)gridDim.x, (int)blockIdx.x);
            pg8::EpiBf16G E{MIX, 1024, 0, nullptr};

#ifndef SKIP_G2
            for (int rep = 0; rep < DBL(7); ++rep) pg8::gemm_phase<pg8::EpiBf16G, pg8::StaticOrder, false>(lds, g, S, E, nullptr);
#endif
        PH_END
        PH_BEGIN
            if (DBL(10) == 2) resid_pass(nullptr, (u16*)(ws + WS_C), MIX, g4 + 1024, (float*)(ws + WS_B), nullptr);
            resid_pass(nullptr, H, MIX, g4 + 1024, RSTD, nullptr);
        PH_END
        PH_BEGIN
            pg8::Gemm g{H, Wgu + (size_t)i * 5632 * 1024, T_, 5632, 1024};
            pg8::StaticOrder S; S.init(T_, 5632, (int)gridDim.x, (int)blockIdx.x);
            pg8::EpiSwiGLU E{ACT, DFF, RSTD};

#ifndef SKIP_G3
            for (int rep = 0; rep < DBL(8); ++rep) pg8::gemm_phase<pg8::EpiSwiGLU, pg8::StaticOrder, false>(lds, g, S, E, nullptr);
#endif
        PH_END
        PH_BEGIN
            pg8::Gemm g{ACT, Wdown + (size_t)i * 1024 * 2816, T_, 1024, DFF};
            pg8::StaticOrder S; S.init(T_, 1024, (int)gridDim.x, (int)blockIdx.x);
            pg8::EpiBf16G E{MIX, 1024, 0, nullptr};

#ifndef SKIP_G4
            for (int rep = 0; rep < DBL(9); ++rep) pg8::gemm_phase<pg8::EpiBf16G, pg8::StaticOrder, false>(lds, g, S, E, nullptr);
#endif
        PH_END
        PH_BEGIN
            if (DBL(10) == 2) resid_pass(nullptr, (u16*)(ws + WS_C), MIX, g4 + 3072, (float*)(ws + WS_B), nullptr);
            resid_pass(nullptr, H, MIX, g4 + 3072, RSTD, (i == 3) ? X : nullptr);
        PH_END
    }
#undef PH_BEGIN
#undef PH_END
}

extern "C" void kernel_launch(void* const* d_in, const int* in_sizes, int n_in, void* d_out, int out_size, void* d_ws, size_t ws_size, hipStream_t stream) {
    static int grid = 0;
    if (grid == 0) {
        if (n_in != 23 || out_size != T_ * DM || ws_size < WS_END) { fprintf(stderr, "kernel_launch: unexpected problem (n_in %d out %d ws %zu)\n", n_in, out_size, ws_size); grid = -1; return; }
        int dev = 0, cus = 0, per_cu = 0;
        (void)hipGetDevice(&dev); (void)hipDeviceGetAttribute(&cus, hipDeviceAttributeMultiprocessorCount, dev);
        if (hipFuncSetAttribute((const void*)fwd_kernel, hipFuncAttributeMaxDynamicSharedMemorySize, LDS_BYTES) != hipSuccess) { fprintf(stderr, "kernel_launch: hipFuncSetAttribute failed\n"); grid = -1; return; }
        if (hipOccupancyMaxActiveBlocksPerMultiprocessor(&per_cu, (const void*)fwd_kernel, NTHR, LDS_BYTES) != hipSuccess || per_cu < 1) { fprintf(stderr, "kernel_launch: occupancy query gave %d\n", per_cu); per_cu = 1; }
        (void)hipGetLastError();
        grid = cus * per_cu;
        fprintf(stderr, "kernel_launch: grid %d (cus %d x %d)\n", grid, cus, per_cu);
    }
    if (grid < 0) return;
    Args a{};
    for (int i = 0; i < 23; ++i) a.in[i] = (const float*)d_in[i];
    a.out = (float*)d_out; a.ws = (uchar*)d_ws;
#if ONE_LAUNCH
    (void)hipMemsetAsync((char*)d_ws + WS_BAR, 0, XCD_BAR_WORDS * 4, stream);
    a.lo = 0; a.hi = NPH;
    void* args[] = {&a};
    hipError_t e = hipLaunchCooperativeKernel((const void*)fwd_kernel, dim3(grid), dim3(NTHR), args, LDS_BYTES, stream);
    if (e != hipSuccess) fprintf(stderr, "kernel_launch: cooperative launch failed: %s (grid %d)\n", hipGetErrorString(e), grid);
#else
    for (int p = 0; p < NPH; ++p) { a.lo = p; a.hi = p + 1;
        hipLaunchKernelGGL(fwd_kernel, dim3(grid), dim3(NTHR), LDS_BYTES, stream, a); }
#endif
}
```

```cpp
#include <hip/hip_runtime.h>
#include <hip/hip_cooperative_groups.h>
#include <cstdio>
namespace cg = cooperative_groups;

#ifndef ONE_LAUNCH
#define ONE_LAUNCH 1
#endif
#ifndef DBL_MASK
#define DBL_MASK 0
#endif
#ifndef ALIGN_EPI
#define ALIGN_EPI 1
#endif
#ifndef USE_SP2
#define USE_SP2 1
#endif
#define DBL(bit) (((DBL_MASK >> (bit)) & 1) ? 2 : 1)

__device__ __forceinline__ int opaque_tid() { int t = (int)threadIdx.x; asm volatile("" : "+v"(t)); return t; }
namespace pg8 {
#define PG8_LAS __attribute__((address_space(3)))
typedef unsigned short bf16_t;
typedef short bf16x8 __attribute__((ext_vector_type(8)));
typedef float f32x4 __attribute__((ext_vector_type(4)));
typedef unsigned u32x4 __attribute__((ext_vector_type(4)));
constexpr int RS_LDS_OFF = 132096;
constexpr int EPI_LDS_OFF = 134144, EPI_LDS_WAVE = 2304;
constexpr int BM = 256, BK = 64, HALF = 128, HTB = HALF * BK * 2  , STAGE_BYTES = 8 * HTB, NXCD = 8, WGM = 8;

__host__ __device__ __forceinline__ int lds_byte(int r, int c) { const int st = (r >> 4) * 2 + (c >> 5), rr = r & 15, cc = c & 31, ob = rr * 64 + cc * 2; return st * 1024 + (ob ^ (((ob >> 9) & 1) << 5)); }
__host__ __device__ __forceinline__ void stage_rc(int b, int& R, int& C) { const int st = b / 1024, sb = b % 1024, swz = sb ^ (((sb >> 9) & 1) << 5); R = (st >> 1) * 16 + swz / 64; C = (st & 1) * 32 + (swz % 64) / 2; }
__host__ __device__ __forceinline__ int perm32(int rho) { const int n = rho >> 4, i = rho & 15; return 8 * (i >> 2) + 4 * n + (i & 3); }
struct Unit { int pm, pn; };
struct Gemm { const bf16_t* A; const bf16_t* Bt; int M, N, K; };

struct StaticOrder {
    int nM, nN, nwg, G, c;
    __host__ __device__ void init(int M, int N, int G_, int c_) { nM = M / BM; nN = N / BM; nwg = nM * nN; G = G_; c = c_; }
    __host__ __device__ bool next(int i, Unit& u) const {
        const long L = (long)i * G + c; if (L >= nwg) return false;
        int wgid = (int)L; { const int q = nwg / NXCD, r = nwg % NXCD, xcd = wgid % NXCD, off = wgid / NXCD; wgid = (xcd < r ? xcd * (q + 1) : r * (q + 1) + (xcd - r) * q) + off; }
        const int nig = WGM * nN, gid = wgid / nig, fm = gid * WGM, gsz = (nM - fm) < WGM ? (nM - fm) : WGM;
        u.pm = fm + ((wgid % nig) % gsz); u.pn = (wgid % nig) / gsz; return true;
    }
    __device__ __forceinline__ void a_ready(const Unit&) const {}
    __device__ __forceinline__ void done(const Unit&) const {}
};
__device__ __forceinline__ unsigned cvt_pk_bf16(float lo, float hi) { unsigned r; asm volatile("v_cvt_pk_bf16_f32 %0, %1, %2" : "=v"(r) : "v"(lo), "v"(hi)); return r; }

__device__ __forceinline__ float gelu_tanh_f(float x) { const float y = 1.5957691216f * (x + 0.044715f * x * x * x); return x * __builtin_amdgcn_rcpf(1.0f + __expf(-y)); }
__device__ __forceinline__ float silu_f(float x) { return x * __builtin_amdgcn_rcpf(1.0f + __expf(-x)); }

struct EpiBf16G {
    static constexpr bool PERM = true, AFTER_DRAIN = false, SWAP = false; static constexpr int NSTORES = 16;
    bf16_t* O; int ldc; int gelu_tiles; const float* rs;
    __device__ __forceinline__ void operator()(const f32x4 (&acc)[2][2][4][2], const Unit& u, int wr, int wc, int fr, int fq, const PG8_LAS float* rsl, PG8_LAS unsigned char* eslot) const {
        const int lane = fq * 16 + fr, lr = lane >> 2, lc = (lane & 3) * 8;
        const int rowb = u.pm * BM + wr * 64, colb = u.pn * BM + wc * 32;
        const bool act = u.pn < gelu_tiles;
#pragma unroll
        for (int ai = 0; ai < 2; ++ai)
#pragma unroll
            for (int m = 0; m < 4; ++m) {
                const float sc = rs ? rsl[wr * 64 + fr + ai * HALF + m * 16] : 1.0f;
#pragma unroll
                for (int bj = 0; bj < 2; ++bj) { f32x4 v0 = acc[ai][bj][m][0] * sc, v1 = acc[ai][bj][m][1] * sc;
                    if (act) {
#pragma unroll
                        for (int j = 0; j < 4; ++j) { v0[j] = gelu_tanh_f(v0[j]); v1[j] = gelu_tanh_f(v1[j]); } }
                    u32x4 w; w.x = cvt_pk_bf16(v0[0], v0[1]); w.y = cvt_pk_bf16(v0[2], v0[3]); w.z = cvt_pk_bf16(v1[0], v1[1]); w.w = cvt_pk_bf16(v1[2], v1[3]);
                    PG8_LAS unsigned char* sl = eslot;
                    *(PG8_LAS u32x4*)(sl + fr * 64 + fq * 16) = w;
                    const u32x4 w2 = *(const PG8_LAS u32x4*)(sl + lane * 16);
                    *(u32x4*)(O + (size_t)(rowb + ai * HALF + m * 16 + lr) * ldc + colb + bj * HALF + lc) = w2; } }
    }
};
struct EpiPT {
    static constexpr bool PERM = false, AFTER_DRAIN = false, SWAP = true; static constexpr int NSTORES = 16;
    bf16_t* O; const float* rs;
    __device__ __forceinline__ void operator()(const f32x4 (&acc)[2][2][4][2], const Unit& u, int wr, int wc, int fr, int fq, const PG8_LAS float* rsl, PG8_LAS unsigned char* eslot) const {
        typedef unsigned u32x2_t __attribute__((ext_vector_type(2)));
        const int lane = fq * 16 + fr;
        const int rowb = u.pm * BM + wr * 64; const int b = rowb >> 11, s0 = rowb & 2047;
#pragma unroll
        for (int ai = 0; ai < 2; ++ai)
#pragma unroll
            for (int bj = 0; bj < 2; ++bj)
#pragma unroll
                for (int n = 0; n < 2; ++n) { const int col0 = u.pn * BM + bj * HALF + wc * 32 + n * 16;
#pragma unroll
                    for (int m = 0; m < 4; ++m) { const f32x4 sc = *(const PG8_LAS f32x4*)(rsl + wr * 64 + 4 * fq + ai * HALF + m * 16);
                        const f32x4 v = acc[ai][bj][m][n] * sc;
                        u32x2_t w; w.x = cvt_pk_bf16(v[0], v[1]); w.y = cvt_pk_bf16(v[2], v[3]);
                        *(PG8_LAS u32x2_t*)(eslot + fr * 144 + (16 * m + 4 * fq) * 2) = w; }
#pragma unroll
                    for (int k = 0; k < 2; ++k) { const int c = lane + 64 * k, col = c >> 3, ch = c & 7;
                        const u32x4 w2 = *(const PG8_LAS u32x4*)(eslot + col * 144 + ch * 16);
                        *(u32x4*)(O + ((size_t)(col0 + col) * 32 + b) * 2048 + s0 + ai * HALF + ch * 8) = w2; } }
    }
};
struct EpiSwiGLU {
    static constexpr bool PERM = true, AFTER_DRAIN = false, SWAP = false; static constexpr int NSTORES = 8;
    bf16_t* O; int ldc; const float* rs;
    __device__ __forceinline__ void operator()(const f32x4 (&acc)[2][2][4][2], const Unit& u, int wr, int wc, int fr, int fq, const PG8_LAS float* rsl, PG8_LAS unsigned char* eslot) const {
        const int lane = fq * 16 + fr, lr = lane >> 2, lc = (lane & 3) * 8;
        const int rowb = u.pm * BM + wr * 64, colb = u.pn * HALF + wc * 32;
#pragma unroll
        for (int ai = 0; ai < 2; ++ai)
#pragma unroll
            for (int m = 0; m < 4; ++m) {
                const float sc = rsl[wr * 64 + fr + ai * HALF + m * 16];
                const f32x4 g0 = acc[ai][0][m][0] * sc, g1 = acc[ai][0][m][1] * sc, u0 = acc[ai][1][m][0] * sc, u1 = acc[ai][1][m][1] * sc;
                const f32x4 a0 = g0 * (-1.4426950408889634f), a1 = g1 * (-1.4426950408889634f);
                f32x4 e0, e1;
#pragma unroll
                for (int j = 0; j < 4; ++j) { e0[j] = __builtin_amdgcn_exp2f(a0[j]); e1[j] = __builtin_amdgcn_exp2f(a1[j]); }
                const f32x4 d0 = e0 + 1.0f, d1 = e1 + 1.0f;
                f32x4 r0, r1;
#pragma unroll
                for (int j = 0; j < 4; ++j) { r0[j] = __builtin_amdgcn_rcpf(d0[j]); r1[j] = __builtin_amdgcn_rcpf(d1[j]); }
                const f32x4 v0 = (g0 * u0) * r0, v1 = (g1 * u1) * r1;
                u32x4 w; w.x = cvt_pk_bf16(v0[0], v0[1]); w.y = cvt_pk_bf16(v0[2], v0[3]); w.z = cvt_pk_bf16(v1[0], v1[1]); w.w = cvt_pk_bf16(v1[2], v1[3]);
                PG8_LAS unsigned char* sl = eslot;
                *(PG8_LAS u32x4*)(sl + fr * 64 + fq * 16) = w;
                const u32x4 w2 = *(const PG8_LAS u32x4*)(sl + lane * 16);
                *(u32x4*)(O + (size_t)(rowb + ai * HALF + m * 16 + lr) * ldc + colb + lc) = w2; }
    }
};

template <class Epi, class Sched, bool STAMP = false>
__device__ __forceinline__ void gemm_phase(PG8_LAS unsigned char* lds, const Gemm g, const Sched& S, const Epi& E, unsigned long long* stamps) {
    const int tid = opaque_tid(), wid = __builtin_amdgcn_readfirstlane(tid >> 6), lane = tid & 63, wr = wid >> 2, wc = wid & 3, fr = lane & 15, fq = lane >> 4;
    const int K = g.K, nt = K / BK;
    int ts_lo = 0, ts_hi = 0, nts = 0; const unsigned long long rt_entry = STAMP ? (unsigned long long)wall_clock64() : 0ull;
#define PG8_STAMP() do { if (STAMP && wid == 0 && nts < 64) { const unsigned long long _c = (unsigned long long)clock64(); \
        ts_lo = (lane == nts) ? (int)(unsigned)_c : ts_lo; ts_hi = (lane == nts) ? (int)(unsigned)(_c >> 32) : ts_hi; ++nts; } } while (0)
    PG8_STAMP();
    unsigned voffA[2], voffB[2];
#pragma unroll
    for (int i = 0; i < 2; ++i) { int R, C; stage_rc(tid * 16 + i * 8192, R, C); const int Rb = Epi::PERM ? ((R & ~31) + perm32(R & 31)) : R;
        voffA[i] = (unsigned)(R * K + C) * 2u; voffB[i] = (unsigned)(Rb * K + C) * 2u; }
    const size_t kstep = (size_t)(BK * 2);
    const size_t hstep = (size_t)HALF * K * 2;
    const size_t tstep = 2 * hstep;
    const unsigned ldsw = (unsigned)wid * 1024u;
    const int aoff = lds_byte(wr * 64 + fr, fq * 8), boff = lds_byte(wc * 32 + fr, fq * 8);
#define PG8_SA(b, h) (((b) * 2 + (h)) * HTB)
#define PG8_SB(b, h) ((4 + (b) * 2 + (h)) * HTB)
#define PG8_STAGE(bufoff, gbase, voff) do { _Pragma("unroll") for (int _i = 0; _i < 2; ++_i) \
        __builtin_amdgcn_global_load_lds((const unsigned*)((const char*)(gbase) + (voff)[_i]), (PG8_LAS unsigned*)(lds + (bufoff) + ldsw + _i * 8192), 16, 0, 0); } while (0)
#define PG8_LDA(dst, b, h) do { _Pragma("unroll") for (int m = 0; m < 4; ++m) _Pragma("unroll") for (int k = 0; k < 2; ++k) dst[m][k] = *(const PG8_LAS bf16x8*)(lds + PG8_SA(b, h) + aoff + m * 2048 + k * 1024); } while (0)
#define PG8_LDB(dst, b, h) do { _Pragma("unroll") for (int n = 0; n < 2; ++n) _Pragma("unroll") for (int k = 0; k < 2; ++k) dst[n][k] = *(const PG8_LAS bf16x8*)(lds + PG8_SB(b, h) + boff + n * 2048 + k * 1024); } while (0)
#define PG8_MMA(ai, bj, At, Bt) do { __builtin_amdgcn_s_setprio(1); _Pragma("unroll") for (int m = 0; m < 4; ++m) _Pragma("unroll") for (int n = 0; n < 2; ++n) _Pragma("unroll") for (int k = 0; k < 2; ++k) \
        acc[ai][bj][m][n] = Epi::SWAP ? __builtin_amdgcn_mfma_f32_16x16x32_bf16(At[m][k], Bt[n][k], acc[ai][bj][m][n], 0, 0, 0) : __builtin_amdgcn_mfma_f32_16x16x32_bf16(Bt[n][k], At[m][k], acc[ai][bj][m][n], 0, 0, 0); __builtin_amdgcn_s_setprio(0); } while (0)
#define PG8_WAIT_V(n) asm volatile("s_waitcnt vmcnt(" #n ")" ::: "memory")
#define PG8_WAIT_L(n) asm volatile("s_waitcnt lgkmcnt(" #n ")" ::: "memory")
#define PG8_BAR __builtin_amdgcn_s_barrier()
#define PG8_SCHED __builtin_amdgcn_sched_barrier(0)
#define PG8_STAGE_RS(unit, buf) do { if (E.rs != nullptr && wid < 4) __builtin_amdgcn_global_load_lds((const unsigned*)(E.rs + (unit).pm * BM + wid * 64 + lane), (PG8_LAS unsigned*)(lds + RS_LDS_OFF + (buf) * 1024 + wid * 256), 4, 0, 0); } while (0)
    Unit cur, nxt; int ui = 0;
    if (!S.next(0, cur)) return;
    f32x4 acc[2][2][4][2];
#pragma unroll
    for (int a = 0; a < 2; ++a)
#pragma unroll
        for (int b = 0; b < 2; ++b)
#pragma unroll
            for (int m = 0; m < 4; ++m)
#pragma unroll
                for (int n = 0; n < 2; ++n) acc[a][b][m][n] = (f32x4){0.f, 0.f, 0.f, 0.f};
    bf16x8 At[4][2], B0[2][2], B1[2][2];
    const char* cA = (const char*)g.A + (size_t)cur.pm * tstep; const char* cB = (const char*)g.Bt + (size_t)cur.pn * tstep;
    S.a_ready(cur);
    PG8_STAGE_RS(cur, 0);
#if USE_SP2
    PG8_STAGE(PG8_SB(0, 0), cB, voffB); PG8_STAGE(PG8_SB(0, 1), cB + hstep, voffB); PG8_STAGE(PG8_SA(0, 0), cA, voffA); PG8_STAGE(PG8_SA(0, 1), cA + hstep, voffA);
    if (wr == 1) PG8_BAR;
    PG8_WAIT_V(2); PG8_BAR;
    PG8_STAGE(PG8_SB(1, 0), cB + kstep, voffB); PG8_STAGE(PG8_SA(1, 0), cA + kstep, voffA); PG8_STAGE(PG8_SB(1, 1), cB + hstep + kstep, voffB); PG8_STAGE(PG8_SA(1, 1), cA + hstep + kstep, voffA);
    PG8_WAIT_V(8); PG8_BAR;
#else
    PG8_STAGE(PG8_SB(0, 0), cB, voffB); PG8_STAGE(PG8_SA(0, 0), cA, voffA); PG8_STAGE(PG8_SB(0, 1), cB + hstep, voffB); PG8_STAGE(PG8_SA(0, 1), cA + hstep, voffA);
    if (wr == 1) PG8_BAR;
    PG8_WAIT_V(4); PG8_BAR;
    PG8_STAGE(PG8_SB(1, 0), cB + kstep, voffB); PG8_STAGE(PG8_SA(1, 0), cA + kstep, voffA); PG8_STAGE(PG8_SB(1, 1), cB + hstep + kstep, voffB); PG8_STAGE(PG8_SA(1, 1), cA + hstep + kstep, voffA);
    PG8_WAIT_V(8); PG8_BAR;
#endif
    PG8_STAMP();
    for (;;) {
        const bool has_next = S.next(ui + 1, nxt);
        const char* nA = has_next ? (const char*)g.A + (size_t)nxt.pm * tstep : cA; const char* nB = has_next ? (const char*)g.Bt + (size_t)nxt.pn * tstep : cB;
        for (int t = 0; t < nt; t += 2) {
            const bool last = (t == nt - 2);
            const char* a2 = last ? nA : cA + (size_t)(t + 2) * kstep; const char* b2 = last ? nB : cB + (size_t)(t + 2) * kstep;
            const char* a3 = a2 + kstep; const char* b3 = b2 + kstep;
            if (last && has_next) { S.a_ready(nxt); PG8_STAGE_RS(nxt, (ui + 1) & 1); }
#if USE_SP2
            const int relaxed = __builtin_amdgcn_readfirstlane((t == 0 && ui > 0) ? 1 : 0);
#define PG8_WAIT_V8R asm volatile("s_cmp_lg_u32 %0, 0\n\ts_cbranch_scc1 .Lpg8rlx%=\n\ts_waitcnt vmcnt(8)\n\ts_branch .Lpg8end%=\n.Lpg8rlx%=:\n\ts_waitcnt vmcnt(%1)\n.Lpg8end%=:" :: "s"(relaxed), "n"(8 + Epi::NSTORES) : "memory", "scc")
            PG8_LDB(B0, 0, 0); PG8_LDB(B1, 0, 1); PG8_SCHED; PG8_LDA(At, 0, 0);
            PG8_WAIT_V8R; PG8_WAIT_L(0); PG8_BAR; PG8_MMA(0, 0, At, B0); PG8_MMA(0, 1, At, B1); PG8_BAR; PG8_SCHED;
            PG8_LDA(At, 0, 1); PG8_STAGE(PG8_SB(0, 0), b2, voffB); PG8_STAGE(PG8_SB(0, 1), b2 + hstep, voffB); PG8_STAGE(PG8_SA(0, 0), a2, voffA);
            PG8_WAIT_V8R; PG8_WAIT_L(0); PG8_BAR; PG8_MMA(1, 0, At, B0); PG8_MMA(1, 1, At, B1); PG8_BAR; PG8_SCHED;
            PG8_LDB(B0, 1, 0); PG8_LDB(B1, 1, 1); PG8_SCHED; PG8_LDA(At, 1, 0); PG8_STAGE(PG8_SA(0, 1), a2 + hstep, voffA);
            PG8_WAIT_V8R; PG8_WAIT_L(0); PG8_BAR; PG8_MMA(0, 0, At, B0); PG8_MMA(0, 1, At, B1); PG8_BAR; PG8_SCHED;
            PG8_LDA(At, 1, 1); PG8_STAGE(PG8_SB(1, 0), b3, voffB); PG8_STAGE(PG8_SB(1, 1), b3 + hstep, voffB); PG8_STAGE(PG8_SA(1, 0), a3, voffA);
            PG8_WAIT_V(8); PG8_WAIT_L(0); PG8_BAR; PG8_MMA(1, 0, At, B0); PG8_MMA(1, 1, At, B1); PG8_BAR; PG8_SCHED;
            PG8_STAGE(PG8_SA(1, 1), a3 + hstep, voffA);
#undef PG8_WAIT_V8R
#else
            PG8_LDB(B0, 0, 0); PG8_SCHED; PG8_LDA(At, 0, 0);
            PG8_WAIT_L(8); PG8_BAR; PG8_WAIT_L(0); PG8_MMA(0, 0, At, B0); PG8_BAR; PG8_SCHED;
            PG8_LDB(B1, 0, 1); PG8_STAGE(PG8_SB(0, 0), b2, voffB);
            PG8_BAR; PG8_WAIT_L(0); PG8_MMA(0, 1, At, B1); PG8_BAR;
            PG8_LDA(At, 0, 1); PG8_STAGE(PG8_SA(0, 0), a2, voffA);
            PG8_BAR; PG8_WAIT_L(0); PG8_MMA(1, 0, At, B0); PG8_BAR; PG8_SCHED;
            PG8_STAGE(PG8_SB(0, 1), b2 + hstep, voffB);
            { const int relaxed = __builtin_amdgcn_readfirstlane((t == 0 && ui > 0) ? 1 : 0);
              asm volatile("s_cmp_lg_u32 %0, 0\n\ts_cbranch_scc1 .Lpg8rlx%=\n\ts_waitcnt vmcnt(6)\n\ts_branch .Lpg8end%=\n.Lpg8rlx%=:\n\ts_waitcnt vmcnt(%1)\n.Lpg8end%=:" :: "s"(relaxed), "n"(6 + Epi::NSTORES) : "memory", "scc"); }
            PG8_BAR; PG8_MMA(1, 1, At, B1); PG8_BAR;
            PG8_LDB(B0, 1, 0); PG8_SCHED; PG8_LDA(At, 1, 0); PG8_STAGE(PG8_SA(0, 1), a2 + hstep, voffA);
            PG8_WAIT_L(8); PG8_BAR; PG8_WAIT_L(0); PG8_MMA(0, 0, At, B0); PG8_BAR; PG8_SCHED;
            PG8_LDB(B1, 1, 1); PG8_STAGE(PG8_SB(1, 0), b3, voffB);
            PG8_BAR; PG8_WAIT_L(0); PG8_MMA(0, 1, At, B1); PG8_BAR;
            PG8_LDA(At, 1, 1); PG8_STAGE(PG8_SA(1, 0), a3, voffA);
            PG8_BAR; PG8_WAIT_L(0); PG8_MMA(1, 0, At, B0); PG8_BAR; PG8_SCHED;
            PG8_STAGE(PG8_SB(1, 1), b3 + hstep, voffB);
            PG8_WAIT_V(6); PG8_BAR; PG8_MMA(1, 1, At, B1); PG8_BAR;
            PG8_STAGE(PG8_SA(1, 1), a3 + hstep, voffA);
#endif
        }
        PG8_STAMP();
#if ALIGN_EPI
        if (wr == 0) PG8_BAR;
#endif
        if constexpr (!Epi::AFTER_DRAIN) { E(acc, cur, wr, wc, fr, fq, (const PG8_LAS float*)(lds + RS_LDS_OFF + (ui & 1) * 1024), lds + EPI_LDS_OFF + wid * EPI_LDS_WAVE); S.done(cur); }
        PG8_STAMP();
        if (!has_next) break;
#pragma unroll
        for (int a = 0; a < 2; ++a)
#pragma unroll
            for (int b = 0; b < 2; ++b)
#pragma unroll
                for (int m = 0; m < 4; ++m)
#pragma unroll
                    for (int n = 0; n < 2; ++n) acc[a][b][m][n] = (f32x4){0.f, 0.f, 0.f, 0.f};
        cur = nxt; cA = nA; cB = nB; ++ui;
#if ALIGN_EPI
        if (wr == 1) PG8_BAR;
#endif
    }
    PG8_WAIT_V(0);
#if !ALIGN_EPI
    if (wr == 0) PG8_BAR;
#endif
    PG8_BAR;
    if constexpr (Epi::AFTER_DRAIN) { E.fused(acc, cur, wr, wc, fr, fq, lds, wid, lane); S.done(cur); }
    PG8_STAMP();
    if (STAMP && wid == 0) { stamps[lane] = lane < nts ? (((unsigned long long)(unsigned)ts_hi << 32) | (unsigned)ts_lo) : 0ull;
        if (lane == 62) stamps[62] = rt_entry; if (lane == 63) stamps[63] = (unsigned long long)wall_clock64(); }
#undef PG8_STAMP
#undef PG8_SA
#undef PG8_SB
#undef PG8_STAGE
#undef PG8_LDA
#undef PG8_LDB
#undef PG8_MMA
#undef PG8_WAIT_V
#undef PG8_WAIT_L
#undef PG8_BAR
#undef PG8_SCHED
#undef PG8_STAGE_RS
}
}

#define LAS PG8_LAS
typedef unsigned short u16;
typedef unsigned char uchar;
using pg8::bf16x8; using pg8::f32x4; using pg8::u32x4; using pg8::cvt_pk_bf16;
typedef float f32x16 __attribute__((ext_vector_type(16)));
typedef unsigned u32x2 __attribute__((ext_vector_type(2)));
typedef int i32x4 __attribute__((ext_vector_type(4)));

constexpr int T_ = 65536, DM = 1024, SEQ = 2048, NB = 32, DFF = 2816, NTHR = 512;
constexpr int LDS_ST_OFF = 155648;
constexpr int LDS_BYTES = LDS_ST_OFF + 16;
constexpr size_t SZ_ABIN = 2ull * 2560 * 1024 * 2, SZ_ABOUT = 2ull * 1024 * 1024 * 2, SZ_CDIN = 2ull * 2048 * 1024 * 2, SZ_CDOUT = 2ull * 1024 * 1024 * 2,
                 SZ_GU = 4ull * 5632 * 1024 * 2, SZ_DOWN = 4ull * 1024 * 2816 * 2, SZ_G = 2ull * 2 * 512 * 4096 * 2;
constexpr size_t WS_ABIN = 0, WS_ABOUT = WS_ABIN + SZ_ABIN, WS_CDIN = WS_ABOUT + SZ_ABOUT, WS_CDOUT = WS_CDIN + SZ_CDIN, WS_GU = WS_CDOUT + SZ_CDOUT, WS_DOWN = WS_GU + SZ_GU,
                 WS_G = WS_DOWN + SZ_DOWN,
                 WS_H = WS_G + SZ_G,
                 WS_B = WS_H + (size_t)T_ * 1024 * 2,
                 WS_C = WS_B + (size_t)T_ * 2560 * 2,
                 WS_D = WS_C + (size_t)1536 * 32 * 2048 * 2,
                 WS_E = WS_D + (size_t)T_ * 1024 * 2,
                 WS_BAR = WS_E + (size_t)T_ * 1024 * 2,
                 WS_RSTD = WS_BAR + 16384,
                 WS_END = WS_RSTD + (size_t)T_ * 4;
static_assert(WS_END <= (1ull << 30), "workspace map exceeds 1 GiB");
static_assert((size_t)T_ * DFF * 2 <= WS_D - WS_B, "act does not fit B + C");

__device__ __forceinline__ float bflo(unsigned w) { return __uint_as_float(w << 16); }
__device__ __forceinline__ float bfhi(unsigned w) { return __uint_as_float(w & 0xffff0000u); }
__device__ __forceinline__ float bf2f(u16 v) { return __uint_as_float(((unsigned)v) << 16); }
__device__ __forceinline__ u16 f2bf(float f) { return (u16)(cvt_pk_bf16(f, 0.f) & 0xffffu); }
__device__ __forceinline__ float wave_sum(float v) {
#pragma unroll
    for (int o = 32; o >= 1; o >>= 1) v += __shfl_xor(v, o, 64);
    return v;
}

__device__ void wt_job(LAS uchar* lds, const float* __restrict__ W, int ldw, int K, int N, u16* __restrict__ out, int ldo, int mode, const float* __restrict__ gain, int& rot) {
    LAS float* tile = (LAS float*)lds;
    const int tid = opaque_tid(); const int nkq = K / 256, nnt = N / 64, nsteps = nkq * nnt;
    const int G = (int)gridDim.x; const int first = ((int)blockIdx.x + G - (rot % G)) % G; rot += nsteps;
    for (int ti = first; ti < nsteps; ti += G) {
        const int kq = ti % nkq, nt = ti / nkq; const int k0 = kq * 256, n0 = nt * 64;
        int sc0 = n0; if (mode == 1) { const int pn = n0 >> 8, r = n0 & 255; sc0 = (r < 128) ? (pn * 128 + r) : (DFF + pn * 128 + (r - 128)); }
        float4 v[8];
#pragma unroll
        for (int i = 0; i < 8; ++i) { const int idx = tid + i * 512; const int kk = idx >> 4, c4 = (idx & 15) * 4;
            v[i] = *(const float4*)(W + (size_t)(k0 + kk) * ldw + sc0 + c4); }
#pragma unroll
        for (int i = 0; i < 8; ++i) { const int idx = tid + i * 512; const int kk = idx >> 4, c4 = (idx & 15) * 4;
            const float gk = gain ? gain[k0 + kk] : 1.0f;
            tile[kk * 65 + c4 + 0] = v[i].x * gk; tile[kk * 65 + c4 + 1] = v[i].y * gk; tile[kk * 65 + c4 + 2] = v[i].z * gk; tile[kk * 65 + c4 + 3] = v[i].w * gk; }
        __syncthreads();
#pragma unroll
        for (int q = 0; q < 4; ++q) { const int nn = tid >> 3, kc = q * 64 + (tid & 7) * 8;
          float f0 = tile[(kc + 0) * 65 + nn], f1 = tile[(kc + 1) * 65 + nn], f2 = tile[(kc + 2) * 65 + nn], f3 = tile[(kc + 3) * 65 + nn];
          float f4 = tile[(kc + 4) * 65 + nn], f5 = tile[(kc + 5) * 65 + nn], f6 = tile[(kc + 6) * 65 + nn], f7 = tile[(kc + 7) * 65 + nn];
          u32x4 w; w.x = cvt_pk_bf16(f0, f1); w.y = cvt_pk_bf16(f2, f3); w.z = cvt_pk_bf16(f4, f5); w.w = cvt_pk_bf16(f6, f7);
          *(u32x4*)(out + (size_t)(n0 + nn) * ldo + k0 + kc) = w; }
        __syncthreads();
    }
}
__device__ void fold_job(const float* __restrict__ cw, const float* __restrict__ scale, const float* __restrict__ Wout, u16* __restrict__ out) {
    for (int idx = blockIdx.x * NTHR + opaque_tid(); idx < 512 * 128; idx += gridDim.x * NTHR) {
        const int k = idx >> 7, n0 = (idx & 127) * 8; const int g = k >> 7;
        const float* cwr = cw + (size_t)k * 128; const float* sc = scale + g * 128; const float* wr = Wout + (size_t)(g * 128) * 1024 + n0;
        float acc[8];
#pragma unroll
        for (int u = 0; u < 8; ++u) acc[u] = 0.f;
#pragma unroll 8
        for (int c2 = 0; c2 < 128; ++c2) { const float cf = cwr[c2] * sc[c2]; const float4 w0 = *(const float4*)(wr + (size_t)c2 * 1024), w1 = *(const float4*)(wr + (size_t)c2 * 1024 + 4);
            acc[0] += cf * w0.x; acc[1] += cf * w0.y; acc[2] += cf * w0.z; acc[3] += cf * w0.w; acc[4] += cf * w1.x; acc[5] += cf * w1.y; acc[6] += cf * w1.z; acc[7] += cf * w1.w; }
#pragma unroll
        for (int u = 0; u < 8; ++u) out[(size_t)(n0 + u) * 1024 + k] = f2bf(acc[u]);
    }
}
__device__ void filter_job(LAS uchar* lds, const float* __restrict__ w1a, const float* __restrict__ b1a, const float* __restrict__ freqa, const float* __restrict__ w2a,
                           const float* __restrict__ b2a, const float* __restrict__ w3a, const float* __restrict__ decaya, u16* __restrict__ Gall) {
    LAS float* h2 = (LAS float*)lds;
    LAS float* zf = h2 + 64 * 64;
    LAS float* h1 = zf + 64 * 33;
    LAS float* w3s = h2 + 64 * 64;
    const int tid = opaque_tid(), lane = tid & 63, wave = __builtin_amdgcn_readfirstlane(tid >> 6);
    for (int item = blockIdx.x; item < 256; item += gridDim.x) {
        const int j = item >> 7, tg = (item >> 2) & 31, cq = item & 3, t0 = tg * 64;
        const float* w1 = w1a + j * 33 * 64; const float* b1 = b1a + j * 64; const float* freq = freqa + j * 128; const float* w2 = w2a + j * 4096; const float* b2 = b2a + j * 64;
        const float* w3 = w3a + (size_t)j * 64 * 2048; const float* decay = decaya + j * 2048; u16* Gj = Gall + (size_t)j * 2 * 512 * 4096;
        float4 wpre[16];
#pragma unroll
        for (int i = 0; i < 16; ++i) { const int idx = tid + i * NTHR; wpre[i] = *(const float4*)(w3 + (size_t)(idx >> 7) * 2048 + cq * 512 + (idx & 127) * 4); }
        for (int idx = tid; idx < 64 * 33; idx += NTHR) { const int tt = idx / 33, f = idx - tt * 33; const float t = (float)(t0 + tt);
            float val;
            if (f == 0) val = t / 2047.0f;
            else { const int fi = (f - 1) & 15; const float band = 1e-4f + (float)fi * ((15.0f - 1e-4f) / 15.0f); const float w = 6.283185307179586f * t / 2048.0f; const float fw = w * band;
                   val = (f <= 16) ? cosf(fw) : -sinf(fw); }
            zf[idx] = val; }
        __syncthreads();
        for (int idx = tid; idx < 4096; idx += NTHR) { const int tt = idx >> 6, k = idx & 63; float acc = 0.f;
            for (int f = 0; f < 33; ++f) acc += zf[tt * 33 + f] * w1[f * 64 + k];
            h1[tt * 64 + k] = sinf(freq[k] * (acc + b1[k])); }
        __syncthreads();
        for (int idx = tid; idx < 4096; idx += NTHR) { const int tt = idx >> 6, k = idx & 63; float acc = 0.f;
            for (int k2 = 0; k2 < 64; ++k2) acc += h1[tt * 64 + k2] * w2[k2 * 64 + k];
            h2[k * 64 + tt] = sinf(freq[64 + k] * (acc + b2[k])); }
        __syncthreads();
#pragma unroll
        for (int i = 0; i < 16; ++i) { const int idx = tid + i * NTHR; f32x4 wv; wv.x = wpre[i].x; wv.y = wpre[i].y; wv.z = wpre[i].z; wv.w = wpre[i].w; *(LAS f32x4*)(w3s + (idx >> 7) * 512 + (idx & 127) * 4) = wv; }
        __syncthreads();
        { const int t = t0 + lane; const float t01 = (float)t / 2047.0f;
          for (int ci = 0; ci < 64; ci += 4) { const int cl = wave * 64 + ci, col = cq * 512 + cl; float a0 = 0.f, a1 = 0.f, a2 = 0.f, a3 = 0.f;
#pragma unroll 16
              for (int k = 0; k < 64; ++k) { const f32x4 w = *(const LAS f32x4*)(w3s + k * 512 + cl); const float hv = h2[k * 64 + lane]; a0 += hv * w.x; a1 += hv * w.y; a2 += hv * w.z; a3 += hv * w.w; }
              const float4 dc = *(const float4*)(decay + col);
              a0 *= expf(-t01 * fabsf(dc.x)); a1 *= expf(-t01 * fabsf(dc.y)); a2 *= expf(-t01 * fabsf(dc.z)); a3 *= expf(-t01 * fabsf(dc.w));
              const int dir = col >> 10, o = (col >> 9) & 1, c = col & 511; u16* g = Gj + (size_t)(o * 512 + c) * 4096;
              if (dir == 0) { g[2048 - t] = f2bf(a0); g[4096 + 2048 - t] = f2bf(a1); g[8192 + 2048 - t] = f2bf(a2); g[12288 + 2048 - t] = f2bf(a3);
                              if (t == 0) { g[0] = 0; g[4096] = 0; g[8192] = 0; g[12288] = 0; } }
              else if (t <= 2046) { g[2049 + t] = f2bf(a0); g[4096 + 2049 + t] = f2bf(a1); g[8192 + 2049 + t] = f2bf(a2); g[12288 + 2049 + t] = f2bf(a3); } } }
        __syncthreads();
    }
}

__device__ __forceinline__ void unpack8(const u32x4 v, float (&f)[8]) { f[0] = bflo(v.x); f[1] = bfhi(v.x); f[2] = bflo(v.y); f[3] = bfhi(v.y); f[4] = bflo(v.z); f[5] = bfhi(v.z); f[6] = bflo(v.w); f[7] = bfhi(v.w); }
__device__ __forceinline__ float4 ntload4(const float* p) { const f32x4 v = __builtin_nontemporal_load((const f32x4*)p); float4 r; r.x = v.x; r.y = v.y; r.z = v.z; r.w = v.w; return r; }
__device__ __forceinline__ void ntstore4(float* p, float a, float b, float c, float d) { f32x4 w; w.x = a; w.y = b; w.z = c; w.w = d; __builtin_nontemporal_store(w, (f32x4*)p); }
__device__ __forceinline__ void resid_pass(const float* __restrict__ xin_f, u16* __restrict__ xb, const u16* __restrict__ mix, const float* __restrict__ gpost, float* __restrict__ rstd_out, float* __restrict__ out_f) {
    const int tid = opaque_tid(); const int lane = tid & 63, wave = tid >> 6;
    const int stride = gridDim.x * 8;
    constexpr int NR = 4;
    for (int row0 = blockIdx.x * 8 + wave; row0 < T_; row0 += NR * stride) {
        float x[NR][16];
        if (xin_f) {
#pragma unroll
            for (int k = 0; k < NR; ++k) { const int row = min(row0 + k * stride, T_ - 1);
#pragma unroll
                for (int c = 0; c < 2; ++c) { const float4 a0 = ntload4(xin_f + (size_t)row * 1024 + c * 512 + lane * 8), a1 = ntload4(xin_f + (size_t)row * 1024 + c * 512 + lane * 8 + 4);
                    x[k][c * 8 + 0] = a0.x; x[k][c * 8 + 1] = a0.y; x[k][c * 8 + 2] = a0.z; x[k][c * 8 + 3] = a0.w; x[k][c * 8 + 4] = a1.x; x[k][c * 8 + 5] = a1.y; x[k][c * 8 + 6] = a1.z; x[k][c * 8 + 7] = a1.w; } }
        } else {
            u32x4 xr[NR][2], mr[NR][2];
#pragma unroll
            for (int k = 0; k < NR; ++k) { const int row = min(row0 + k * stride, T_ - 1);
#pragma unroll
                for (int c = 0; c < 2; ++c) { xr[k][c] = *(const u32x4*)(xb + (size_t)row * 1024 + c * 512 + lane * 8); mr[k][c] = __builtin_nontemporal_load((const u32x4*)(mix + (size_t)row * 1024 + c * 512 + lane * 8)); } }
            float g[16];
#pragma unroll
            for (int c = 0; c < 2; ++c) { const float4 a0 = *(const float4*)(gpost + c * 512 + lane * 8), a1 = *(const float4*)(gpost + c * 512 + lane * 8 + 4);
                g[c * 8 + 0] = a0.x; g[c * 8 + 1] = a0.y; g[c * 8 + 2] = a0.z; g[c * 8 + 3] = a0.w; g[c * 8 + 4] = a1.x; g[c * 8 + 5] = a1.y; g[c * 8 + 6] = a1.z; g[c * 8 + 7] = a1.w; }
#pragma unroll
            for (int k = 0; k < NR; ++k) { float m[16]; float ss = 0.f;
#pragma unroll
                for (int c = 0; c < 2; ++c) { float t8[8]; unpack8(mr[k][c], t8);
#pragma unroll
                    for (int e = 0; e < 8; ++e) { m[c * 8 + e] = t8[e]; ss += t8[e] * t8[e]; } }
                ss = wave_sum(ss); const float rstd = rsqrtf(ss * (1.0f / 1024.0f) + 1e-6f);
#pragma unroll
                for (int c = 0; c < 2; ++c) { float t8[8]; unpack8(xr[k][c], t8);
#pragma unroll
                    for (int e = 0; e < 8; ++e) x[k][c * 8 + e] = t8[e] + m[c * 8 + e] * rstd * g[c * 8 + e]; } }
        }
#pragma unroll
        for (int k = 0; k < NR; ++k) { const int row = row0 + k * stride;
            if (row < T_) {
                if (out_f) {
#pragma unroll
                    for (int c = 0; c < 2; ++c) { ntstore4(out_f + (size_t)row * 1024 + c * 512 + lane * 8, x[k][c * 8 + 0], x[k][c * 8 + 1], x[k][c * 8 + 2], x[k][c * 8 + 3]);
                        ntstore4(out_f + (size_t)row * 1024 + c * 512 + lane * 8 + 4, x[k][c * 8 + 4], x[k][c * 8 + 5], x[k][c * 8 + 6], x[k][c * 8 + 7]); }
                } else {
                    float ss = 0.f;
#pragma unroll
                    for (int e = 0; e < 16; ++e) ss += x[k][e] * x[k][e];
                    ss = wave_sum(ss);
                    if (lane == 0) rstd_out[row] = rsqrtf(ss * (1.0f / 1024.0f) + 1e-6f);
#pragma unroll
                    for (int c = 0; c < 2; ++c) { u32x4 w; w.x = cvt_pk_bf16(x[k][c * 8 + 0], x[k][c * 8 + 1]); w.y = cvt_pk_bf16(x[k][c * 8 + 2], x[k][c * 8 + 3]); w.z = cvt_pk_bf16(x[k][c * 8 + 4], x[k][c * 8 + 5]); w.w = cvt_pk_bf16(x[k][c * 8 + 6], x[k][c * 8 + 7]);
                        *(u32x4*)(xb + (size_t)row * 1024 + c * 512 + lane * 8) = w; }
                }
            }
        }
    }
}

constexpr int TRS = 66;
__device__ __forceinline__ void tr_tile8(LAS u16* tiles  , const u16* __restrict__ src, size_t lds_src, size_t src_ts, u16* __restrict__ dst, size_t ldd, size_t dst_ts) {
    const int tid = opaque_tid(), r = tid >> 3, ch = (tid & 7) * 8;
    u32x4 v[8];
#pragma unroll
    for (int k = 0; k < 8; ++k) v[k] = *(const u32x4*)(src + k * src_ts + (size_t)r * lds_src + ch);
#pragma unroll
    for (int k = 0; k < 8; ++k) { LAS u16* tile = tiles + k * 64 * TRS;
        tile[(ch + 0) * TRS + r] = (u16)(v[k].x & 0xffffu); tile[(ch + 1) * TRS + r] = (u16)(v[k].x >> 16);
        tile[(ch + 2) * TRS + r] = (u16)(v[k].y & 0xffffu); tile[(ch + 3) * TRS + r] = (u16)(v[k].y >> 16);
        tile[(ch + 4) * TRS + r] = (u16)(v[k].z & 0xffffu); tile[(ch + 5) * TRS + r] = (u16)(v[k].z >> 16);
        tile[(ch + 6) * TRS + r] = (u16)(v[k].w & 0xffffu); tile[(ch + 7) * TRS + r] = (u16)(v[k].w >> 16); }
    __syncthreads();
#pragma unroll
    for (int k = 0; k < 8; ++k) { const LAS unsigned* p = (const LAS unsigned*)(tiles + k * 64 * TRS + r * TRS + ch);
        u32x4 o; o.x = p[0]; o.y = p[1]; o.z = p[2]; o.w = p[3];
        *(u32x4*)(dst + k * dst_ts + (size_t)r * ldd + ch) = o; }
    __syncthreads();
}
__device__ void transpose_fwd_phase(LAS uchar* lds, const u16* __restrict__ proj, u16* __restrict__ pT) {
    LAS u16* tiles = (LAS u16*)lds;
    for (int it = blockIdx.x; it < NB * 32 * 3; it += gridDim.x) {
        const int c8 = it % 3, st = (it / 3) & 31, b = it / 96;
        tr_tile8(tiles, proj + (size_t)(b * SEQ + st * 64) * 2560 + 1024 + c8 * 512, 2560, 64, pT + ((size_t)(c8 * 512) * NB + b) * SEQ + st * 64, (size_t)NB * SEQ, (size_t)64 * NB * SEQ);
    }
}
__device__ void transpose_back_phase(LAS uchar* lds, const u16* __restrict__ yT, u16* __restrict__ ycat) {
    LAS u16* tiles = (LAS u16*)lds;
    for (int it = blockIdx.x; it < NB * 32; it += gridDim.x) {
        const int st = it & 31, b = it >> 5;
        tr_tile8(tiles, yT + (size_t)b * SEQ + st * 64, (size_t)NB * SEQ, (size_t)64 * NB * SEQ, ycat + (size_t)(b * SEQ + st * 64) * 1024 + 512, 1024, 64);
    }
}
__device__ void gating_phase(LAS uchar* lds, const u16* __restrict__ proj  , const float* __restrict__ ln_g  ,
                             const float* __restrict__ w_s  , const float* __restrict__ b_s  , u16* __restrict__ ycat  ) {
    LAS u16* vT = (LAS u16*)lds;
    LAS u16* wsb = vT + 128 * 136;
    LAS float* stats = (LAS float*)(wsb + 128 * 136);
    const int tid = opaque_tid(), lane = tid & 63, wave = tid >> 6, fr = lane & 15, fq = lane >> 4;
    for (int item = blockIdx.x; item < T_ / 128; item += gridDim.x) {
        const int tok0 = item * 128;
        { u32x4 vv[16];
#pragma unroll
          for (int tt = 0; tt < 16; ++tt) vv[tt] = *(const u32x4*)(proj + (size_t)(tok0 + wave * 16 + tt) * 1024 + 512 + lane * 8);
#pragma unroll
          for (int tt = 0; tt < 16; ++tt) { const int q = wave * 16 + tt; const u32x4 v = vv[tt];
            const float f0 = bflo(v.x), f1 = bfhi(v.x), f2 = bflo(v.y), f3 = bfhi(v.y), f4 = bflo(v.z), f5 = bfhi(v.z), f6 = bflo(v.w), f7 = bfhi(v.w);
            const float mean = wave_sum(f0 + f1 + f2 + f3 + f4 + f5 + f6 + f7) * (1.0f / 512.0f);
            const float d0 = f0 - mean, d1 = f1 - mean, d2 = f2 - mean, d3 = f3 - mean, d4 = f4 - mean, d5 = f5 - mean, d6 = f6 - mean, d7 = f7 - mean;
            const float var = wave_sum(d0 * d0 + d1 * d1 + d2 * d2 + d3 * d3 + d4 * d4 + d5 * d5 + d6 * d6 + d7 * d7) * (1.0f / 512.0f);
            if (lane == 0) { stats[q * 2] = mean; stats[q * 2 + 1] = rsqrtf(var + 1e-5f); } } }
        __syncthreads();
        u32x4 vreg[4]; float4 wreg[8];
#define GATE_LOAD(g) do { _Pragma("unroll") for (int i = 0; i < 4; ++i) { const int idx = tid + i * NTHR; vreg[i] = *(const u32x4*)(proj + (size_t)(tok0 + (idx >> 4)) * 1024 + 512 + (g) * 128 + (idx & 15) * 8); } \
                          _Pragma("unroll") for (int i = 0; i < 8; ++i) { const int idx = tid + i * NTHR; wreg[i] = *(const float4*)(w_s + (size_t)((g) * 128 + (idx >> 5)) * 128 + (idx & 31) * 4); } } while (0)
        GATE_LOAD(0);
#pragma unroll
        for (int g = 0; g < 4; ++g) {
#pragma unroll
            for (int i = 0; i < 4; ++i) { const int idx = tid + i * NTHR; const int q = idx >> 4, c0 = (idx & 15) * 8;
                const u32x4 v = vreg[i];
                const float mean = stats[q * 2], rstd = stats[q * 2 + 1];
                const float4 g0 = *(const float4*)(ln_g + g * 128 + c0), g1 = *(const float4*)(ln_g + g * 128 + c0 + 4);
                vT[(c0 + 0) * 136 + q] = f2bf((bflo(v.x) - mean) * rstd * g0.x); vT[(c0 + 1) * 136 + q] = f2bf((bfhi(v.x) - mean) * rstd * g0.y);
                vT[(c0 + 2) * 136 + q] = f2bf((bflo(v.y) - mean) * rstd * g0.z); vT[(c0 + 3) * 136 + q] = f2bf((bfhi(v.y) - mean) * rstd * g0.w);
                vT[(c0 + 4) * 136 + q] = f2bf((bflo(v.z) - mean) * rstd * g1.x); vT[(c0 + 5) * 136 + q] = f2bf((bfhi(v.z) - mean) * rstd * g1.y);
                vT[(c0 + 6) * 136 + q] = f2bf((bflo(v.w) - mean) * rstd * g1.z); vT[(c0 + 7) * 136 + q] = f2bf((bfhi(v.w) - mean) * rstd * g1.w); }
#pragma unroll
            for (int i = 0; i < 8; ++i) { const int idx = tid + i * NTHR; const int p = idx >> 5, q0 = (idx & 31) * 4;
                const float4 w = wreg[i];
                u32x2 o; o.x = cvt_pk_bf16(w.x, w.y); o.y = cvt_pk_bf16(w.z, w.w);
                *(LAS u32x2*)(wsb + p * 136 + q0) = o; }
            __syncthreads();
            if (g < 3) GATE_LOAD(g + 1);
            const int p = 16 * wave + fr; const size_t tok = (size_t)(tok0 + p); const float bias = b_s[g * 128 + p];
            u32x2 uu[8];
#pragma unroll
            for (int mi = 0; mi < 8; ++mi) uu[mi] = *(const u32x2*)(proj + tok * 1024 + g * 128 + 16 * mi + 4 * fq);
            f32x4 acc[8];
#pragma unroll
            for (int mi = 0; mi < 8; ++mi) acc[mi] = (f32x4){0.f, 0.f, 0.f, 0.f};
#pragma unroll
            for (int kk = 0; kk < 4; ++kk) {
                const bf16x8 bfrag = *(const LAS bf16x8*)(wsb + (16 * wave + fr) * 136 + 32 * kk + 8 * fq);
#pragma unroll
                for (int mi = 0; mi < 8; ++mi) { const bf16x8 afrag = *(const LAS bf16x8*)(vT + (16 * mi + fr) * 136 + 32 * kk + 8 * fq);
                    acc[mi] = __builtin_amdgcn_mfma_f32_16x16x32_bf16(afrag, bfrag, acc[mi], 0, 0, 0); }
            }
#pragma unroll
            for (int mi = 0; mi < 8; ++mi) { const int c = 16 * mi + 4 * fq;
                u32x2 o; o.x = cvt_pk_bf16(bflo(uu[mi].x) * (acc[mi][0] + bias), bfhi(uu[mi].x) * (acc[mi][1] + bias)); o.y = cvt_pk_bf16(bflo(uu[mi].y) * (acc[mi][2] + bias), bfhi(uu[mi].y) * (acc[mi][3] + bias));
                *(u32x2*)(ycat + tok * 1024 + g * 128 + c) = o; }
            __syncthreads();
        }
#undef GATE_LOAD
    }
}

constexpr int HZ_ROW = 4112;
constexpr int HZ_KR0 = NB * HZ_ROW;
constexpr int HZ_KRC = 8208;
static_assert(HZ_KR0 + 2 * HZ_KRC <= LDS_ST_OFF, "hyena LDS");

__device__ __forceinline__ void hy_load_kr(LAS uchar* lds, const u16* __restrict__ g) {
    const int tid = opaque_tid();
    const u32x4 w = *(const u32x4*)(g + tid * 8);
    const unsigned nxt = (tid < 511) ? (unsigned)g[tid * 8 + 8] : 0u;
    *(LAS u32x4*)(lds + HZ_KR0 + tid * 16) = w;
    u32x4 s; s.x = (w.x >> 16) | (w.y << 16); s.y = (w.y >> 16) | (w.z << 16); s.z = (w.z >> 16) | (w.w << 16); s.w = (w.w >> 16) | (nxt << 16);
    *(LAS u32x4*)(lds + HZ_KR0 + HZ_KRC + tid * 16) = s;
}
__device__ __forceinline__ void conv3_8(const u16* __restrict__ p, int s0, float w0, float w1, float w2, float (&o)[8]) {
    const u32x4 v = *(const u32x4*)(p + s0);
    const float prev = (s0 > 0) ? bf2f(p[s0 - 1]) : 0.f, next = (s0 + 8 < SEQ) ? bf2f(p[s0 + 8]) : 0.f;
    const float x0 = bflo(v.x), x1 = bfhi(v.x), x2 = bflo(v.y), x3 = bfhi(v.y), x4 = bflo(v.z), x5 = bfhi(v.z), x6 = bflo(v.w), x7 = bfhi(v.w);
    o[0] = w0 * prev + w1 * x0 + w2 * x1; o[1] = w0 * x0 + w1 * x1 + w2 * x2; o[2] = w0 * x1 + w1 * x2 + w2 * x3; o[3] = w0 * x2 + w1 * x3 + w2 * x4;
    o[4] = w0 * x3 + w1 * x4 + w2 * x5; o[5] = w0 * x4 + w1 * x5 + w2 * x6; o[6] = w0 * x5 + w1 * x6 + w2 * x7; o[7] = w0 * x6 + w1 * x7 + w2 * next;
}
__device__ void hyena_phase(LAS uchar* lds, const u16* __restrict__ pT  , const u16* __restrict__ G  , const float* __restrict__ conv_w  ,
                            const float* __restrict__ skip  , u16* __restrict__ yT  ) {
    const int tid = opaque_tid(), lane = tid & 63, wave = __builtin_amdgcn_readfirstlane(tid >> 6), r = lane & 31, h = lane >> 5;
    const int tbase = 256 * wave;
    const int e0 = 8 * h - r + 2048 - tbase, par = e0 & 1;
    const LAS uchar* abase = lds + HZ_KR0 + par * HZ_KRC + (e0 - par) * 2;
    const LAS uchar* bbase = lds + r * HZ_ROW + 16 * h;
    for (int c = blockIdx.x; c < 512; c += gridDim.x) {
        {
            const u16* src = pT + (size_t)c * NB * SEQ; const float w0 = conv_w[c], w1 = conv_w[1536 + c], w2 = conv_w[3072 + c];
#pragma unroll
            for (int it = 0; it < 16; ++it) { const int idx = tid + it * NTHR; const int b = idx >> 8, s0 = (idx & 255) * 8; float o[8];
                conv3_8(src + (size_t)b * SEQ, s0, w0, w1, w2, o);
                u32x4 w; w.x = cvt_pk_bf16(o[0], o[1]); w.y = cvt_pk_bf16(o[2], o[3]); w.z = cvt_pk_bf16(o[4], o[5]); w.w = cvt_pk_bf16(o[6], o[7]);
                *(LAS u32x4*)(lds + b * HZ_ROW + s0 * 2) = w; }
            hy_load_kr(lds, G + (size_t)c * 4096);
        }
        __syncthreads();
#pragma unroll 1
        for (int o = 0; o < 2; ++o) {
            f32x16 acc[8];
#pragma unroll
            for (int i = 0; i < 8; ++i)
#pragma unroll
                for (int k = 0; k < 16; ++k) acc[i][k] = 0.f;
#pragma unroll 1
            for (int p = 0; p < 2; ++p) {
                bf16x8 W[8];
#pragma unroll
                for (int k = 1; k < 8; ++k) { const LAS unsigned* ap = (const LAS unsigned*)(abase + (16 * p - 32 * k) * 2);
                    i32x4 av; av.x = (int)ap[0]; av.y = (int)ap[1]; av.z = (int)ap[2]; av.w = (int)ap[3]; W[8 - k] = __builtin_bit_cast(bf16x8, av); }
#pragma unroll 1
                for (int J = 0; J < 8; ++J) {
                    const LAS uchar* aj = abase + (16 * p + 256 * J) * 2;
                    const LAS uchar* bj = bbase + (16 * p + 256 * J) * 2;
#pragma unroll
                    for (int jj = 0; jj < 8; ++jj) {
                        const LAS unsigned* ap = (const LAS unsigned*)(aj + 64 * jj);
                        i32x4 av; av.x = (int)ap[0]; av.y = (int)ap[1]; av.z = (int)ap[2]; av.w = (int)ap[3]; W[jj] = __builtin_bit_cast(bf16x8, av);
                        const bf16x8 bb = *(const LAS bf16x8*)(bj + 64 * jj);
#pragma unroll
                        for (int i = 0; i < 8; ++i) acc[i] = __builtin_amdgcn_mfma_f32_32x32x16_bf16(W[(jj - i) & 7], bb, acc[i], 0, 0, 0);
                    }
                }
            }
            { const int cc = 512 * (o + 1) + c; const float w0 = conv_w[cc], w1 = conv_w[1536 + cc], w2 = conv_w[3072 + cc]; const float sk = skip[o * 512 + c];
              const u16* p0 = pT + ((size_t)cc * NB + r) * SEQ + tbase + 4 * h;
              const LAS uchar* z0 = lds + r * HZ_ROW + (tbase + 4 * h) * 2;
              const int tl = tbase + 4 * h;
#pragma unroll
              for (int i = 0; i < 8; ++i) {
                  if ((i & 3) == 0) __builtin_amdgcn_sched_barrier(0);
#pragma unroll
                  for (int q = 0; q < 4; ++q) { const int off = 32 * i + 8 * q;
                      const u32x2 zz = *(const LAS u32x2*)(z0 + off * 2);
                      const u32x2 gv = *(const u32x2*)(p0 + off);
                      const float um = bf2f(p0[off - 1]), up = bf2f(p0[off + 4]);
                      const float gm = (tl + off > 0) ? um : 0.f, gp = (tl + off + 4 < SEQ) ? up : 0.f;
                      const float g0 = bflo(gv.x), g1 = bfhi(gv.x), g2 = bflo(gv.y), g3 = bfhi(gv.y);
                      acc[i][4 * q + 0] = (w0 * gm + w1 * g0 + w2 * g1) * (acc[i][4 * q + 0] + sk * bflo(zz.x));
                      acc[i][4 * q + 1] = (w0 * g0 + w1 * g1 + w2 * g2) * (acc[i][4 * q + 1] + sk * bfhi(zz.x));
                      acc[i][4 * q + 2] = (w0 * g1 + w1 * g2 + w2 * g3) * (acc[i][4 * q + 2] + sk * bflo(zz.y));
                      acc[i][4 * q + 3] = (w0 * g2 + w1 * g3 + w2 * gp) * (acc[i][4 * q + 3] + sk * bfhi(zz.y)); } } }
            __syncthreads();
#pragma unroll
            for (int i = 0; i < 8; ++i)
#pragma unroll
                for (int q = 0; q < 4; ++q) {
                    u32x2 w; w.x = cvt_pk_bf16(acc[i][4 * q + 0], acc[i][4 * q + 1]); w.y = cvt_pk_bf16(acc[i][4 * q + 2], acc[i][4 * q + 3]);
                    *(LAS u32x2*)(lds + r * HZ_ROW + (tbase + 4 * h) * 2 + (32 * i + 8 * q) * 2) = w; }
            if (o == 0) hy_load_kr(lds, G + (size_t)(512 + c) * 4096);
            __syncthreads();
        }
#pragma unroll 8
        for (int idx = tid; idx < NB * 256; idx += NTHR) { const int b = idx >> 8, s0 = (idx & 255) * 8;
            *(u32x4*)(yT + ((size_t)c * NB + b) * SEQ + s0) = *(const LAS u32x4*)(lds + b * HZ_ROW + s0 * 2); }
        __syncthreads();
    }
}

__device__ __forceinline__ u32x4 pack8(const float (&o)[8]) { u32x4 w; w.x = cvt_pk_bf16(o[0], o[1]); w.y = cvt_pk_bf16(o[2], o[3]); w.z = cvt_pk_bf16(o[4], o[5]); w.w = cvt_pk_bf16(o[6], o[7]); return w; }
template <int W> __device__ __forceinline__ void pool_unit(const u16* __restrict__ seq  , int t0, u16* __restrict__ out  ) {
    constexpr int LEFT = W / 2, RIGHT = W - LEFT - 1, NR = 8 + W - 1;
    u32x4 rows[NR];
#pragma unroll
    for (int k = 0; k < NR; ++k) { const int p = t0 - LEFT + k; const int pc = min(max(p, 0), SEQ - 1);
        const u32x4 v = *(const u32x4*)(seq + (size_t)pc * 2048); const bool ok = (p >= 0 && p < SEQ);
        rows[k].x = ok ? v.x : 0u; rows[k].y = ok ? v.y : 0u; rows[k].z = ok ? v.z : 0u; rows[k].w = ok ? v.w : 0u; }
    float sm[8];
#pragma unroll
    for (int c = 0; c < 8; ++c) sm[c] = 0.f;
#pragma unroll
    for (int k = 0; k < W; ++k) { float f[8]; unpack8(rows[k], f);
#pragma unroll
        for (int c = 0; c < 8; ++c) sm[c] += f[c]; }
#pragma unroll
    for (int i = 0; i < 8; ++i) { const int t = t0 + i; const int lo = max(t - LEFT, 0), hi = min(t + RIGHT, SEQ - 1); const float inv = 1.0f / (float)(hi - lo + 1);
        float ctr[8], o[8]; unpack8(rows[i + LEFT], ctr);
#pragma unroll
        for (int c = 0; c < 8; ++c) o[c] = sm[c] * inv - ctr[c];
        *(u32x4*)(out + (size_t)t * 1024) = pack8(o);
        if (i < 7) { float fa[8], fs[8]; unpack8(rows[i + W], fa); unpack8(rows[i], fs);
#pragma unroll
            for (int c = 0; c < 8; ++c) sm[c] += fa[c] - fs[c]; } }
}
__device__ __forceinline__ void dconv_unit(const u16* __restrict__ seq  , int t0, const float* __restrict__ dconv  , u16* __restrict__ out  ) {
    u32x4 cr[10], hr[10], br[8];
#pragma unroll
    for (int k = 0; k < 10; ++k) { const int p = t0 - 1 + k; const int pc = min(max(p, 0), SEQ - 1);
        const u32x4 v = *(const u32x4*)(seq + (size_t)pc * 2048 + 1024); hr[k] = *(const u32x4*)(seq + (size_t)pc * 2048 + 1536); const bool ok = (p >= 0 && p < SEQ);
        cr[k].x = ok ? v.x : 0u; cr[k].y = ok ? v.y : 0u; cr[k].z = ok ? v.z : 0u; cr[k].w = ok ? v.w : 0u; }
#pragma unroll
    for (int i = 0; i < 8; ++i) br[i] = *(const u32x4*)(seq + (size_t)(t0 + i) * 2048 + 512);
    float w0[8], w1[8], w2[8];
    { const float4 a0 = *(const float4*)(dconv), a1 = *(const float4*)(dconv + 4), b0 = *(const float4*)(dconv + 512), b1 = *(const float4*)(dconv + 516), c0 = *(const float4*)(dconv + 1024), c1 = *(const float4*)(dconv + 1028);
      w0[0] = a0.x; w0[1] = a0.y; w0[2] = a0.z; w0[3] = a0.w; w0[4] = a1.x; w0[5] = a1.y; w0[6] = a1.z; w0[7] = a1.w;
      w1[0] = b0.x; w1[1] = b0.y; w1[2] = b0.z; w1[3] = b0.w; w1[4] = b1.x; w1[5] = b1.y; w1[6] = b1.z; w1[7] = b1.w;
      w2[0] = c0.x; w2[1] = c0.y; w2[2] = c0.z; w2[3] = c0.w; w2[4] = c1.x; w2[5] = c1.y; w2[6] = c1.z; w2[7] = c1.w; }
    float pm[8], pc_[8], pn[8];
    { float c[8], h[8]; unpack8(cr[0], c); unpack8(hr[0], h);
#pragma unroll
      for (int k = 0; k < 8; ++k) pm[k] = c[k] * h[k];
      unpack8(cr[1], c); unpack8(hr[1], h);
#pragma unroll
      for (int k = 0; k < 8; ++k) pc_[k] = c[k] * h[k]; }
#pragma unroll
    for (int i = 0; i < 8; ++i) { float c[8], h[8], bb[8], o[8]; unpack8(cr[i + 2], c); unpack8(hr[i + 2], h); unpack8(br[i], bb);
#pragma unroll
        for (int k = 0; k < 8; ++k) { pn[k] = c[k] * h[k]; o[k] = bb[k] * (w0[k] * pm[k] + w1[k] * pc_[k] + w2[k] * pn[k]); pm[k] = pc_[k]; pc_[k] = pn[k]; }
        *(u32x4*)(out + (size_t)(t0 + i) * 1024) = pack8(o); }
}
__device__ void stencil_phase(const u16* __restrict__ proj  , const float* __restrict__ dconv  , u16* __restrict__ ycat  ) {
    const int tid = opaque_tid(), lane = tid & 63, wave = __builtin_amdgcn_readfirstlane(tid >> 6);
    const int chl = (lane & 15) * 8, run = lane >> 4;
    for (int wu = blockIdx.x * 8 + wave; wu < (T_ / 32) * 8; wu += gridDim.x * 8) {
        const int rq = wu >> 3, kind = wu & 7; const int tok0 = rq * 32 + run * 8; const int t0 = tok0 & (SEQ - 1); const size_t s0 = (size_t)(tok0 - t0);
        if (kind < 4) { const int ch0 = kind * 128 + chl; const u16* seq = proj + s0 * 2048 + ch0; u16* out = ycat + s0 * 1024 + ch0;
            if (kind == 0) pool_unit<2>(seq, t0, out); else if (kind == 1) pool_unit<4>(seq, t0, out); else if (kind == 2) pool_unit<8>(seq, t0, out); else pool_unit<16>(seq, t0, out);
        } else { const int ch0 = (kind - 4) * 128 + chl; dconv_unit(proj + s0 * 2048 + ch0, t0, dconv + ch0, ycat + s0 * 1024 + 512 + ch0); }
    }
}


#define XB_TMO      128
#define XB_XCNT(j)  (256  + 64 * (j))
#define XB_XSUB(j)  (1280 + 64 * (j))
#define XB_XGEN(j)  (2304 + 64 * (j))
#define XB_TOP      3328
#define XB_TOPGEN   3392
#define XCD_BAR_WORDS 3456
#define XB_SPIN_CAP (1u << 20)
__device__ __forceinline__ unsigned xb_ld(unsigned* p)              { return __hip_atomic_load(p, __ATOMIC_RELAXED, __HIP_MEMORY_SCOPE_AGENT); }
__device__ __forceinline__ unsigned xb_add(unsigned* p, unsigned v) { return __hip_atomic_fetch_add(p, v, __ATOMIC_RELAXED, __HIP_MEMORY_SCOPE_AGENT); }
__device__ __forceinline__ unsigned xb_xcc_id() { return (unsigned)__builtin_amdgcn_s_getreg((3 << 11) | 20) & 0xFu; }
#define XB_SPIN(cond, bar) do { unsigned _sp = 0; while (cond) { __builtin_amdgcn_s_sleep(1); \
    if ((++_sp & 255u) == 0u) { if (xb_ld(&(bar)[XB_TMO])) break; if (_sp > XB_SPIN_CAP) { atomicAdd(&(bar)[XB_TMO], 1u); break; } } } } while (0)
struct XcdBarrier { unsigned* bar; unsigned x; volatile LAS unsigned* st; };
__device__ __forceinline__ XcdBarrier xcd_barrier_post(unsigned* bar, volatile LAS unsigned* st) {
    XcdBarrier b; b.bar = bar; b.x = xb_xcc_id(); b.st = st;
    if (threadIdx.x == 0) (void)xb_add(&bar[XB_XCNT(b.x)], 1u);
    return b;
}
__device__ __forceinline__ void xcd_barrier_complete(unsigned* bar, unsigned x, unsigned& nloc, unsigned& nx) {
    const unsigned G = gridDim.x * gridDim.y * gridDim.z;
    unsigned sum, cnt, mine, sp = 0u;
    for (;;) {
        sum = 0u; cnt = 0u; mine = 0u;
#pragma unroll
        for (unsigned j = 0; j < 16; ++j) { const unsigned c = xb_ld(&bar[XB_XCNT(j)]); sum += c; cnt += (c > 0u) ? 1u : 0u; mine = (j == x) ? c : mine; }
        if (sum == G) break;
        __builtin_amdgcn_s_sleep(1);
        if ((++sp & 255u) == 0u) { if (xb_ld(&bar[XB_TMO])) break; if (sp > XB_SPIN_CAP) { atomicAdd(&bar[XB_TMO], 1u); break; } }
    }
    nloc = mine > 0u ? mine : 1u; nx = cnt > 0u ? cnt : 1u;
}
__device__ __forceinline__ void xcd_barrier(const XcdBarrier& b) {
    asm volatile("s_waitcnt vmcnt(0)" ::: "memory");
    __syncthreads();
    if (threadIdx.x == 0) {
        unsigned* bar = b.bar;
        __builtin_amdgcn_s_waitcnt(0);
        unsigned nloc = b.st[0], nx = b.st[1];
        if (nloc == 0u) { xcd_barrier_complete(bar, b.x, nloc, nx); b.st[0] = nloc; b.st[1] = nx; }
        const unsigned old = xb_add(&bar[XB_XSUB(b.x)], 1u);
        const unsigned gen = old / nloc;
        if (old + 1u == (gen + 1u) * nloc) {
            __builtin_amdgcn_fence(__ATOMIC_RELEASE, "agent");
            asm volatile("s_waitcnt vmcnt(0)" ::: "memory");
            const unsigned og = xb_add(&bar[XB_TOP], 1u);
            const unsigned tg = og / nx;
            if (og + 1u == (tg + 1u) * nx) xb_add(&bar[XB_TOPGEN], 1u);
            else XB_SPIN(xb_ld(&bar[XB_TOPGEN]) == tg, bar);
            __builtin_amdgcn_fence(__ATOMIC_ACQUIRE, "agent");
            xb_add(&bar[XB_XGEN(b.x)], 1u);
            asm volatile("s_waitcnt vmcnt(0)" ::: "memory");
        } else {
            XB_SPIN(xb_ld(&bar[XB_XGEN(b.x)]) == gen, bar);
            __builtin_amdgcn_fence(__ATOMIC_ACQUIRE, "agent");
            asm volatile("s_waitcnt vmcnt(0)" ::: "memory");
        }
    }
    __syncthreads();
}

constexpr int NPH = 1 + 2 * 8 + 2 * 7;
struct Args { const float* in[23]; float* out; uchar* ws; int lo, hi; };

__global__ void __launch_bounds__(NTHR, 2) fwd_kernel(Args a) {
    extern __shared__ __attribute__((aligned(16))) uchar lds_raw[];
    LAS uchar* lds = (LAS uchar*)lds_raw;
    cg::grid_group grid = cg::this_grid();
    const int lo = a.lo, hi = a.hi; int ph = 0;
    volatile LAS unsigned* xst = (volatile LAS unsigned*)(lds + LDS_ST_OFF);
    if (threadIdx.x == 0) { xst[0] = 0u; xst[1] = 0u; }
    __syncthreads();
    XcdBarrier xb = xcd_barrier_post((unsigned*)(a.ws + WS_BAR), xst);
#define PH_BEGIN if (ph >= lo && ph < hi) {
#define PH_END } if (ph >= lo && ph + 1 < hi) { if (lo < 0) grid.sync();   xcd_barrier(xb); if (DBL(11) == 2) { xcd_barrier(xb); xcd_barrier(xb); } } ++ph;
    uchar* ws = a.ws;
    u16* Wabin = (u16*)(ws + WS_ABIN); u16* Wabout = (u16*)(ws + WS_ABOUT); u16* Wcdin = (u16*)(ws + WS_CDIN); u16* Wcdout = (u16*)(ws + WS_CDOUT);
    u16* Wgu = (u16*)(ws + WS_GU); u16* Wdown = (u16*)(ws + WS_DOWN); u16* Gf = (u16*)(ws + WS_G);
    u16* H = (u16*)(ws + WS_H); u16* PROJ = (u16*)(ws + WS_B); u16* YT = (u16*)(ws + WS_B + (size_t)T_ * 1024 * 2);     u16* ACT = (u16*)(ws + WS_B); u16* PT = (u16*)(ws + WS_C);
    u16* YCAT = (u16*)(ws + WS_D); u16* MIX = (u16*)(ws + WS_E); float* RSTD = (float*)(ws + WS_RSTD);
    const float* x_in = a.in[0]; const float* norm_g = a.in[1]; float* X = a.out;

    PH_BEGIN
      for (int rep = 0; rep < DBL(0); ++rep) {
        int rot = 0;
        filter_job(lds, a.in[10], a.in[11], a.in[12], a.in[13], a.in[14], a.in[15], a.in[16], Gf);
        for (int j = 0; j < 2; ++j) {
            wt_job(lds, a.in[4] + (size_t)j * 1024 * 2560, 2560, 1024, 2560, Wabin + (size_t)j * 2560 * 1024, 1024, 0, norm_g + (size_t)(2 * j) * 4 * 1024, rot);
            wt_job(lds, a.in[5] + (size_t)j * 1024 * 1024, 1024, 1024, 1024, Wabout + (size_t)j * 1024 * 1024, 1024, 0, nullptr, rot);
            wt_job(lds, a.in[18] + (size_t)j * 1024 * 2048, 2048, 1024, 2048, Wcdin + (size_t)j * 2048 * 1024, 1024, 0, norm_g + (size_t)(2 * j + 1) * 4 * 1024, rot);
            wt_job(lds, a.in[19] + (size_t)j * 1024 * 1024 + 512 * 1024, 1024, 512, 1024, Wcdout + (size_t)j * 1024 * 1024 + 512, 1024, 0, nullptr, rot);
            fold_job(a.in[20] + (size_t)j * 4 * 128 * 128, a.in[21] + j * 512, a.in[19] + (size_t)j * 1024 * 1024, Wcdout + (size_t)j * 1024 * 1024);
        }
        for (int i = 0; i < 4; ++i) {
            wt_job(lds, a.in[2] + (size_t)i * 1024 * 5632, 5632, 1024, 5632, Wgu + (size_t)i * 5632 * 1024, 1024, 1, norm_g + (size_t)(i * 4 + 2) * 1024, rot);
            wt_job(lds, a.in[3] + (size_t)i * 2816 * 1024, 1024, 2816, 1024, Wdown + (size_t)i * 1024 * 2816, 2816, 0, nullptr, rot);
        }
      }
        resid_pass(x_in, H, nullptr, nullptr, RSTD, nullptr);
    PH_END

#pragma unroll 1
    for (int i = 0; i < 4; ++i) {
        const int j = i >> 1; const bool even = (i & 1) == 0;
        const float* g4 = norm_g + (size_t)i * 4 * 1024;
        PH_BEGIN
            { const int N = even ? 1024 : 2048;
              pg8::Gemm g{H, even ? Wabin + (size_t)j * 2560 * 1024 : Wcdin + (size_t)j * 2048 * 1024, T_, N, 1024};
              pg8::StaticOrder S; S.init(T_, N, (int)gridDim.x, (int)blockIdx.x);
              pg8::EpiBf16G E{PROJ, N, even ? 4 : 0, RSTD};
#ifndef SKIP_G1
              for (int rep = 0; rep < DBL(6); ++rep) pg8::gemm_phase<pg8::EpiBf16G, pg8::StaticOrder, false>(lds, g, S, E, nullptr);
#endif
            }
            if (even) {
              pg8::Gemm g{H, Wabin + (size_t)j * 2560 * 1024 + (size_t)1024 * 1024, T_, 1536, 1024};
              pg8::StaticOrder S; S.init(T_, 1536, (int)gridDim.x, (int)blockIdx.x);
              pg8::EpiPT E{PT, RSTD};
              pg8::gemm_phase<pg8::EpiPT, pg8::StaticOrder, false>(lds, g, S, E, nullptr);
            }
        PH_END
        if (even) {
            PH_BEGIN
                for (int rep = 0; rep < DBL(1); ++rep) gating_phase(lds, PROJ, a.in[6] + j * 512, a.in[7] + (size_t)j * 4 * 128 * 128, a.in[8] + j * 512, YCAT);
                for (int rep = 0; rep < DBL(3); ++rep) hyena_phase(lds, PT, Gf + (size_t)j * 2 * 512 * 4096, a.in[9] + (size_t)j * 3 * 1536, a.in[17] + j * 1024, YT);
            PH_END
            PH_BEGIN
                for (int rep = 0; rep < DBL(4); ++rep) transpose_back_phase(lds, YT, YCAT);
            PH_END
        } else {
            PH_BEGIN
                for (int rep = 0; rep < DBL(5); ++rep) stencil_phase(PROJ, a.in[22] + (size_t)j * 3 * 512, YCAT);
            PH_END
        }
        PH_BEGIN
            pg8::Gemm g{YCAT, even ? Wabout + (size_t)j * 1024 * 1024 : Wcdout + (size_t)j * 1024 * 1024, T_, 1024, 1024};
            pg8::StaticOrder S; S.init(T_, 1024, (int)gridDim.x, (int)blockIdx.x);
            pg8::EpiBf16G E{MIX, 1024, 0, nullptr};

#ifndef SKIP_G2
            for (int rep = 0; rep < DBL(7); ++rep) pg8::gemm_phase<pg8::EpiBf16G, pg8::StaticOrder, false>(lds, g, S, E, nullptr);
#endif
        PH_END
        PH_BEGIN
            if (DBL(10) == 2) resid_pass(nullptr, (u16*)(ws + WS_C), MIX, g4 + 1024, (float*)(ws + WS_B), nullptr);
            resid_pass(nullptr, H, MIX, g4 + 1024, RSTD, nullptr);
        PH_END
        PH_BEGIN
            pg8::Gemm g{H, Wgu + (size_t)i * 5632 * 1024, T_, 5632, 1024};
            pg8::StaticOrder S; S.init(T_, 5632, (int)gridDim.x, (int)blockIdx.x);
            pg8::EpiSwiGLU E{ACT, DFF, RSTD};

#ifndef SKIP_G3
            for (int rep = 0; rep < DBL(8); ++rep) pg8::gemm_phase<pg8::EpiSwiGLU, pg8::StaticOrder, false>(lds, g, S, E, nullptr);
#endif
        PH_END
        PH_BEGIN
            pg8::Gemm g{ACT, Wdown + (size_t)i * 1024 * 2816, T_, 1024, DFF};
            pg8::StaticOrder S; S.init(T_, 1024, (int)gridDim.x, (int)blockIdx.x);
            pg8::EpiBf16G E{MIX, 1024, 0, nullptr};

#ifndef SKIP_G4
            for (int rep = 0; rep < DBL(9); ++rep) pg8::gemm_phase<pg8::EpiBf16G, pg8::StaticOrder, false>(lds, g, S, E, nullptr);
#endif
        PH_END
        PH_BEGIN
            if (DBL(10) == 2) resid_pass(nullptr, (u16*)(ws + WS_C), MIX, g4 + 3072, (float*)(ws + WS_B), nullptr);
            resid_pass(nullptr, H, MIX, g4 + 3072, RSTD, (i == 3) ? X : nullptr);
        PH_END
    }
#undef PH_BEGIN
#undef PH_END
}

extern "C" void kernel_launch(void* const* d_in, const int* in_sizes, int n_in, void* d_out, int out_size, void* d_ws, size_t ws_size, hipStream_t stream) {
    static int grid = 0;
    if (grid == 0) {
        if (n_in != 23 || out_size != T_ * DM || ws_size < WS_END) { fprintf(stderr, "kernel_launch: unexpected problem (n_in %d out %d ws %zu)\n", n_in, out_size, ws_size); grid = -1; return; }
        int dev = 0, cus = 0, per_cu = 0;
        (void)hipGetDevice(&dev); (void)hipDeviceGetAttribute(&cus, hipDeviceAttributeMultiprocessorCount, dev);
        if (hipFuncSetAttribute((const void*)fwd_kernel, hipFuncAttributeMaxDynamicSharedMemorySize, LDS_BYTES) != hipSuccess) { fprintf(stderr, "kernel_launch: hipFuncSetAttribute failed\n"); grid = -1; return; }
        if (hipOccupancyMaxActiveBlocksPerMultiprocessor(&per_cu, (const void*)fwd_kernel, NTHR, LDS_BYTES) != hipSuccess || per_cu < 1) { fprintf(stderr, "kernel_launch: occupancy query gave %d\n", per_cu); per_cu = 1; }
        (void)hipGetLastError();
        grid = cus * per_cu;
        fprintf(stderr, "kernel_launch: grid %d (cus %d x %d)\n", grid, cus, per_cu);
    }
    if (grid < 0) return;
    Args a{};
    for (int i = 0; i < 23; ++i) a.in[i] = (const float*)d_in[i];
    a.out = (float*)d_out; a.ws = (uchar*)d_ws;
#if ONE_LAUNCH
    (void)hipMemsetAsync((char*)d_ws + WS_BAR, 0, XCD_BAR_WORDS * 4, stream);
    a.lo = 0; a.hi = NPH;
    void* args[] = {&a};
    hipError_t e = hipLaunchCooperativeKernel((const void*)fwd_kernel, dim3(grid), dim3(NTHR), args, LDS_BYTES, stream);
    if (e != hipSuccess) fprintf(stderr, "kernel_launch: cooperative launch failed: %s (grid %d)\n", hipGetErrorString(e), grid);
#else
    for (int p = 0; p < NPH; ++p) { a.lo = p; a.hi = p + 1;
        hipLaunchKernelGGL(fwd_kernel, dim3(grid), dim3(NTHR), LDS_BYTES, stream, a); }
#endif
}
```

```cpp
#include <hip/hip_runtime.h>
#include <hip/hip_cooperative_groups.h>
#include <cstdio>
namespace cg = cooperative_groups;

#ifndef ONE_LAUNCH
#define ONE_LAUNCH 1
#endif
#ifndef DBL_MASK
#define DBL_MASK 0
#endif
#ifndef ALIGN_EPI
#define ALIGN_EPI 1
#endif
#ifndef USE_SP2
#define USE_SP2 1
#endif
#define DBL(bit) (((DBL_MASK >> (bit)) & 1) ? 2 : 1)

__device__ __forceinline__ int opaque_tid() { int t = (int)threadIdx.x; asm volatile("" : "+v"(t)); return t; }
namespace pg8 {
#define PG8_LAS __attribute__((address_space(3)))
typedef unsigned short bf16_t;
typedef short bf16x8 __attribute__((ext_vector_type(8)));
typedef float f32x4 __attribute__((ext_vector_type(4)));
typedef unsigned u32x4 __attribute__((ext_vector_type(4)));
constexpr int RS_LDS_OFF = 132096;
constexpr int EPI_LDS_OFF = 134144, EPI_LDS_WAVE = 2304;
constexpr int BM = 256, BK = 64, HALF = 128, HTB = HALF * BK * 2  , STAGE_BYTES = 8 * HTB, NXCD = 8, WGM = 8;

__host__ __device__ __forceinline__ int lds_byte(int r, int c) { const int st = (r >> 4) * 2 + (c >> 5), rr = r & 15, cc = c & 31, ob = rr * 64 + cc * 2; return st * 1024 + (ob ^ (((ob >> 9) & 1) << 5)); }
__host__ __device__ __forceinline__ void stage_rc(int b, int& R, int& C) { const int st = b / 1024, sb = b % 1024, swz = sb ^ (((sb >> 9) & 1) << 5); R = (st >> 1) * 16 + swz / 64; C = (st & 1) * 32 + (swz % 64) / 2; }
__host__ __device__ __forceinline__ int perm32(int rho) { const int n = rho >> 4, i = rho & 15; return 8 * (i >> 2) + 4 * n + (i & 3); }
struct Unit { int pm, pn; };
struct Gemm { const bf16_t* A; const bf16_t* Bt; int M, N, K; };

struct StaticOrder {
    int nM, nN, nwg, G, c;
    __host__ __device__ void init(int M, int N, int G_, int c_) { nM = M / BM; nN = N / BM; nwg = nM * nN; G = G_; c = c_; }
    __host__ __device__ bool next(int i, Unit& u) const {
        const long L = (long)i * G + c; if (L >= nwg) return false;
        int wgid = (int)L; { const int q = nwg / NXCD, r = nwg % NXCD, xcd = wgid % NXCD, off = wgid / NXCD; wgid = (xcd < r ? xcd * (q + 1) : r * (q + 1) + (xcd - r) * q) + off; }
        const int nig = WGM * nN, gid = wgid / nig, fm = gid * WGM, gsz = (nM - fm) < WGM ? (nM - fm) : WGM;
        u.pm = fm + ((wgid % nig) % gsz); u.pn = (wgid % nig) / gsz; return true;
    }
    __device__ __forceinline__ void a_ready(const Unit&) const {}
    __device__ __forceinline__ void done(const Unit&) const {}
};
__device__ __forceinline__ unsigned cvt_pk_bf16(float lo, float hi) { unsigned r; asm volatile("v_cvt_pk_bf16_f32 %0, %1, %2" : "=v"(r) : "v"(lo), "v"(hi)); return r; }

__device__ __forceinline__ float gelu_tanh_f(float x) { const float y = 1.5957691216f * (x + 0.044715f * x * x * x); return x * __builtin_amdgcn_rcpf(1.0f + __expf(-y)); }
__device__ __forceinline__ float silu_f(float x) { return x * __builtin_amdgcn_rcpf(1.0f + __expf(-x)); }

struct EpiBf16G {
    static constexpr bool PERM = true, AFTER_DRAIN = false, SWAP = false; static constexpr int NSTORES = 16;
    bf16_t* O; int ldc; int gelu_tiles; const float* rs;
    __device__ __forceinline__ void operator()(const f32x4 (&acc)[2][2][4][2], const Unit& u, int wr, int wc, int fr, int fq, const PG8_LAS float* rsl, PG8_LAS unsigned char* eslot) const {
        const int lane = fq * 16 + fr, lr = lane >> 2, lc = (lane & 3) * 8;
        const int rowb = u.pm * BM + wr * 64, colb = u.pn * BM + wc * 32;
        const bool act = u.pn < gelu_tiles;
#pragma unroll
        for (int ai = 0; ai < 2; ++ai)
#pragma unroll
            for (int m = 0; m < 4; ++m) {
                const float sc = rs ? rsl[wr * 64 + fr + ai * HALF + m * 16] : 1.0f;
#pragma unroll
                for (int bj = 0; bj < 2; ++bj) { f32x4 v0 = acc[ai][bj][m][0] * sc, v1 = acc[ai][bj][m][1] * sc;
                    if (act) {
#pragma unroll
                        for (int j = 0; j < 4; ++j) { v0[j] = gelu_tanh_f(v0[j]); v1[j] = gelu_tanh_f(v1[j]); } }
                    u32x4 w; w.x = cvt_pk_bf16(v0[0], v0[1]); w.y = cvt_pk_bf16(v0[2], v0[3]); w.z = cvt_pk_bf16(v1[0], v1[1]); w.w = cvt_pk_bf16(v1[2], v1[3]);
                    PG8_LAS unsigned char* sl = eslot;
                    *(PG8_LAS u32x4*)(sl + fr * 64 + fq * 16) = w;
                    const u32x4 w2 = *(const PG8_LAS u32x4*)(sl + lane * 16);
                    *(u32x4*)(O + (size_t)(rowb + ai * HALF + m * 16 + lr) * ldc + colb + bj * HALF + lc) = w2; } }
    }
};
struct EpiPT {
    static constexpr bool PERM = false, AFTER_DRAIN = false, SWAP = true; static constexpr int NSTORES = 16;
    bf16_t* O; const float* rs;
    __device__ __forceinline__ void operator()(const f32x4 (&acc)[2][2][4][2], const Unit& u, int wr, int wc, int fr, int fq, const PG8_LAS float* rsl, PG8_LAS unsigned char* eslot) const {
        typedef unsigned u32x2_t __attribute__((ext_vector_type(2)));
        const int lane = fq * 16 + fr;
        const int rowb = u.pm * BM + wr * 64; const int b = rowb >> 11, s0 = rowb & 2047;
#pragma unroll
        for (int ai = 0; ai < 2; ++ai)
#pragma unroll
            for (int bj = 0; bj < 2; ++bj)
#pragma unroll
                for (int n = 0; n < 2; ++n) { const int col0 = u.pn * BM + bj * HALF + wc * 32 + n * 16;
#pragma unroll
                    for (int m = 0; m < 4; ++m) { const f32x4 sc = *(const PG8_LAS f32x4*)(rsl + wr * 64 + 4 * fq + ai * HALF + m * 16);
                        const f32x4 v = acc[ai][bj][m][n] * sc;
                        u32x2_t w; w.x = cvt_pk_bf16(v[0], v[1]); w.y = cvt_pk_bf16(v[2], v[3]);
                        *(PG8_LAS u32x2_t*)(eslot + fr * 144 + (16 * m + 4 * fq) * 2) = w; }
#pragma unroll
                    for (int k = 0; k < 2; ++k) { const int c = lane + 64 * k, col = c >> 3, ch = c & 7;
                        const u32x4 w2 = *(const PG8_LAS u32x4*)(eslot + col * 144 + ch * 16);
                        *(u32x4*)(O + ((size_t)(col0 + col) * 32 + b) * 2048 + s0 + ai * HALF + ch * 8) = w2; } }
    }
};
struct EpiSwiGLU {
    static constexpr bool PERM = true, AFTER_DRAIN = false, SWAP = false; static constexpr int NSTORES = 8;
    bf16_t* O; int ldc; const float* rs;
    __device__ __forceinline__ void operator()(const f32x4 (&acc)[2][2][4][2], const Unit& u, int wr, int wc, int fr, int fq, const PG8_LAS float* rsl, PG8_LAS unsigned char* eslot) const {
        const int lane = fq * 16 + fr, lr = lane >> 2, lc = (lane & 3) * 8;
        const int rowb = u.pm * BM + wr * 64, colb = u.pn * HALF + wc * 32;
#pragma unroll
        for (int ai = 0; ai < 2; ++ai)
#pragma unroll
            for (int m = 0; m < 4; ++m) {
                const float sc = rsl[wr * 64 + fr + ai * HALF + m * 16];
                const f32x4 g0 = acc[ai][0][m][0] * sc, g1 = acc[ai][0][m][1] * sc, u0 = acc[ai][1][m][0] * sc, u1 = acc[ai][1][m][1] * sc;
                const f32x4 a0 = g0 * (-1.4426950408889634f), a1 = g1 * (-1.4426950408889634f);
                f32x4 e0, e1;
#pragma unroll
                for (int j = 0; j < 4; ++j) { e0[j] = __builtin_amdgcn_exp2f(a0[j]); e1[j] = __builtin_amdgcn_exp2f(a1[j]); }
                const f32x4 d0 = e0 + 1.0f, d1 = e1 + 1.0f;
                f32x4 r0, r1;
#pragma unroll
                for (int j = 0; j < 4; ++j) { r0[j] = __builtin_amdgcn_rcpf(d0[j]); r1[j] = __builtin_amdgcn_rcpf(d1[j]); }
                const f32x4 v0 = (g0 * u0) * r0, v1 = (g1 * u1) * r1;
                u32x4 w; w.x = cvt_pk_bf16(v0[0], v0[1]); w.y = cvt_pk_bf16(v0[2], v0[3]); w.z = cvt_pk_bf16(v1[0], v1[1]); w.w = cvt_pk_bf16(v1[2], v1[3]);
                PG8_LAS unsigned char* sl = eslot;
                *(PG8_LAS u32x4*)(sl + fr * 64 + fq * 16) = w;
                const u32x4 w2 = *(const PG8_LAS u32x4*)(sl + lane * 16);
                *(u32x4*)(O + (size_t)(rowb + ai * HALF + m * 16 + lr) * ldc + colb + lc) = w2; }
    }
};

template <class Epi, class Sched, bool STAMP = false>
__device__ __forceinline__ void gemm_phase(PG8_LAS unsigned char* lds, const Gemm g, const Sched& S, const Epi& E, unsigned long long* stamps) {
    const int tid = opaque_tid(), wid = __builtin_amdgcn_readfirstlane(tid >> 6), lane = tid & 63, wr = wid >> 2, wc = wid & 3, fr = lane & 15, fq = lane >> 4;
    const int K = g.K, nt = K / BK;
    int ts_lo = 0, ts_hi = 0, nts = 0; const unsigned long long rt_entry = STAMP ? (unsigned long long)wall_clock64() : 0ull;
#define PG8_STAMP() do { if (STAMP && wid == 0 && nts < 64) { const unsigned long long _c = (unsigned long long)clock64(); \
        ts_lo = (lane == nts) ? (int)(unsigned)_c : ts_lo; ts_hi = (lane == nts) ? (int)(unsigned)(_c >> 32) : ts_hi; ++nts; } } while (0)
    PG8_STAMP();
    unsigned voffA[2], voffB[2];
#pragma unroll
    for (int i = 0; i < 2; ++i) { int R, C; stage_rc(tid * 16 + i * 8192, R, C); const int Rb = Epi::PERM ? ((R & ~31) + perm32(R & 31)) : R;
        voffA[i] = (unsigned)(R * K + C) * 2u; voffB[i] = (unsigned)(Rb * K + C) * 2u; }
    const size_t kstep = (size_t)(BK * 2);
    const size_t hstep = (size_t)HALF * K * 2;
    const size_t tstep = 2 * hstep;
    const unsigned ldsw = (unsigned)wid * 1024u;
    const int aoff = lds_byte(wr * 64 + fr, fq * 8), boff = lds_byte(wc * 32 + fr, fq * 8);
#define PG8_SA(b, h) (((b) * 2 + (h)) * HTB)
#define PG8_SB(b, h) ((4 + (b) * 2 + (h)) * HTB)
#define PG8_STAGE(bufoff, gbase, voff) do { _Pragma("unroll") for (int _i = 0; _i < 2; ++_i) \
        __builtin_amdgcn_global_load_lds((const unsigned*)((const char*)(gbase) + (voff)[_i]), (PG8_LAS unsigned*)(lds + (bufoff) + ldsw + _i * 8192), 16, 0, 0); } while (0)
#define PG8_LDA(dst, b, h) do { _Pragma("unroll") for (int m = 0; m < 4; ++m) _Pragma("unroll") for (int k = 0; k < 2; ++k) dst[m][k] = *(const PG8_LAS bf16x8*)(lds + PG8_SA(b, h) + aoff + m * 2048 + k * 1024); } while (0)
#define PG8_LDB(dst, b, h) do { _Pragma("unroll") for (int n = 0; n < 2; ++n) _Pragma("unroll") for (int k = 0; k < 2; ++k) dst[n][k] = *(const PG8_LAS bf16x8*)(lds + PG8_SB(b, h) + boff + n * 2048 + k * 1024); } while (0)
#define PG8_MMA(ai, bj, At, Bt) do { __builtin_amdgcn_s_setprio(1); _Pragma("unroll") for (int m = 0; m < 4; ++m) _Pragma("unroll") for (int n = 0; n < 2; ++n) _Pragma("unroll") for (int k = 0; k < 2; ++k) \
        acc[ai][bj][m][n] = Epi::SWAP ? __builtin_amdgcn_mfma_f32_16x16x32_bf16(At[m][k], Bt[n][k], acc[ai][bj][m][n], 0, 0, 0) : __builtin_amdgcn_mfma_f32_16x16x32_bf16(Bt[n][k], At[m][k], acc[ai][bj][m][n], 0, 0, 0); __builtin_amdgcn_s_setprio(0); } while (0)
#define PG8_WAIT_V(n) asm volatile("s_waitcnt vmcnt(" #n ")" ::: "memory")
#define PG8_WAIT_L(n) asm volatile("s_waitcnt lgkmcnt(" #n ")" ::: "memory")
#define PG8_BAR __builtin_amdgcn_s_barrier()
#define PG8_SCHED __builtin_amdgcn_sched_barrier(0)
#define PG8_STAGE_RS(unit, buf) do { if (E.rs != nullptr && wid < 4) __builtin_amdgcn_global_load_lds((const unsigned*)(E.rs + (unit).pm * BM + wid * 64 + lane), (PG8_LAS unsigned*)(lds + RS_LDS_OFF + (buf) * 1024 + wid * 256), 4, 0, 0); } while (0)
    Unit cur, nxt; int ui = 0;
    if (!S.next(0, cur)) return;
    f32x4 acc[2][2][4][2];
#pragma unroll
    for (int a = 0; a < 2; ++a)
#pragma unroll
        for (int b = 0; b < 2; ++b)
#pragma unroll
            for (int m = 0; m < 4; ++m)
#pragma unroll
                for (int n = 0; n < 2; ++n) acc[a][b][m][n] = (f32x4){0.f, 0.f, 0.f, 0.f};
    bf16x8 At[4][2], B0[2][2], B1[2][2];
    const char* cA = (const char*)g.A + (size_t)cur.pm * tstep; const char* cB = (const char*)g.Bt + (size_t)cur.pn * tstep;
    S.a_ready(cur);
    PG8_STAGE_RS(cur, 0);
#if USE_SP2
    PG8_STAGE(PG8_SB(0, 0), cB, voffB); PG8_STAGE(PG8_SB(0, 1), cB + hstep, voffB); PG8_STAGE(PG8_SA(0, 0), cA, voffA); PG8_STAGE(PG8_SA(0, 1), cA + hstep, voffA);
    if (wr == 1) PG8_BAR;
    PG8_WAIT_V(2); PG8_BAR;
    PG8_STAGE(PG8_SB(1, 0), cB + kstep, voffB); PG8_STAGE(PG8_SA(1, 0), cA + kstep, voffA); PG8_STAGE(PG8_SB(1, 1), cB + hstep + kstep, voffB); PG8_STAGE(PG8_SA(1, 1), cA + hstep + kstep, voffA);
    PG8_WAIT_V(8); PG8_BAR;
#else
    PG8_STAGE(PG8_SB(0, 0), cB, voffB); PG8_STAGE(PG8_SA(0, 0), cA, voffA); PG8_STAGE(PG8_SB(0, 1), cB + hstep, voffB); PG8_STAGE(PG8_SA(0, 1), cA + hstep, voffA);
    if (wr == 1) PG8_BAR;
    PG8_WAIT_V(4); PG8_BAR;
    PG8_STAGE(PG8_SB(1, 0), cB + kstep, voffB); PG8_STAGE(PG8_SA(1, 0), cA + kstep, voffA); PG8_STAGE(PG8_SB(1, 1), cB + hstep + kstep, voffB); PG8_STAGE(PG8_SA(1, 1), cA + hstep + kstep, voffA);
    PG8_WAIT_V(8); PG8_BAR;
#endif
    PG8_STAMP();
    for (;;) {
        const bool has_next = S.next(ui + 1, nxt);
        const char* nA = has_next ? (const char*)g.A + (size_t)nxt.pm * tstep : cA; const char* nB = has_next ? (const char*)g.Bt + (size_t)nxt.pn * tstep : cB;
        for (int t = 0; t < nt; t += 2) {
            const bool last = (t == nt - 2);
            const char* a2 = last ? nA : cA + (size_t)(t + 2) * kstep; const char* b2 = last ? nB : cB + (size_t)(t + 2) * kstep;
            const char* a3 = a2 + kstep; const char* b3 = b2 + kstep;
            if (last && has_next) { S.a_ready(nxt); PG8_STAGE_RS(nxt, (ui + 1) & 1); }
#if USE_SP2
            const int relaxed = __builtin_amdgcn_readfirstlane((t == 0 && ui > 0) ? 1 : 0);
#define PG8_WAIT_V8R asm volatile("s_cmp_lg_u32 %0, 0\n\ts_cbranch_scc1 .Lpg8rlx%=\n\ts_waitcnt vmcnt(8)\n\ts_branch .Lpg8end%=\n.Lpg8rlx%=:\n\ts_waitcnt vmcnt(%1)\n.Lpg8end%=:" :: "s"(relaxed), "n"(8 + Epi::NSTORES) : "memory", "scc")
            PG8_LDB(B0, 0, 0); PG8_LDB(B1, 0, 1); PG8_SCHED; PG8_LDA(At, 0, 0);
            PG8_WAIT_V8R; PG8_WAIT_L(0); PG8_BAR; PG8_MMA(0, 0, At, B0); PG8_MMA(0, 1, At, B1); PG8_BAR; PG8_SCHED;
            PG8_LDA(At, 0, 1); PG8_STAGE(PG8_SB(0, 0), b2, voffB); PG8_STAGE(PG8_SB(0, 1), b2 + hstep, voffB); PG8_STAGE(PG8_SA(0, 0), a2, voffA);
            PG8_WAIT_V8R; PG8_WAIT_L(0); PG8_BAR; PG8_MMA(1, 0, At, B0); PG8_MMA(1, 1, At, B1); PG8_BAR; PG8_SCHED;
            PG8_LDB(B0, 1, 0); PG8_LDB(B1, 1, 1); PG8_SCHED; PG8_LDA(At, 1, 0); PG8_STAGE(PG8_SA(0, 1), a2 + hstep, voffA);
            PG8_WAIT_V8R; PG8_WAIT_L(0); PG8_BAR; PG8_MMA(0, 0, At, B0); PG8_MMA(0, 1, At, B1); PG8_BAR; PG8_SCHED;
            PG8_LDA(At, 1, 1); PG8_STAGE(PG8_SB(1, 0), b3, voffB); PG8_STAGE(PG8_SB(1, 1), b3 + hstep, voffB); PG8_STAGE(PG8_SA(1, 0), a3, voffA);
            PG8_WAIT_V(8); PG8_WAIT_L(0); PG8_BAR; PG8_MMA(1, 0, At, B0); PG8_MMA(1, 1, At, B1); PG8_BAR; PG8_SCHED;
            PG8_STAGE(PG8_SA(1, 1), a3 + hstep, voffA);
#undef PG8_WAIT_V8R
#else
            PG8_LDB(B0, 0, 0); PG8_SCHED; PG8_LDA(At, 0, 0);
            PG8_WAIT_L(8); PG8_BAR; PG8_WAIT_L(0); PG8_MMA(0, 0, At, B0); PG8_BAR; PG8_SCHED;
            PG8_LDB(B1, 0, 1); PG8_STAGE(PG8_SB(0, 0), b2, voffB);
            PG8_BAR; PG8_WAIT_L(0); PG8_MMA(0, 1, At, B1); PG8_BAR;
            PG8_LDA(At, 0, 1); PG8_STAGE(PG8_SA(0, 0), a2, voffA);
            PG8_BAR; PG8_WAIT_L(0); PG8_MMA(1, 0, At, B0); PG8_BAR; PG8_SCHED;
            PG8_STAGE(PG8_SB(0, 1), b2 + hstep, voffB);
            { const int relaxed = __builtin_amdgcn_readfirstlane((t == 0 && ui > 0) ? 1 : 0);
              asm volatile("s_cmp_lg_u32 %0, 0\n\ts_cbranch_scc1 .Lpg8rlx%=\n\ts_waitcnt vmcnt(6)\n\ts_branch .Lpg8end%=\n.Lpg8rlx%=:\n\ts_waitcnt vmcnt(%1)\n.Lpg8end%=:" :: "s"(relaxed), "n"(6 + Epi::NSTORES) : "memory", "scc"); }
            PG8_BAR; PG8_MMA(1, 1, At, B1); PG8_BAR;
            PG8_LDB(B0, 1, 0); PG8_SCHED; PG8_LDA(At, 1, 0); PG8_STAGE(PG8_SA(0, 1), a2 + hstep, voffA);
            PG8_WAIT_L(8); PG8_BAR; PG8_WAIT_L(0); PG8_MMA(0, 0, At, B0); PG8_BAR; PG8_SCHED;
            PG8_LDB(B1, 1, 1); PG8_STAGE(PG8_SB(1, 0), b3, voffB);
            PG8_BAR; PG8_WAIT_L(0); PG8_MMA(0, 1, At, B1); PG8_BAR;
            PG8_LDA(At, 1, 1); PG8_STAGE(PG8_SA(1, 0), a3, voffA);
            PG8_BAR; PG8_WAIT_L(0); PG8_MMA(1, 0, At, B0); PG8_BAR; PG8_SCHED;
            PG8_STAGE(PG8_SB(1, 1), b3 + hstep, voffB);
            PG8_WAIT_V(6); PG8_BAR; PG8_MMA(1, 1, At, B1); PG8_BAR;
            PG8_STAGE(PG8_SA(1, 1), a3 + hstep, voffA);
#endif
        }
        PG8_STAMP();
#if ALIGN_EPI
        if (wr == 0) PG8_BAR;
#endif
        if constexpr (!Epi::AFTER_DRAIN) { E(acc, cur, wr, wc, fr, fq, (const PG8_LAS float*)(lds + RS_LDS_OFF + (ui & 1) * 1024), lds + EPI_LDS_OFF + wid * EPI_LDS_WAVE); S.done(cur); }
        PG8_STAMP();
        if (!has_next) break;
#pragma unroll
        for (int a = 0; a < 2; ++a)
#pragma unroll
            for (int b = 0; b < 2; ++b)
#pragma unroll
                for (int m = 0; m < 4; ++m)
#pragma unroll
                    for (int n = 0; n < 2; ++n) acc[a][b][m][n] = (f32x4){0.f, 0.f, 0.f, 0.f};
        cur = nxt; cA = nA; cB = nB; ++ui;
#if ALIGN_EPI
        if (wr == 1) PG8_BAR;
#endif
    }
    PG8_WAIT_V(0);
#if !ALIGN_EPI
    if (wr == 0) PG8_BAR;
#endif
    PG8_BAR;
    if constexpr (Epi::AFTER_DRAIN) { E.fused(acc, cur, wr, wc, fr, fq, lds, wid, lane); S.done(cur); }
    PG8_STAMP();
    if (STAMP && wid == 0) { stamps[lane] = lane < nts ? (((unsigned long long)(unsigned)ts_hi << 32) | (unsigned)ts_lo) : 0ull;
        if (lane == 62) stamps[62] = rt_entry; if (lane == 63) stamps[63] = (unsigned long long)wall_clock64(); }
#undef PG8_STAMP
#undef PG8_SA
#undef PG8_SB
#undef PG8_STAGE
#undef PG8_LDA
#undef PG8_LDB
#undef PG8_MMA
#undef PG8_WAIT_V
#undef PG8_WAIT_L
#undef PG8_BAR
#undef PG8_SCHED
#undef PG8_STAGE_RS
}
}

#define LAS PG8_LAS
typedef unsigned short u16;
typedef unsigned char uchar;
using pg8::bf16x8; using pg8::f32x4; using pg8::u32x4; using pg8::cvt_pk_bf16;
typedef float f32x16 __attribute__((ext_vector_type(16)));
typedef unsigned u32x2 __attribute__((ext_vector_type(2)));
typedef int i32x4 __attribute__((ext_vector_type(4)));

constexpr int T_ = 65536, DM = 1024, SEQ = 2048, NB = 32, DFF = 2816, NTHR = 512;
constexpr int LDS_ST_OFF = 155648;
constexpr int LDS_BYTES = LDS_ST_OFF + 16;
constexpr size_t SZ_ABIN = 2ull * 2560 * 1024 * 2, SZ_ABOUT = 2ull * 1024 * 1024 * 2, SZ_CDIN = 2ull * 2048 * 1024 * 2, SZ_CDOUT = 2ull * 1024 * 1024 * 2,
                 SZ_GU = 4ull * 5632 * 1024 * 2, SZ_DOWN = 4ull * 1024 * 2816 * 2, SZ_G = 2ull * 2 * 512 * 4096 * 2;
constexpr size_t WS_ABIN = 0, WS_ABOUT = WS_ABIN + SZ_ABIN, WS_CDIN = WS_ABOUT + SZ_ABOUT, WS_CDOUT = WS_CDIN + SZ_CDIN, WS_GU = WS_CDOUT + SZ_CDOUT, WS_DOWN = WS_GU + SZ_GU,
                 WS_G = WS_DOWN + SZ_DOWN,
                 WS_H = WS_G + SZ_G,
                 WS_B = WS_H + (size_t)T_ * 1024 * 2,
                 WS_C = WS_B + (size_t)T_ * 2560 * 2,
                 WS_D = WS_C + (size_t)1536 * 32 * 2048 * 2,
                 WS_E = WS_D + (size_t)T_ * 1024 * 2,
                 WS_BAR = WS_E + (size_t)T_ * 1024 * 2,
                 WS_RSTD = WS_BAR + 16384,
                 WS_END = WS_RSTD + (size_t)T_ * 4;
static_assert(WS_END <= (1ull << 30), "workspace map exceeds 1 GiB");
static_assert((size_t)T_ * DFF * 2 <= WS_D - WS_B, "act does not fit B + C");

__device__ __forceinline__ float bflo(unsigned w) { return __uint_as_float(w << 16); }
__device__ __forceinline__ float bfhi(unsigned w) { return __uint_as_float(w & 0xffff0000u); }
__device__ __forceinline__ float bf2f(u16 v) { return __uint_as_float(((unsigned)v) << 16); }
__device__ __forceinline__ u16 f2bf(float f) { return (u16)(cvt_pk_bf16(f, 0.f) & 0xffffu); }
__device__ __forceinline__ float wave_sum(float v) {
#pragma unroll
    for (int o = 32; o >= 1; o >>= 1) v += __shfl_xor(v, o, 64);
    return v;
}

__device__ void wt_job(LAS uchar* lds, const float* __restrict__ W, int ldw, int K, int N, u16* __restrict__ out, int ldo, int mode, const float* __restrict__ gain, int& rot) {
    LAS float* tile = (LAS float*)lds;
    const int tid = opaque_tid(); const int nkq = K / 256, nnt = N / 64, nsteps = nkq * nnt;
    const int G = (int)gridDim.x; const int first = ((int)blockIdx.x + G - (rot % G)) % G; rot += nsteps;
    for (int ti = first; ti < nsteps; ti += G) {
        const int kq = ti % nkq, nt = ti / nkq; const int k0 = kq * 256, n0 = nt * 64;
        int sc0 = n0; if (mode == 1) { const int pn = n0 >> 8, r = n0 & 255; sc0 = (r < 128) ? (pn * 128 + r) : (DFF + pn * 128 + (r - 128)); }
        float4 v[8];
#pragma unroll
        for (int i = 0; i < 8; ++i) { const int idx = tid + i * 512; const int kk = idx >> 4, c4 = (idx & 15) * 4;
            v[i] = *(const float4*)(W + (size_t)(k0 + kk) * ldw + sc0 + c4); }
#pragma unroll
        for (int i = 0; i < 8; ++i) { const int idx = tid + i * 512; const int kk = idx >> 4, c4 = (idx & 15) * 4;
            const float gk = gain ? gain[k0 + kk] : 1.0f;
            tile[kk * 65 + c4 + 0] = v[i].x * gk; tile[kk * 65 + c4 + 1] = v[i].y * gk; tile[kk * 65 + c4 + 2] = v[i].z * gk; tile[kk * 65 + c4 + 3] = v[i].w * gk; }
        __syncthreads();
#pragma unroll
        for (int q = 0; q < 4; ++q) { const int nn = tid >> 3, kc = q * 64 + (tid & 7) * 8;
          float f0 = tile[(kc + 0) * 65 + nn], f1 = tile[(kc + 1) * 65 + nn], f2 = tile[(kc + 2) * 65 + nn], f3 = tile[(kc + 3) * 65 + nn];
          float f4 = tile[(kc + 4) * 65 + nn], f5 = tile[(kc + 5) * 65 + nn], f6 = tile[(kc + 6) * 65 + nn], f7 = tile[(kc + 7) * 65 + nn];
          u32x4 w; w.x = cvt_pk_bf16(f0, f1); w.y = cvt_pk_bf16(f2, f3); w.z = cvt_pk_bf16(f4, f5); w.w = cvt_pk_bf16(f6, f7);
          *(u32x4*)(out + (size_t)(n0 + nn) * ldo + k0 + kc) = w; }
        __syncthreads();
    }
}
__device__ void fold_job(const float* __restrict__ cw, const float* __restrict__ scale, const float* __restrict__ Wout, u16* __restrict__ out) {
    for (int idx = blockIdx.x * NTHR + opaque_tid(); idx < 512 * 128; idx += gridDim.x * NTHR) {
        const int k = idx >> 7, n0 = (idx & 127) * 8; const int g = k >> 7;
        const float* cwr = cw + (size_t)k * 128; const float* sc = scale + g * 128; const float* wr = Wout + (size_t)(g * 128) * 1024 + n0;
        float acc[8];
#pragma unroll
        for (int u = 0; u < 8; ++u) acc[u] = 0.f;
#pragma unroll 8
        for (int c2 = 0; c2 < 128; ++c2) { const float cf = cwr[c2] * sc[c2]; const float4 w0 = *(const float4*)(wr + (size_t)c2 * 1024), w1 = *(const float4*)(wr + (size_t)c2 * 1024 + 4);
            acc[0] += cf * w0.x; acc[1] += cf * w0.y; acc[2] += cf * w0.z; acc[3] += cf * w0.w; acc[4] += cf * w1.x; acc[5] += cf * w1.y; acc[6] += cf * w1.z; acc[7] += cf * w1.w; }
#pragma unroll
        for (int u = 0; u < 8; ++u) out[(size_t)(n0 + u) * 1024 + k] = f2bf(acc[u]);
    }
}
__device__ __forceinline__ void filter_job(LAS uchar* lds, const float* __restrict__ w1a, const float* __restrict__ b1a, const float* __restrict__ freqa, const float* __restrict__ w2a,
                           const float* __restrict__ b2a, const float* __restrict__ w3a, const float* __restrict__ decaya, u16* __restrict__ Gall) {
    LAS float* h2 = (LAS float*)lds;
    LAS float* zf = h2 + 64 * 64;
    LAS float* h1 = zf + 64 * 33;
    LAS float* w3s = h2 + 64 * 64;
    const int tid = opaque_tid(), lane = tid & 63, wave = __builtin_amdgcn_readfirstlane(tid >> 6);
    for (int item = blockIdx.x; item < 256; item += gridDim.x) {
        const int j = item >> 7, tg = (item >> 2) & 31, cq = item & 3, t0 = tg * 64;
        const float* w1 = w1a + j * 33 * 64; const float* b1 = b1a + j * 64; const float* freq = freqa + j * 128; const float* w2 = w2a + j * 4096; const float* b2 = b2a + j * 64;
        const float* w3 = w3a + (size_t)j * 64 * 2048; const float* decay = decaya + j * 2048; u16* Gj = Gall + (size_t)j * 2 * 512 * 4096;
        float4 wpre[16];
#pragma unroll
        for (int i = 0; i < 16; ++i) { const int idx = tid + i * NTHR; wpre[i] = *(const float4*)(w3 + (size_t)(idx >> 7) * 2048 + cq * 512 + (idx & 127) * 4); }
        for (int idx = tid; idx < 64 * 33; idx += NTHR) { const int tt = idx / 33, f = idx - tt * 33; const float t = (float)(t0 + tt);
            float val;
            if (f == 0) val = t / 2047.0f;
            else { const int fi = (f - 1) & 15; const float band = 1e-4f + (float)fi * ((15.0f - 1e-4f) / 15.0f); const float w = 6.283185307179586f * t / 2048.0f; const float fw = w * band;
                   val = (f <= 16) ? cosf(fw) : -sinf(fw); }
            zf[idx] = val; }
        __syncthreads();
        for (int idx = tid; idx < 4096; idx += NTHR) { const int tt = idx >> 6, k = idx & 63; float acc = 0.f;
            for (int f = 0; f < 33; ++f) acc += zf[tt * 33 + f] * w1[f * 64 + k];
            h1[tt * 64 + k] = sinf(freq[k] * (acc + b1[k])); }
        __syncthreads();
        for (int idx = tid; idx < 4096; idx += NTHR) { const int tt = idx >> 6, k = idx & 63; float acc = 0.f;
            for (int k2 = 0; k2 < 64; ++k2) acc += h1[tt * 64 + k2] * w2[k2 * 64 + k];
            h2[k * 64 + tt] = sinf(freq[64 + k] * (acc + b2[k])); }
        __syncthreads();
#pragma unroll
        for (int i = 0; i < 16; ++i) { const int idx = tid + i * NTHR; f32x4 wv; wv.x = wpre[i].x; wv.y = wpre[i].y; wv.z = wpre[i].z; wv.w = wpre[i].w; *(LAS f32x4*)(w3s + (idx >> 7) * 512 + (idx & 127) * 4) = wv; }
        __syncthreads();
        { const int t = t0 + lane; const float t01 = (float)t / 2047.0f;
          for (int ci = 0; ci < 64; ci += 4) { const int cl = wave * 64 + ci, col = cq * 512 + cl; float a0 = 0.f, a1 = 0.f, a2 = 0.f, a3 = 0.f;
#pragma unroll 16
              for (int k = 0; k < 64; ++k) { const f32x4 w = *(const LAS f32x4*)(w3s + k * 512 + cl); const float hv = h2[k * 64 + lane]; a0 += hv * w.x; a1 += hv * w.y; a2 += hv * w.z; a3 += hv * w.w; }
              const float4 dc = *(const float4*)(decay + col);
              a0 *= expf(-t01 * fabsf(dc.x)); a1 *= expf(-t01 * fabsf(dc.y)); a2 *= expf(-t01 * fabsf(dc.z)); a3 *= expf(-t01 * fabsf(dc.w));
              const int dir = col >> 10, o = (col >> 9) & 1, c = col & 511; u16* g = Gj + (size_t)(o * 512 + c) * 4096;
              if (dir == 0) { g[2048 - t] = f2bf(a0); g[4096 + 2048 - t] = f2bf(a1); g[8192 + 2048 - t] = f2bf(a2); g[12288 + 2048 - t] = f2bf(a3);
                              if (t == 0) { g[0] = 0; g[4096] = 0; g[8192] = 0; g[12288] = 0; } }
              else if (t <= 2046) { g[2049 + t] = f2bf(a0); g[4096 + 2049 + t] = f2bf(a1); g[8192 + 2049 + t] = f2bf(a2); g[12288 + 2049 + t] = f2bf(a3); } } }
        __syncthreads();
    }
}

__device__ __forceinline__ void unpack8(const u32x4 v, float (&f)[8]) { f[0] = bflo(v.x); f[1] = bfhi(v.x); f[2] = bflo(v.y); f[3] = bfhi(v.y); f[4] = bflo(v.z); f[5] = bfhi(v.z); f[6] = bflo(v.w); f[7] = bfhi(v.w); }
__device__ __forceinline__ float4 ntload4(const float* p) { const f32x4 v = __builtin_nontemporal_load((const f32x4*)p); float4 r; r.x = v.x; r.y = v.y; r.z = v.z; r.w = v.w; return r; }
__device__ __forceinline__ void ntstore4(float* p, float a, float b, float c, float d) { f32x4 w; w.x = a; w.y = b; w.z = c; w.w = d; __builtin_nontemporal_store(w, (f32x4*)p); }
__device__ __forceinline__ void resid_pass(const float* __restrict__ xin_f, u16* __restrict__ xb, const u16* __restrict__ mix, const float* __restrict__ gpost, float* __restrict__ rstd_out, float* __restrict__ out_f) {
    const int tid = opaque_tid(); const int lane = tid & 63, wave = tid >> 6;
    const int stride = gridDim.x * 8;
    constexpr int NR = 4;
    for (int row0 = blockIdx.x * 8 + wave; row0 < T_; row0 += NR * stride) {
        float x[NR][16];
        if (xin_f) {
#pragma unroll
            for (int k = 0; k < NR; ++k) { const int row = min(row0 + k * stride, T_ - 1);
#pragma unroll
                for (int c = 0; c < 2; ++c) { const float4 a0 = ntload4(xin_f + (size_t)row * 1024 + c * 512 + lane * 8), a1 = ntload4(xin_f + (size_t)row * 1024 + c * 512 + lane * 8 + 4);
                    x[k][c * 8 + 0] = a0.x; x[k][c * 8 + 1] = a0.y; x[k][c * 8 + 2] = a0.z; x[k][c * 8 + 3] = a0.w; x[k][c * 8 + 4] = a1.x; x[k][c * 8 + 5] = a1.y; x[k][c * 8 + 6] = a1.z; x[k][c * 8 + 7] = a1.w; } }
        } else {
            u32x4 xr[NR][2], mr[NR][2];
#pragma unroll
            for (int k = 0; k < NR; ++k) { const int row = min(row0 + k * stride, T_ - 1);
#pragma unroll
                for (int c = 0; c < 2; ++c) { xr[k][c] = *(const u32x4*)(xb + (size_t)row * 1024 + c * 512 + lane * 8); mr[k][c] = __builtin_nontemporal_load((const u32x4*)(mix + (size_t)row * 1024 + c * 512 + lane * 8)); } }
            float g[16];
#pragma unroll
            for (int c = 0; c < 2; ++c) { const float4 a0 = *(const float4*)(gpost + c * 512 + lane * 8), a1 = *(const float4*)(gpost + c * 512 + lane * 8 + 4);
                g[c * 8 + 0] = a0.x; g[c * 8 + 1] = a0.y; g[c * 8 + 2] = a0.z; g[c * 8 + 3] = a0.w; g[c * 8 + 4] = a1.x; g[c * 8 + 5] = a1.y; g[c * 8 + 6] = a1.z; g[c * 8 + 7] = a1.w; }
#pragma unroll
            for (int k = 0; k < NR; ++k) { float m[16]; float ss = 0.f;
#pragma unroll
                for (int c = 0; c < 2; ++c) { float t8[8]; unpack8(mr[k][c], t8);
#pragma unroll
                    for (int e = 0; e < 8; ++e) { m[c * 8 + e] = t8[e]; ss += t8[e] * t8[e]; } }
                ss = wave_sum(ss); const float rstd = rsqrtf(ss * (1.0f / 1024.0f) + 1e-6f);
#pragma unroll
                for (int c = 0; c < 2; ++c) { float t8[8]; unpack8(xr[k][c], t8);
#pragma unroll
                    for (int e = 0; e < 8; ++e) x[k][c * 8 + e] = t8[e] + m[c * 8 + e] * rstd * g[c * 8 + e]; } }
        }
#pragma unroll
        for (int k = 0; k < NR; ++k) { const int row = row0 + k * stride;
            if (row < T_) {
                if (out_f) {
#pragma unroll
                    for (int c = 0; c < 2; ++c) { ntstore4(out_f + (size_t)row * 1024 + c * 512 + lane * 8, x[k][c * 8 + 0], x[k][c * 8 + 1], x[k][c * 8 + 2], x[k][c * 8 + 3]);
                        ntstore4(out_f + (size_t)row * 1024 + c * 512 + lane * 8 + 4, x[k][c * 8 + 4], x[k][c * 8 + 5], x[k][c * 8 + 6], x[k][c * 8 + 7]); }
                } else {
                    float ss = 0.f;
#pragma unroll
                    for (int e = 0; e < 16; ++e) ss += x[k][e] * x[k][e];
                    ss = wave_sum(ss);
                    if (lane == 0) rstd_out[row] = rsqrtf(ss * (1.0f / 1024.0f) + 1e-6f);
#pragma unroll
                    for (int c = 0; c < 2; ++c) { u32x4 w; w.x = cvt_pk_bf16(x[k][c * 8 + 0], x[k][c * 8 + 1]); w.y = cvt_pk_bf16(x[k][c * 8 + 2], x[k][c * 8 + 3]); w.z = cvt_pk_bf16(x[k][c * 8 + 4], x[k][c * 8 + 5]); w.w = cvt_pk_bf16(x[k][c * 8 + 6], x[k][c * 8 + 7]);
                        *(u32x4*)(xb + (size_t)row * 1024 + c * 512 + lane * 8) = w; }
                }
            }
        }
    }
}

constexpr int TRS = 66;
__device__ __forceinline__ void tr_tile8(LAS u16* tiles  , const u16* __restrict__ src, size_t lds_src, size_t src_ts, u16* __restrict__ dst, size_t ldd, size_t dst_ts) {
    const int tid = opaque_tid(), r = tid >> 3, ch = (tid & 7) * 8;
    u32x4 v[8];
#pragma unroll
    for (int k = 0; k < 8; ++k) v[k] = *(const u32x4*)(src + k * src_ts + (size_t)r * lds_src + ch);
#pragma unroll
    for (int k = 0; k < 8; ++k) { LAS u16* tile = tiles + k * 64 * TRS;
        tile[(ch + 0) * TRS + r] = (u16)(v[k].x & 0xffffu); tile[(ch + 1) * TRS + r] = (u16)(v[k].x >> 16);
        tile[(ch + 2) * TRS + r] = (u16)(v[k].y & 0xffffu); tile[(ch + 3) * TRS + r] = (u16)(v[k].y >> 16);
        tile[(ch + 4) * TRS + r] = (u16)(v[k].z & 0xffffu); tile[(ch + 5) * TRS + r] = (u16)(v[k].z >> 16);
        tile[(ch + 6) * TRS + r] = (u16)(v[k].w & 0xffffu); tile[(ch + 7) * TRS + r] = (u16)(v[k].w >> 16); }
    __syncthreads();
#pragma unroll
    for (int k = 0; k < 8; ++k) { const LAS unsigned* p = (const LAS unsigned*)(tiles + k * 64 * TRS + r * TRS + ch);
        u32x4 o; o.x = p[0]; o.y = p[1]; o.z = p[2]; o.w = p[3];
        *(u32x4*)(dst + k * dst_ts + (size_t)r * ldd + ch) = o; }
    __syncthreads();
}
__device__ void transpose_fwd_phase(LAS uchar* lds, const u16* __restrict__ proj, u16* __restrict__ pT) {
    LAS u16* tiles = (LAS u16*)lds;
    for (int it = blockIdx.x; it < NB * 32 * 3; it += gridDim.x) {
        const int c8 = it % 3, st = (it / 3) & 31, b = it / 96;
        tr_tile8(tiles, proj + (size_t)(b * SEQ + st * 64) * 2560 + 1024 + c8 * 512, 2560, 64, pT + ((size_t)(c8 * 512) * NB + b) * SEQ + st * 64, (size_t)NB * SEQ, (size_t)64 * NB * SEQ);
    }
}
__device__ void transpose_back_phase(LAS uchar* lds, const u16* __restrict__ yT, u16* __restrict__ ycat) {
    LAS u16* tiles = (LAS u16*)lds;
    for (int it = blockIdx.x; it < NB * 32; it += gridDim.x) {
        const int st = it & 31, b = it >> 5;
        tr_tile8(tiles, yT + (size_t)b * SEQ + st * 64, (size_t)NB * SEQ, (size_t)64 * NB * SEQ, ycat + (size_t)(b * SEQ + st * 64) * 1024 + 512, 1024, 64);
    }
}
__device__ void gating_phase(LAS uchar* lds, const u16* __restrict__ proj  , const float* __restrict__ ln_g  ,
                             const float* __restrict__ w_s  , const float* __restrict__ b_s  , u16* __restrict__ ycat  ) {
    LAS u16* vT = (LAS u16*)lds;
    LAS u16* wsb = vT + 128 * 136;
    LAS float* stats = (LAS float*)(wsb + 128 * 136);
    const int tid = opaque_tid(), lane = tid & 63, wave = tid >> 6, fr = lane & 15, fq = lane >> 4;
    for (int item = blockIdx.x; item < T_ / 128; item += gridDim.x) {
        const int tok0 = item * 128;
        { u32x4 vv[16];
#pragma unroll
          for (int tt = 0; tt < 16; ++tt) vv[tt] = *(const u32x4*)(proj + (size_t)(tok0 + wave * 16 + tt) * 1024 + 512 + lane * 8);
#pragma unroll
          for (int tt = 0; tt < 16; ++tt) { const int q = wave * 16 + tt; const u32x4 v = vv[tt];
            const float f0 = bflo(v.x), f1 = bfhi(v.x), f2 = bflo(v.y), f3 = bfhi(v.y), f4 = bflo(v.z), f5 = bfhi(v.z), f6 = bflo(v.w), f7 = bfhi(v.w);
            const float mean = wave_sum(f0 + f1 + f2 + f3 + f4 + f5 + f6 + f7) * (1.0f / 512.0f);
            const float d0 = f0 - mean, d1 = f1 - mean, d2 = f2 - mean, d3 = f3 - mean, d4 = f4 - mean, d5 = f5 - mean, d6 = f6 - mean, d7 = f7 - mean;
            const float var = wave_sum(d0 * d0 + d1 * d1 + d2 * d2 + d3 * d3 + d4 * d4 + d5 * d5 + d6 * d6 + d7 * d7) * (1.0f / 512.0f);
            if (lane == 0) { stats[q * 2] = mean; stats[q * 2 + 1] = rsqrtf(var + 1e-5f); } } }
        __syncthreads();
        u32x4 vreg[4]; float4 wreg[8];
#define GATE_LOAD(g) do { _Pragma("unroll") for (int i = 0; i < 4; ++i) { const int idx = tid + i * NTHR; vreg[i] = *(const u32x4*)(proj + (size_t)(tok0 + (idx >> 4)) * 1024 + 512 + (g) * 128 + (idx & 15) * 8); } \
                          _Pragma("unroll") for (int i = 0; i < 8; ++i) { const int idx = tid + i * NTHR; wreg[i] = *(const float4*)(w_s + (size_t)((g) * 128 + (idx >> 5)) * 128 + (idx & 31) * 4); } } while (0)
        GATE_LOAD(0);
#pragma unroll
        for (int g = 0; g < 4; ++g) {
#pragma unroll
            for (int i = 0; i < 4; ++i) { const int idx = tid + i * NTHR; const int q = idx >> 4, c0 = (idx & 15) * 8;
                const u32x4 v = vreg[i];
                const float mean = stats[q * 2], rstd = stats[q * 2 + 1];
                const float4 g0 = *(const float4*)(ln_g + g * 128 + c0), g1 = *(const float4*)(ln_g + g * 128 + c0 + 4);
                vT[(c0 + 0) * 136 + q] = f2bf((bflo(v.x) - mean) * rstd * g0.x); vT[(c0 + 1) * 136 + q] = f2bf((bfhi(v.x) - mean) * rstd * g0.y);
                vT[(c0 + 2) * 136 + q] = f2bf((bflo(v.y) - mean) * rstd * g0.z); vT[(c0 + 3) * 136 + q] = f2bf((bfhi(v.y) - mean) * rstd * g0.w);
                vT[(c0 + 4) * 136 + q] = f2bf((bflo(v.z) - mean) * rstd * g1.x); vT[(c0 + 5) * 136 + q] = f2bf((bfhi(v.z) - mean) * rstd * g1.y);
                vT[(c0 + 6) * 136 + q] = f2bf((bflo(v.w) - mean) * rstd * g1.z); vT[(c0 + 7) * 136 + q] = f2bf((bfhi(v.w) - mean) * rstd * g1.w); }
#pragma unroll
            for (int i = 0; i < 8; ++i) { const int idx = tid + i * NTHR; const int p = idx >> 5, q0 = (idx & 31) * 4;
                const float4 w = wreg[i];
                u32x2 o; o.x = cvt_pk_bf16(w.x, w.y); o.y = cvt_pk_bf16(w.z, w.w);
                *(LAS u32x2*)(wsb + p * 136 + q0) = o; }
            __syncthreads();
            if (g < 3) GATE_LOAD(g + 1);
            const int p = 16 * wave + fr; const size_t tok = (size_t)(tok0 + p); const float bias = b_s[g * 128 + p];
            u32x2 uu[8];
#pragma unroll
            for (int mi = 0; mi < 8; ++mi) uu[mi] = *(const u32x2*)(proj + tok * 1024 + g * 128 + 16 * mi + 4 * fq);
            f32x4 acc[8];
#pragma unroll
            for (int mi = 0; mi < 8; ++mi) acc[mi] = (f32x4){0.f, 0.f, 0.f, 0.f};
#pragma unroll
            for (int kk = 0; kk < 4; ++kk) {
                const bf16x8 bfrag = *(const LAS bf16x8*)(wsb + (16 * wave + fr) * 136 + 32 * kk + 8 * fq);
#pragma unroll
                for (int mi = 0; mi < 8; ++mi) { const bf16x8 afrag = *(const LAS bf16x8*)(vT + (16 * mi + fr) * 136 + 32 * kk + 8 * fq);
                    acc[mi] = __builtin_amdgcn_mfma_f32_16x16x32_bf16(afrag, bfrag, acc[mi], 0, 0, 0); }
            }
#pragma unroll
            for (int mi = 0; mi < 8; ++mi) { const int c = 16 * mi + 4 * fq;
                u32x2 o; o.x = cvt_pk_bf16(bflo(uu[mi].x) * (acc[mi][0] + bias), bfhi(uu[mi].x) * (acc[mi][1] + bias)); o.y = cvt_pk_bf16(bflo(uu[mi].y) * (acc[mi][2] + bias), bfhi(uu[mi].y) * (acc[mi][3] + bias));
                *(u32x2*)(ycat + tok * 1024 + g * 128 + c) = o; }
            __syncthreads();
        }
#undef GATE_LOAD
    }
}

constexpr int HZ_ROW = 4112;
constexpr int HZ_KR0 = NB * HZ_ROW;
constexpr int HZ_KRC = 8208;
static_assert(HZ_KR0 + 2 * HZ_KRC <= LDS_ST_OFF, "hyena LDS");

__device__ __forceinline__ void hy_load_kr(LAS uchar* lds, const u16* __restrict__ g) {
    const int tid = opaque_tid();
    const u32x4 w = *(const u32x4*)(g + tid * 8);
    const unsigned nxt = (tid < 511) ? (unsigned)g[tid * 8 + 8] : 0u;
    *(LAS u32x4*)(lds + HZ_KR0 + tid * 16) = w;
    u32x4 s; s.x = (w.x >> 16) | (w.y << 16); s.y = (w.y >> 16) | (w.z << 16); s.z = (w.z >> 16) | (w.w << 16); s.w = (w.w >> 16) | (nxt << 16);
    *(LAS u32x4*)(lds + HZ_KR0 + HZ_KRC + tid * 16) = s;
}
__device__ __forceinline__ void conv3_8(const u16* __restrict__ p, int s0, float w0, float w1, float w2, float (&o)[8]) {
    const u32x4 v = *(const u32x4*)(p + s0);
    const float prev = (s0 > 0) ? bf2f(p[s0 - 1]) : 0.f, next = (s0 + 8 < SEQ) ? bf2f(p[s0 + 8]) : 0.f;
    const float x0 = bflo(v.x), x1 = bfhi(v.x), x2 = bflo(v.y), x3 = bfhi(v.y), x4 = bflo(v.z), x5 = bfhi(v.z), x6 = bflo(v.w), x7 = bfhi(v.w);
    o[0] = w0 * prev + w1 * x0 + w2 * x1; o[1] = w0 * x0 + w1 * x1 + w2 * x2; o[2] = w0 * x1 + w1 * x2 + w2 * x3; o[3] = w0 * x2 + w1 * x3 + w2 * x4;
    o[4] = w0 * x3 + w1 * x4 + w2 * x5; o[5] = w0 * x4 + w1 * x5 + w2 * x6; o[6] = w0 * x5 + w1 * x6 + w2 * x7; o[7] = w0 * x6 + w1 * x7 + w2 * next;
}
__device__ void hyena_phase(LAS uchar* lds, const u16* __restrict__ pT  , const u16* __restrict__ G  , const float* __restrict__ conv_w  ,
                            const float* __restrict__ skip  , u16* __restrict__ yT  ) {
    const int tid = opaque_tid(), lane = tid & 63, wave = __builtin_amdgcn_readfirstlane(tid >> 6), r = lane & 31, h = lane >> 5;
    const int tbase = 256 * wave;
    const int e0 = 8 * h - r + 2048 - tbase, par = e0 & 1;
    const LAS uchar* abase = lds + HZ_KR0 + par * HZ_KRC + (e0 - par) * 2;
    const LAS uchar* bbase = lds + r * HZ_ROW + 16 * h;
    for (int c = blockIdx.x; c < 512; c += gridDim.x) {
        {
            const u16* src = pT + (size_t)c * NB * SEQ; const float w0 = conv_w[c], w1 = conv_w[1536 + c], w2 = conv_w[3072 + c];
#pragma unroll
            for (int it = 0; it < 16; ++it) { const int idx = tid + it * NTHR; const int b = idx >> 8, s0 = (idx & 255) * 8; float o[8];
                conv3_8(src + (size_t)b * SEQ, s0, w0, w1, w2, o);
                u32x4 w; w.x = cvt_pk_bf16(o[0], o[1]); w.y = cvt_pk_bf16(o[2], o[3]); w.z = cvt_pk_bf16(o[4], o[5]); w.w = cvt_pk_bf16(o[6], o[7]);
                *(LAS u32x4*)(lds + b * HZ_ROW + s0 * 2) = w; }
            hy_load_kr(lds, G + (size_t)c * 4096);
        }
        __syncthreads();
#pragma unroll 1
        for (int o = 0; o < 2; ++o) {
            f32x16 acc[8];
#pragma unroll
            for (int i = 0; i < 8; ++i)
#pragma unroll
                for (int k = 0; k < 16; ++k) acc[i][k] = 0.f;
#pragma unroll 1
            for (int p = 0; p < 2; ++p) {
                bf16x8 W[8];
#pragma unroll
                for (int k = 1; k < 8; ++k) { const LAS unsigned* ap = (const LAS unsigned*)(abase + (16 * p - 32 * k) * 2);
                    i32x4 av; av.x = (int)ap[0]; av.y = (int)ap[1]; av.z = (int)ap[2]; av.w = (int)ap[3]; W[8 - k] = __builtin_bit_cast(bf16x8, av); }
#pragma unroll 1
                for (int J = 0; J < 8; ++J) {
                    const LAS uchar* aj = abase + (16 * p + 256 * J) * 2;
                    const LAS uchar* bj = bbase + (16 * p + 256 * J) * 2;
#pragma unroll
                    for (int jj = 0; jj < 8; ++jj) {
                        const LAS unsigned* ap = (const LAS unsigned*)(aj + 64 * jj);
                        i32x4 av; av.x = (int)ap[0]; av.y = (int)ap[1]; av.z = (int)ap[2]; av.w = (int)ap[3]; W[jj] = __builtin_bit_cast(bf16x8, av);
                        const bf16x8 bb = *(const LAS bf16x8*)(bj + 64 * jj);
#pragma unroll
                        for (int i = 0; i < 8; ++i) acc[i] = __builtin_amdgcn_mfma_f32_32x32x16_bf16(W[(jj - i) & 7], bb, acc[i], 0, 0, 0);
                    }
                }
            }
            { const int cc = 512 * (o + 1) + c; const float w0 = conv_w[cc], w1 = conv_w[1536 + cc], w2 = conv_w[3072 + cc]; const float sk = skip[o * 512 + c];
              const u16* p0 = pT + ((size_t)cc * NB + r) * SEQ + tbase + 4 * h;
              const LAS uchar* z0 = lds + r * HZ_ROW + (tbase + 4 * h) * 2;
              const int tl = tbase + 4 * h;
#pragma unroll
              for (int i = 0; i < 8; ++i) {
                  if ((i & 3) == 0) __builtin_amdgcn_sched_barrier(0);
#pragma unroll
                  for (int q = 0; q < 4; ++q) { const int off = 32 * i + 8 * q;
                      const u32x2 zz = *(const LAS u32x2*)(z0 + off * 2);
                      const u32x2 gv = *(const u32x2*)(p0 + off);
                      const float um = bf2f(p0[off - 1]), up = bf2f(p0[off + 4]);
                      const float gm = (tl + off > 0) ? um : 0.f, gp = (tl + off + 4 < SEQ) ? up : 0.f;
                      const float g0 = bflo(gv.x), g1 = bfhi(gv.x), g2 = bflo(gv.y), g3 = bfhi(gv.y);
                      acc[i][4 * q + 0] = (w0 * gm + w1 * g0 + w2 * g1) * (acc[i][4 * q + 0] + sk * bflo(zz.x));
                      acc[i][4 * q + 1] = (w0 * g0 + w1 * g1 + w2 * g2) * (acc[i][4 * q + 1] + sk * bfhi(zz.x));
                      acc[i][4 * q + 2] = (w0 * g1 + w1 * g2 + w2 * g3) * (acc[i][4 * q + 2] + sk * bflo(zz.y));
                      acc[i][4 * q + 3] = (w0 * g2 + w1 * g3 + w2 * gp) * (acc[i][4 * q + 3] + sk * bfhi(zz.y)); } } }
            __syncthreads();
#pragma unroll
            for (int i = 0; i < 8; ++i)
#pragma unroll
                for (int q = 0; q < 4; ++q) {
                    u32x2 w; w.x = cvt_pk_bf16(acc[i][4 * q + 0], acc[i][4 * q + 1]); w.y = cvt_pk_bf16(acc[i][4 * q + 2], acc[i][4 * q + 3]);
                    *(LAS u32x2*)(lds + r * HZ_ROW + (tbase + 4 * h) * 2 + (32 * i + 8 * q) * 2) = w; }
            if (o == 0) hy_load_kr(lds, G + (size_t)(512 + c) * 4096);
            __syncthreads();
        }
#pragma unroll 8
        for (int idx = tid; idx < NB * 256; idx += NTHR) { const int b = idx >> 8, s0 = (idx & 255) * 8;
            *(u32x4*)(yT + ((size_t)c * NB + b) * SEQ + s0) = *(const LAS u32x4*)(lds + b * HZ_ROW + s0 * 2); }
        __syncthreads();
    }
}

__device__ __forceinline__ u32x4 pack8(const float (&o)[8]) { u32x4 w; w.x = cvt_pk_bf16(o[0], o[1]); w.y = cvt_pk_bf16(o[2], o[3]); w.z = cvt_pk_bf16(o[4], o[5]); w.w = cvt_pk_bf16(o[6], o[7]); return w; }
template <int W> __device__ __forceinline__ void pool_unit(const u16* __restrict__ seq  , int t0, u16* __restrict__ out  ) {
    constexpr int LEFT = W / 2, RIGHT = W - LEFT - 1, NR = 8 + W - 1;
    u32x4 rows[NR];
#pragma unroll
    for (int k = 0; k < NR; ++k) { const int p = t0 - LEFT + k; const int pc = min(max(p, 0), SEQ - 1);
        const u32x4 v = *(const u32x4*)(seq + (size_t)pc * 2048); const bool ok = (p >= 0 && p < SEQ);
        rows[k].x = ok ? v.x : 0u; rows[k].y = ok ? v.y : 0u; rows[k].z = ok ? v.z : 0u; rows[k].w = ok ? v.w : 0u; }
    float sm[8];
#pragma unroll
    for (int c = 0; c < 8; ++c) sm[c] = 0.f;
#pragma unroll
    for (int k = 0; k < W; ++k) { float f[8]; unpack8(rows[k], f);
#pragma unroll
        for (int c = 0; c < 8; ++c) sm[c] += f[c]; }
#pragma unroll
    for (int i = 0; i < 8; ++i) { const int t = t0 + i; const int lo = max(t - LEFT, 0), hi = min(t + RIGHT, SEQ - 1); const float inv = 1.0f / (float)(hi - lo + 1);
        float ctr[8], o[8]; unpack8(rows[i + LEFT], ctr);
#pragma unroll
        for (int c = 0; c < 8; ++c) o[c] = sm[c] * inv - ctr[c];
        *(u32x4*)(out + (size_t)t * 1024) = pack8(o);
        if (i < 7) { float fa[8], fs[8]; unpack8(rows[i + W], fa); unpack8(rows[i], fs);
#pragma unroll
            for (int c = 0; c < 8; ++c) sm[c] += fa[c] - fs[c]; } }
}
__device__ __forceinline__ void dconv_unit(const u16* __restrict__ seq  , int t0, const float* __restrict__ dconv  , u16* __restrict__ out  ) {
    u32x4 cr[10], hr[10], br[8];
#pragma unroll
    for (int k = 0; k < 10; ++k) { const int p = t0 - 1 + k; const int pc = min(max(p, 0), SEQ - 1);
        const u32x4 v = *(const u32x4*)(seq + (size_t)pc * 2048 + 1024); hr[k] = *(const u32x4*)(seq + (size_t)pc * 2048 + 1536); const bool ok = (p >= 0 && p < SEQ);
        cr[k].x = ok ? v.x : 0u; cr[k].y = ok ? v.y : 0u; cr[k].z = ok ? v.z : 0u; cr[k].w = ok ? v.w : 0u; }
#pragma unroll
    for (int i = 0; i < 8; ++i) br[i] = *(const u32x4*)(seq + (size_t)(t0 + i) * 2048 + 512);
    float w0[8], w1[8], w2[8];
    { const float4 a0 = *(const float4*)(dconv), a1 = *(const float4*)(dconv + 4), b0 = *(const float4*)(dconv + 512), b1 = *(const float4*)(dconv + 516), c0 = *(const float4*)(dconv + 1024), c1 = *(const float4*)(dconv + 1028);
      w0[0] = a0.x; w0[1] = a0.y; w0[2] = a0.z; w0[3] = a0.w; w0[4] = a1.x; w0[5] = a1.y; w0[6] = a1.z; w0[7] = a1.w;
      w1[0] = b0.x; w1[1] = b0.y; w1[2] = b0.z; w1[3] = b0.w; w1[4] = b1.x; w1[5] = b1.y; w1[6] = b1.z; w1[7] = b1.w;
      w2[0] = c0.x; w2[1] = c0.y; w2[2] = c0.z; w2[3] = c0.w; w2[4] = c1.x; w2[5] = c1.y; w2[6] = c1.z; w2[7] = c1.w; }
    float pm[8], pc_[8], pn[8];
    { float c[8], h[8]; unpack8(cr[0], c); unpack8(hr[0], h);
#pragma unroll
      for (int k = 0; k < 8; ++k) pm[k] = c[k] * h[k];
      unpack8(cr[1], c); unpack8(hr[1], h);
#pragma unroll
      for (int k = 0; k < 8; ++k) pc_[k] = c[k] * h[k]; }
#pragma unroll
    for (int i = 0; i < 8; ++i) { float c[8], h[8], bb[8], o[8]; unpack8(cr[i + 2], c); unpack8(hr[i + 2], h); unpack8(br[i], bb);
#pragma unroll
        for (int k = 0; k < 8; ++k) { pn[k] = c[k] * h[k]; o[k] = bb[k] * (w0[k] * pm[k] + w1[k] * pc_[k] + w2[k] * pn[k]); pm[k] = pc_[k]; pc_[k] = pn[k]; }
        *(u32x4*)(out + (size_t)(t0 + i) * 1024) = pack8(o); }
}
__device__ void stencil_phase(const u16* __restrict__ proj  , const float* __restrict__ dconv  , u16* __restrict__ ycat  ) {
    const int tid = opaque_tid(), lane = tid & 63, wave = __builtin_amdgcn_readfirstlane(tid >> 6);
    const int chl = (lane & 15) * 8, run = lane >> 4;
    for (int wu = blockIdx.x * 8 + wave; wu < (T_ / 32) * 8; wu += gridDim.x * 8) {
        const int rq = wu >> 3, kind = wu & 7; const int tok0 = rq * 32 + run * 8; const int t0 = tok0 & (SEQ - 1); const size_t s0 = (size_t)(tok0 - t0);
        if (kind < 4) { const int ch0 = kind * 128 + chl; const u16* seq = proj + s0 * 2048 + ch0; u16* out = ycat + s0 * 1024 + ch0;
            if (kind == 0) pool_unit<2>(seq, t0, out); else if (kind == 1) pool_unit<4>(seq, t0, out); else if (kind == 2) pool_unit<8>(seq, t0, out); else pool_unit<16>(seq, t0, out);
        } else { const int ch0 = (kind - 4) * 128 + chl; dconv_unit(proj + s0 * 2048 + ch0, t0, dconv + ch0, ycat + s0 * 1024 + 512 + ch0); }
    }
}


#define XB_TMO      128
#define XB_XCNT(j)  (256  + 64 * (j))
#define XB_XSUB(j)  (1280 + 64 * (j))
#define XB_XGEN(j)  (2304 + 64 * (j))
#define XB_TOP      3328
#define XB_TOPGEN   3392
#define XCD_BAR_WORDS 3456
#define XB_SPIN_CAP (1u << 20)
__device__ __forceinline__ unsigned xb_ld(unsigned* p)              { return __hip_atomic_load(p, __ATOMIC_RELAXED, __HIP_MEMORY_SCOPE_AGENT); }
__device__ __forceinline__ unsigned xb_add(unsigned* p, unsigned v) { return __hip_atomic_fetch_add(p, v, __ATOMIC_RELAXED, __HIP_MEMORY_SCOPE_AGENT); }
__device__ __forceinline__ unsigned xb_xcc_id() { return (unsigned)__builtin_amdgcn_s_getreg((3 << 11) | 20) & 0xFu; }
#define XB_SPIN(cond, bar) do { unsigned _sp = 0; while (cond) { __builtin_amdgcn_s_sleep(1); \
    if ((++_sp & 255u) == 0u) { if (xb_ld(&(bar)[XB_TMO])) break; if (_sp > XB_SPIN_CAP) { atomicAdd(&(bar)[XB_TMO], 1u); break; } } } } while (0)
struct XcdBarrier { unsigned* bar; unsigned x; volatile LAS unsigned* st; };
__device__ __forceinline__ XcdBarrier xcd_barrier_post(unsigned* bar, volatile LAS unsigned* st) {
    XcdBarrier b; b.bar = bar; b.x = xb_xcc_id(); b.st = st;
    if (threadIdx.x == 0) (void)xb_add(&bar[XB_XCNT(b.x)], 1u);
    return b;
}
__device__ __forceinline__ void xcd_barrier_complete(unsigned* bar, unsigned x, unsigned& nloc, unsigned& nx) {
    const unsigned G = gridDim.x * gridDim.y * gridDim.z;
    unsigned sum, cnt, mine, sp = 0u;
    for (;;) {
        sum = 0u; cnt = 0u; mine = 0u;
#pragma unroll
        for (unsigned j = 0; j < 16; ++j) { const unsigned c = xb_ld(&bar[XB_XCNT(j)]); sum += c; cnt += (c > 0u) ? 1u : 0u; mine = (j == x) ? c : mine; }
        if (sum == G) break;
        __builtin_amdgcn_s_sleep(1);
        if ((++sp & 255u) == 0u) { if (xb_ld(&bar[XB_TMO])) break; if (sp > XB_SPIN_CAP) { atomicAdd(&bar[XB_TMO], 1u); break; } }
    }
    nloc = mine > 0u ? mine : 1u; nx = cnt > 0u ? cnt : 1u;
}
__device__ __forceinline__ void xcd_barrier(const XcdBarrier& b) {
    asm volatile("s_waitcnt vmcnt(0)" ::: "memory");
    __syncthreads();
    if (threadIdx.x == 0) {
        unsigned* bar = b.bar;
        __builtin_amdgcn_s_waitcnt(0);
        unsigned nloc = b.st[0], nx = b.st[1];
        if (nloc == 0u) { xcd_barrier_complete(bar, b.x, nloc, nx); b.st[0] = nloc; b.st[1] = nx; }
        const unsigned old = xb_add(&bar[XB_XSUB(b.x)], 1u);
        const unsigned gen = old / nloc;
        if (old + 1u == (gen + 1u) * nloc) {
            __builtin_amdgcn_fence(__ATOMIC_RELEASE, "agent");
            asm volatile("s_waitcnt vmcnt(0)" ::: "memory");
            const unsigned og = xb_add(&bar[XB_TOP], 1u);
            const unsigned tg = og / nx;
            if (og + 1u == (tg + 1u) * nx) xb_add(&bar[XB_TOPGEN], 1u);
            else XB_SPIN(xb_ld(&bar[XB_TOPGEN]) == tg, bar);
            __builtin_amdgcn_fence(__ATOMIC_ACQUIRE, "agent");
            xb_add(&bar[XB_XGEN(b.x)], 1u);
            asm volatile("s_waitcnt vmcnt(0)" ::: "memory");
        } else {
            XB_SPIN(xb_ld(&bar[XB_XGEN(b.x)]) == gen, bar);
            __builtin_amdgcn_fence(__ATOMIC_ACQUIRE, "agent");
            asm volatile("s_waitcnt vmcnt(0)" ::: "memory");
        }
    }
    __syncthreads();
}

constexpr int NPH = 1 + 2 * 8 + 2 * 7;
struct Args { const float* in[23]; float* out; uchar* ws; int lo, hi; };

__global__ void __launch_bounds__(NTHR, 2) fwd_kernel(Args a) {
    extern __shared__ __attribute__((aligned(16))) uchar lds_raw[];
    LAS uchar* lds = (LAS uchar*)lds_raw;
    cg::grid_group grid = cg::this_grid();
    const int lo = a.lo, hi = a.hi; int ph = 0;
    volatile LAS unsigned* xst = (volatile LAS unsigned*)(lds + LDS_ST_OFF);
    if (threadIdx.x == 0) { xst[0] = 0u; xst[1] = 0u; }
    __syncthreads();
    XcdBarrier xb = xcd_barrier_post((unsigned*)(a.ws + WS_BAR), xst);
#define PH_BEGIN if (ph >= lo && ph < hi) {
#define PH_END } if (ph >= lo && ph + 1 < hi) { if (lo < 0) grid.sync();   xcd_barrier(xb); if (DBL(11) == 2) { xcd_barrier(xb); xcd_barrier(xb); } } ++ph;
    uchar* ws = a.ws;
    u16* Wabin = (u16*)(ws + WS_ABIN); u16* Wabout = (u16*)(ws + WS_ABOUT); u16* Wcdin = (u16*)(ws + WS_CDIN); u16* Wcdout = (u16*)(ws + WS_CDOUT);
    u16* Wgu = (u16*)(ws + WS_GU); u16* Wdown = (u16*)(ws + WS_DOWN); u16* Gf = (u16*)(ws + WS_G);
    u16* H = (u16*)(ws + WS_H); u16* PROJ = (u16*)(ws + WS_B); u16* YT = (u16*)(ws + WS_B + (size_t)T_ * 1024 * 2);     u16* ACT = (u16*)(ws + WS_B); u16* PT = (u16*)(ws + WS_C);
    u16* YCAT = (u16*)(ws + WS_D); u16* MIX = (u16*)(ws + WS_E); float* RSTD = (float*)(ws + WS_RSTD);
    const float* x_in = a.in[0]; const float* norm_g = a.in[1]; float* X = a.out;

    PH_BEGIN
      for (int rep = 0; rep < DBL(0); ++rep) {
        int rot = 0;
        if ((blockIdx.x & 1) == 0) filter_job(lds, a.in[10], a.in[11], a.in[12], a.in[13], a.in[14], a.in[15], a.in[16], Gf);
        for (int j = 0; j < 2; ++j) {
            wt_job(lds, a.in[4] + (size_t)j * 1024 * 2560, 2560, 1024, 2560, Wabin + (size_t)j * 2560 * 1024, 1024, 0, norm_g + (size_t)(2 * j) * 4 * 1024, rot);
            wt_job(lds, a.in[5] + (size_t)j * 1024 * 1024, 1024, 1024, 1024, Wabout + (size_t)j * 1024 * 1024, 1024, 0, nullptr, rot);
            wt_job(lds, a.in[18] + (size_t)j * 1024 * 2048, 2048, 1024, 2048, Wcdin + (size_t)j * 2048 * 1024, 1024, 0, norm_g + (size_t)(2 * j + 1) * 4 * 1024, rot);
            wt_job(lds, a.in[19] + (size_t)j * 1024 * 1024 + 512 * 1024, 1024, 512, 1024, Wcdout + (size_t)j * 1024 * 1024 + 512, 1024, 0, nullptr, rot);
            fold_job(a.in[20] + (size_t)j * 4 * 128 * 128, a.in[21] + j * 512, a.in[19] + (size_t)j * 1024 * 1024, Wcdout + (size_t)j * 1024 * 1024);
        }
        for (int i = 0; i < 4; ++i) {
            wt_job(lds, a.in[2] + (size_t)i * 1024 * 5632, 5632, 1024, 5632, Wgu + (size_t)i * 5632 * 1024, 1024, 1, norm_g + (size_t)(i * 4 + 2) * 1024, rot);
            wt_job(lds, a.in[3] + (size_t)i * 2816 * 1024, 1024, 2816, 1024, Wdown + (size_t)i * 1024 * 2816, 2816, 0, nullptr, rot);
        }
      }
        resid_pass(x_in, H, nullptr, nullptr, RSTD, nullptr);
        if ((blockIdx.x & 1) != 0) filter_job(lds, a.in[10], a.in[11], a.in[12], a.in[13], a.in[14], a.in[15], a.in[16], Gf);
    PH_END

#pragma unroll 1
    for (int i = 0; i < 4; ++i) {
        const int j = i >> 1; const bool even = (i & 1) == 0;
        const float* g4 = norm_g + (size_t)i * 4 * 1024;
        PH_BEGIN
            { const int N = even ? 1024 : 2048;
              pg8::Gemm g{H, even ? Wabin + (size_t)j * 2560 * 1024 : Wcdin + (size_t)j * 2048 * 1024, T_, N, 1024};
              pg8::StaticOrder S; S.init(T_, N, (int)gridDim.x, (int)blockIdx.x);
              pg8::EpiBf16G E{PROJ, N, even ? 4 : 0, RSTD};
#ifndef SKIP_G1
              for (int rep = 0; rep < DBL(6); ++rep) pg8::gemm_phase<pg8::EpiBf16G, pg8::StaticOrder, false>(lds, g, S, E, nullptr);
#endif
            }
            if (even) {
              pg8::Gemm g{H, Wabin + (size_t)j * 2560 * 1024 + (size_t)1024 * 1024, T_, 1536, 1024};
              pg8::StaticOrder S; S.init(T_, 1536, (int)gridDim.x, (int)blockIdx.x);
              pg8::EpiPT E{PT, RSTD};
              pg8::gemm_phase<pg8::EpiPT, pg8::StaticOrder, false>(lds, g, S, E, nullptr);
            }
        PH_END
        if (even) {
            PH_BEGIN
                for (int rep = 0; rep < DBL(1); ++rep) gating_phase(lds, PROJ, a.in[6] + j * 512, a.in[7] + (size_t)j * 4 * 128 * 128, a.in[8] + j * 512, YCAT);
                for (int rep = 0; rep < DBL(3); ++rep) hyena_phase(lds, PT, Gf + (size_t)j * 2 * 512 * 4096, a.in[9] + (size_t)j * 3 * 1536, a.in[17] + j * 1024, YT);
            PH_END
            PH_BEGIN
                for (int rep = 0; rep < DBL(4); ++rep) transpose_back_phase(lds, YT, YCAT);
            PH_END
        } else {
            PH_BEGIN
                for (int rep = 0; rep < DBL(5); ++rep) stencil_phase(PROJ, a.in[22] + (size_t)j * 3 * 512, YCAT);
            PH_END
        }
        PH_BEGIN
            pg8::Gemm g{YCAT, even ? Wabout + (size_t)j * 1024 * 1024 : Wcdout + (size_t)j * 1024 * 1024, T_, 1024, 1024};
            pg8::StaticOrder S; S.init(T_, 1024, (int)gridDim.x, (int)blockIdx.x);
            pg8::EpiBf16G E{MIX, 1024, 0, nullptr};

#ifndef SKIP_G2
            for (int rep = 0; rep < DBL(7); ++rep) pg8::gemm_phase<pg8::EpiBf16G, pg8::StaticOrder, false>(lds, g, S, E, nullptr);
#endif
        PH_END
        PH_BEGIN
            if (DBL(10) == 2) resid_pass(nullptr, (u16*)(ws + WS_C), MIX, g4 + 1024, (float*)(ws + WS_B), nullptr);
            resid_pass(nullptr, H, MIX, g4 + 1024, RSTD, nullptr);
        PH_END
        PH_BEGIN
            pg8::Gemm g{H, Wgu + (size_t)i * 5632 * 1024, T_, 5632, 1024};
            pg8::StaticOrder S; S.init(T_, 5632, (int)gridDim.x, (int)blockIdx.x);
            pg8::EpiSwiGLU E{ACT, DFF, RSTD};

#ifndef SKIP_G3
            for (int rep = 0; rep < DBL(8); ++rep) pg8::gemm_phase<pg8::EpiSwiGLU, pg8::StaticOrder, false>(lds, g, S, E, nullptr);
#endif
        PH_END
        PH_BEGIN
            pg8::Gemm g{ACT, Wdown + (size_t)i * 1024 * 2816, T_, 1024, DFF};
            pg8::StaticOrder S; S.init(T_, 1024, (int)gridDim.x, (int)blockIdx.x);
            pg8::EpiBf16G E{MIX, 1024, 0, nullptr};

#ifndef SKIP_G4
            for (int rep = 0; rep < DBL(9); ++rep) pg8::gemm_phase<pg8::EpiBf16G, pg8::StaticOrder, false>(lds, g, S, E, nullptr);
#endif
        PH_END
        PH_BEGIN
            if (DBL(10) == 2) resid_pass(nullptr, (u16*)(ws + WS_C), MIX, g4 + 3072, (float*)(ws + WS_B), nullptr);
            resid_pass(nullptr, H, MIX, g4 + 3072, RSTD, (i == 3) ? X : nullptr);
        PH_END
    }
#undef PH_BEGIN
#undef PH_END
}

extern "C" void kernel_launch(void* const* d_in, const int* in_sizes, int n_in, void* d_out, int out_size, void* d_ws, size_t ws_size, hipStream_t stream) {
    static int grid = 0;
    if (grid == 0) {
        if (n_in != 23 || out_size != T_ * DM || ws_size < WS_END) { fprintf(stderr, "kernel_launch: unexpected problem (n_in %d out %d ws %zu)\n", n_in, out_size, ws_size); grid = -1; return; }
        int dev = 0, cus = 0, per_cu = 0;
        (void)hipGetDevice(&dev); (void)hipDeviceGetAttribute(&cus, hipDeviceAttributeMultiprocessorCount, dev);
        if (hipFuncSetAttribute((const void*)fwd_kernel, hipFuncAttributeMaxDynamicSharedMemorySize, LDS_BYTES) != hipSuccess) { fprintf(stderr, "kernel_launch: hipFuncSetAttribute failed\n"); grid = -1; return; }
        if (hipOccupancyMaxActiveBlocksPerMultiprocessor(&per_cu, (const void*)fwd_kernel, NTHR, LDS_BYTES) != hipSuccess || per_cu < 1) { fprintf(stderr, "kernel_launch: occupancy query gave %d\n", per_cu); per_cu = 1; }
        (void)hipGetLastError();
        grid = cus * per_cu;
        fprintf(stderr, "kernel_launch: grid %d (cus %d x %d)\n", grid, cus, per_cu);
    }
    if (grid < 0) return;
    Args a{};
    for (int i = 0; i < 23; ++i) a.in[i] = (const float*)d_in[i];
    a.out = (float*)d_out; a.ws = (uchar*)d_ws;
#if ONE_LAUNCH
    (void)hipMemsetAsync((char*)d_ws + WS_BAR, 0, XCD_BAR_WORDS * 4, stream);
    a.lo = 0; a.hi = NPH;
    void* args[] = {&a};
    hipError_t e = hipLaunchCooperativeKernel((const void*)fwd_kernel, dim3(grid), dim3(NTHR), args, LDS_BYTES, stream);
    if (e != hipSuccess) fprintf(stderr, "kernel_launch: cooperative launch failed: %s (grid %d)\n", hipGetErrorString(e), grid);
#else
    for (int p = 0; p < NPH; ++p) { a.lo = p; a.hi = p + 1;
        hipLaunchKernelGGL(fwd_kernel, dim3(grid), dim3(NTHR), LDS_BYTES, stream, a); }
#endif
}
```

```cpp
#include <hip/hip_runtime.h>
#include <hip/hip_cooperative_groups.h>
#include <cstdio>
namespace cg = cooperative_groups;

#ifndef ONE_LAUNCH
#define ONE_LAUNCH 1
#endif
#ifndef DBL_MASK
#define DBL_MASK 0
#endif
#ifndef ALIGN_EPI
#define ALIGN_EPI 1
#endif
#ifndef USE_SP2
#define USE_SP2 1
#endif
#define DBL(bit) (((DBL_MASK >> (bit)) & 1) ? 2 : 1)

__device__ __forceinline__ int opaque_tid() { int t = (int)threadIdx.x; asm volatile("" : "+v"(t)); return t; }
namespace pg8 {
#define PG8_LAS __attribute__((address_space(3)))
typedef unsigned short bf16_t;
typedef short bf16x8 __attribute__((ext_vector_type(8)));
typedef float f32x4 __attribute__((ext_vector_type(4)));
typedef unsigned u32x4 __attribute__((ext_vector_type(4)));
constexpr int RS_LDS_OFF = 132096;
constexpr int EPI_LDS_OFF = 134144, EPI_LDS_WAVE = 2304;
constexpr int BM = 256, BK = 64, HALF = 128, HTB = HALF * BK * 2  , STAGE_BYTES = 8 * HTB, NXCD = 8, WGM = 8;

__host__ __device__ __forceinline__ int lds_byte(int r, int c) { const int st = (r >> 4) * 2 + (c >> 5), rr = r & 15, cc = c & 31, ob = rr * 64 + cc * 2; return st * 1024 + (ob ^ (((ob >> 9) & 1) << 5)); }
__host__ __device__ __forceinline__ void stage_rc(int b, int& R, int& C) { const int st = b / 1024, sb = b % 1024, swz = sb ^ (((sb >> 9) & 1) << 5); R = (st >> 1) * 16 + swz / 64; C = (st & 1) * 32 + (swz % 64) / 2; }
__host__ __device__ __forceinline__ int perm32(int rho) { const int n = rho >> 4, i = rho & 15; return 8 * (i >> 2) + 4 * n + (i & 3); }
struct Unit { int pm, pn; };
struct Gemm { const bf16_t* A; const bf16_t* Bt; int M, N, K; };

struct StaticOrder {
    int nM, nN, nwg, G, c;
    __host__ __device__ void init(int M, int N, int G_, int c_) { nM = M / BM; nN = N / BM; nwg = nM * nN; G = G_; c = c_; }
    __host__ __device__ bool next(int i, Unit& u) const {
        const long L = (long)i * G + c; if (L >= nwg) return false;
        int wgid = (int)L; { const int q = nwg / NXCD, r = nwg % NXCD, xcd = wgid % NXCD, off = wgid / NXCD; wgid = (xcd < r ? xcd * (q + 1) : r * (q + 1) + (xcd - r) * q) + off; }
        const int nig = WGM * nN, gid = wgid / nig, fm = gid * WGM, gsz = (nM - fm) < WGM ? (nM - fm) : WGM;
        u.pm = fm + ((wgid % nig) % gsz); u.pn = (wgid % nig) / gsz; return true;
    }
    __device__ __forceinline__ void a_ready(const Unit&) const {}
    __device__ __forceinline__ void done(const Unit&) const {}
};
__device__ __forceinline__ unsigned cvt_pk_bf16(float lo, float hi) { unsigned r; asm volatile("v_cvt_pk_bf16_f32 %0, %1, %2" : "=v"(r) : "v"(lo), "v"(hi)); return r; }

__device__ __forceinline__ float gelu_tanh_f(float x) { const float y = 1.5957691216f * (x + 0.044715f * x * x * x); return x * __builtin_amdgcn_rcpf(1.0f + __expf(-y)); }
__device__ __forceinline__ float silu_f(float x) { return x * __builtin_amdgcn_rcpf(1.0f + __expf(-x)); }

struct EpiBf16G {
    static constexpr bool PERM = true, AFTER_DRAIN = false, SWAP = false; static constexpr int NSTORES = 16;
    bf16_t* O; int ldc; int gelu_tiles; const float* rs;
    __device__ __forceinline__ void operator()(const f32x4 (&acc)[2][2][4][2], const Unit& u, int wr, int wc, int fr, int fq, const PG8_LAS float* rsl, PG8_LAS unsigned char* eslot) const {
        const int lane = fq * 16 + fr, lr = lane >> 2, lc = (lane & 3) * 8;
        const int rowb = u.pm * BM + wr * 64, colb = u.pn * BM + wc * 32;
        const bool act = u.pn < gelu_tiles;
#pragma unroll
        for (int ai = 0; ai < 2; ++ai)
#pragma unroll
            for (int m = 0; m < 4; ++m) {
                const float sc = rs ? rsl[wr * 64 + fr + ai * HALF + m * 16] : 1.0f;
#pragma unroll
                for (int bj = 0; bj < 2; ++bj) { f32x4 v0 = acc[ai][bj][m][0] * sc, v1 = acc[ai][bj][m][1] * sc;
                    if (act) {
#pragma unroll
                        for (int j = 0; j < 4; ++j) { v0[j] = gelu_tanh_f(v0[j]); v1[j] = gelu_tanh_f(v1[j]); } }
                    u32x4 w; w.x = cvt_pk_bf16(v0[0], v0[1]); w.y = cvt_pk_bf16(v0[2], v0[3]); w.z = cvt_pk_bf16(v1[0], v1[1]); w.w = cvt_pk_bf16(v1[2], v1[3]);
                    PG8_LAS unsigned char* sl = eslot;
                    *(PG8_LAS u32x4*)(sl + fr * 64 + fq * 16) = w;
                    const u32x4 w2 = *(const PG8_LAS u32x4*)(sl + lane * 16);
                    *(u32x4*)(O + (size_t)(rowb + ai * HALF + m * 16 + lr) * ldc + colb + bj * HALF + lc) = w2; } }
    }
};
struct EpiPT {
    static constexpr bool PERM = false, AFTER_DRAIN = false, SWAP = true; static constexpr int NSTORES = 16;
    bf16_t* O; const float* rs;
    __device__ __forceinline__ void operator()(const f32x4 (&acc)[2][2][4][2], const Unit& u, int wr, int wc, int fr, int fq, const PG8_LAS float* rsl, PG8_LAS unsigned char* eslot) const {
        typedef unsigned u32x2_t __attribute__((ext_vector_type(2)));
        const int lane = fq * 16 + fr;
        const int rowb = u.pm * BM + wr * 64; const int b = rowb >> 11, s0 = rowb & 2047;
#pragma unroll
        for (int ai = 0; ai < 2; ++ai)
#pragma unroll
            for (int bj = 0; bj < 2; ++bj)
#pragma unroll
                for (int n = 0; n < 2; ++n) { const int col0 = u.pn * BM + bj * HALF + wc * 32 + n * 16;
#pragma unroll
                    for (int m = 0; m < 4; ++m) { const f32x4 sc = *(const PG8_LAS f32x4*)(rsl + wr * 64 + 4 * fq + ai * HALF + m * 16);
                        const f32x4 v = acc[ai][bj][m][n] * sc;
                        u32x2_t w; w.x = cvt_pk_bf16(v[0], v[1]); w.y = cvt_pk_bf16(v[2], v[3]);
                        *(PG8_LAS u32x2_t*)(eslot + fr * 144 + (16 * m + 4 * fq) * 2) = w; }
#pragma unroll
                    for (int k = 0; k < 2; ++k) { const int c = lane + 64 * k, col = c >> 3, ch = c & 7;
                        const u32x4 w2 = *(const PG8_LAS u32x4*)(eslot + col * 144 + ch * 16);
                        *(u32x4*)(O + ((size_t)(col0 + col) * 32 + b) * 2048 + s0 + ai * HALF + ch * 8) = w2; } }
    }
};
struct EpiSwiGLU {
    static constexpr bool PERM = true, AFTER_DRAIN = false, SWAP = false; static constexpr int NSTORES = 8;
    bf16_t* O; int ldc; const float* rs;
    __device__ __forceinline__ void operator()(const f32x4 (&acc)[2][2][4][2], const Unit& u, int wr, int wc, int fr, int fq, const PG8_LAS float* rsl, PG8_LAS unsigned char* eslot) const {
        const int lane = fq * 16 + fr, lr = lane >> 2, lc = (lane & 3) * 8;
        const int rowb = u.pm * BM + wr * 64, colb = u.pn * HALF + wc * 32;
#pragma unroll
        for (int ai = 0; ai < 2; ++ai)
#pragma unroll
            for (int m = 0; m < 4; ++m) {
                const float sc = rsl[wr * 64 + fr + ai * HALF + m * 16];
                const f32x4 g0 = acc[ai][0][m][0] * sc, g1 = acc[ai][0][m][1] * sc, u0 = acc[ai][1][m][0] * sc, u1 = acc[ai][1][m][1] * sc;
                const f32x4 a0 = g0 * (-1.4426950408889634f), a1 = g1 * (-1.4426950408889634f);
                f32x4 e0, e1;
#pragma unroll
                for (int j = 0; j < 4; ++j) { e0[j] = __builtin_amdgcn_exp2f(a0[j]); e1[j] = __builtin_amdgcn_exp2f(a1[j]); }
                const f32x4 d0 = e0 + 1.0f, d1 = e1 + 1.0f;
                f32x4 r0, r1;
#pragma unroll
                for (int j = 0; j < 4; ++j) { r0[j] = __builtin_amdgcn_rcpf(d0[j]); r1[j] = __builtin_amdgcn_rcpf(d1[j]); }
                const f32x4 v0 = (g0 * u0) * r0, v1 = (g1 * u1) * r1;
                u32x4 w; w.x = cvt_pk_bf16(v0[0], v0[1]); w.y = cvt_pk_bf16(v0[2], v0[3]); w.z = cvt_pk_bf16(v1[0], v1[1]); w.w = cvt_pk_bf16(v1[2], v1[3]);
                PG8_LAS unsigned char* sl = eslot;
                *(PG8_LAS u32x4*)(sl + fr * 64 + fq * 16) = w;
                const u32x4 w2 = *(const PG8_LAS u32x4*)(sl + lane * 16);
                *(u32x4*)(O + (size_t)(rowb + ai * HALF + m * 16 + lr) * ldc + colb + lc) = w2; }
    }
};

template <class Epi, class Sched, bool STAMP = false>
__device__ __forceinline__ void gemm_phase(PG8_LAS unsigned char* lds, const Gemm g, const Sched& S, const Epi& E, unsigned long long* stamps) {
    const int tid = opaque_tid(), wid = __builtin_amdgcn_readfirstlane(tid >> 6), lane = tid & 63, wr = wid >> 2, wc = wid & 3, fr = lane & 15, fq = lane >> 4;
    const int K = g.K, nt = K / BK;
    int ts_lo = 0, ts_hi = 0, nts = 0; const unsigned long long rt_entry = STAMP ? (unsigned long long)wall_clock64() : 0ull;
#define PG8_STAMP() do { if (STAMP && wid == 0 && nts < 64) { const unsigned long long _c = (unsigned long long)clock64(); \
        ts_lo = (lane == nts) ? (int)(unsigned)_c : ts_lo; ts_hi = (lane == nts) ? (int)(unsigned)(_c >> 32) : ts_hi; ++nts; } } while (0)
    PG8_STAMP();
    unsigned voffA[2], voffB[2];
#pragma unroll
    for (int i = 0; i < 2; ++i) { int R, C; stage_rc(tid * 16 + i * 8192, R, C); const int Rb = Epi::PERM ? ((R & ~31) + perm32(R & 31)) : R;
        voffA[i] = (unsigned)(R * K + C) * 2u; voffB[i] = (unsigned)(Rb * K + C) * 2u; }
    const size_t kstep = (size_t)(BK * 2);
    const size_t hstep = (size_t)HALF * K * 2;
    const size_t tstep = 2 * hstep;
    const unsigned ldsw = (unsigned)wid * 1024u;
    const int aoff = lds_byte(wr * 64 + fr, fq * 8), boff = lds_byte(wc * 32 + fr, fq * 8);
#define PG8_SA(b, h) (((b) * 2 + (h)) * HTB)
#define PG8_SB(b, h) ((4 + (b) * 2 + (h)) * HTB)
#define PG8_STAGE(bufoff, gbase, voff) do { _Pragma("unroll") for (int _i = 0; _i < 2; ++_i) \
        __builtin_amdgcn_global_load_lds((const unsigned*)((const char*)(gbase) + (voff)[_i]), (PG8_LAS unsigned*)(lds + (bufoff) + ldsw + _i * 8192), 16, 0, 0); } while (0)
#define PG8_LDA(dst, b, h) do { _Pragma("unroll") for (int m = 0; m < 4; ++m) _Pragma("unroll") for (int k = 0; k < 2; ++k) dst[m][k] = *(const PG8_LAS bf16x8*)(lds + PG8_SA(b, h) + aoff + m * 2048 + k * 1024); } while (0)
#define PG8_LDB(dst, b, h) do { _Pragma("unroll") for (int n = 0; n < 2; ++n) _Pragma("unroll") for (int k = 0; k < 2; ++k) dst[n][k] = *(const PG8_LAS bf16x8*)(lds + PG8_SB(b, h) + boff + n * 2048 + k * 1024); } while (0)
#define PG8_MMA(ai, bj, At, Bt) do { __builtin_amdgcn_s_setprio(1); _Pragma("unroll") for (int m = 0; m < 4; ++m) _Pragma("unroll") for (int n = 0; n < 2; ++n) _Pragma("unroll") for (int k = 0; k < 2; ++k) \
        acc[ai][bj][m][n] = Epi::SWAP ? __builtin_amdgcn_mfma_f32_16x16x32_bf16(At[m][k], Bt[n][k], acc[ai][bj][m][n], 0, 0, 0) : __builtin_amdgcn_mfma_f32_16x16x32_bf16(Bt[n][k], At[m][k], acc[ai][bj][m][n], 0, 0, 0); __builtin_amdgcn_s_setprio(0); } while (0)
#define PG8_WAIT_V(n) asm volatile("s_waitcnt vmcnt(" #n ")" ::: "memory")
#define PG8_WAIT_L(n) asm volatile("s_waitcnt lgkmcnt(" #n ")" ::: "memory")
#define PG8_BAR __builtin_amdgcn_s_barrier()
#define PG8_SCHED __builtin_amdgcn_sched_barrier(0)
#define PG8_STAGE_RS(unit, buf) do { if (E.rs != nullptr && wid < 4) __builtin_amdgcn_global_load_lds((const unsigned*)(E.rs + (unit).pm * BM + wid * 64 + lane), (PG8_LAS unsigned*)(lds + RS_LDS_OFF + (buf) * 1024 + wid * 256), 4, 0, 0); } while (0)
    Unit cur, nxt; int ui = 0;
    if (!S.next(0, cur)) return;
    f32x4 acc[2][2][4][2];
#pragma unroll
    for (int a = 0; a < 2; ++a)
#pragma unroll
        for (int b = 0; b < 2; ++b)
#pragma unroll
            for (int m = 0; m < 4; ++m)
#pragma unroll
                for (int n = 0; n < 2; ++n) acc[a][b][m][n] = (f32x4){0.f, 0.f, 0.f, 0.f};
    bf16x8 At[4][2], B0[2][2], B1[2][2];
    const char* cA = (const char*)g.A + (size_t)cur.pm * tstep; const char* cB = (const char*)g.Bt + (size_t)cur.pn * tstep;
    S.a_ready(cur);
    PG8_STAGE_RS(cur, 0);
#if USE_SP2
    PG8_STAGE(PG8_SB(0, 0), cB, voffB); PG8_STAGE(PG8_SB(0, 1), cB + hstep, voffB); PG8_STAGE(PG8_SA(0, 0), cA, voffA); PG8_STAGE(PG8_SA(0, 1), cA + hstep, voffA);
    if (wr == 1) PG8_BAR;
    PG8_WAIT_V(2); PG8_BAR;
    PG8_STAGE(PG8_SB(1, 0), cB + kstep, voffB); PG8_STAGE(PG8_SA(1, 0), cA + kstep, voffA); PG8_STAGE(PG8_SB(1, 1), cB + hstep + kstep, voffB); PG8_STAGE(PG8_SA(1, 1), cA + hstep + kstep, voffA);
    PG8_WAIT_V(8); PG8_BAR;
#else
    PG8_STAGE(PG8_SB(0, 0), cB, voffB); PG8_STAGE(PG8_SA(0, 0), cA, voffA); PG8_STAGE(PG8_SB(0, 1), cB + hstep, voffB); PG8_STAGE(PG8_SA(0, 1), cA + hstep, voffA);
    if (wr == 1) PG8_BAR;
    PG8_WAIT_V(4); PG8_BAR;
    PG8_STAGE(PG8_SB(1, 0), cB + kstep, voffB); PG8_STAGE(PG8_SA(1, 0), cA + kstep, voffA); PG8_STAGE(PG8_SB(1, 1), cB + hstep + kstep, voffB); PG8_STAGE(PG8_SA(1, 1), cA + hstep + kstep, voffA);
    PG8_WAIT_V(8); PG8_BAR;
#endif
    PG8_STAMP();
    for (;;) {
        const bool has_next = S.next(ui + 1, nxt);
        const char* nA = has_next ? (const char*)g.A + (size_t)nxt.pm * tstep : cA; const char* nB = has_next ? (const char*)g.Bt + (size_t)nxt.pn * tstep : cB;
        for (int t = 0; t < nt; t += 2) {
            const bool last = (t == nt - 2);
            const char* a2 = last ? nA : cA + (size_t)(t + 2) * kstep; const char* b2 = last ? nB : cB + (size_t)(t + 2) * kstep;
            const char* a3 = a2 + kstep; const char* b3 = b2 + kstep;
            if (last && has_next) { S.a_ready(nxt); PG8_STAGE_RS(nxt, (ui + 1) & 1); }
#if USE_SP2
            const int relaxed = __builtin_amdgcn_readfirstlane((t == 0 && ui > 0) ? 1 : 0);
#define PG8_WAIT_V8R asm volatile("s_cmp_lg_u32 %0, 0\n\ts_cbranch_scc1 .Lpg8rlx%=\n\ts_waitcnt vmcnt(8)\n\ts_branch .Lpg8end%=\n.Lpg8rlx%=:\n\ts_waitcnt vmcnt(%1)\n.Lpg8end%=:" :: "s"(relaxed), "n"(8 + Epi::NSTORES) : "memory", "scc")
            PG8_LDB(B0, 0, 0); PG8_LDB(B1, 0, 1); PG8_SCHED; PG8_LDA(At, 0, 0);
            PG8_WAIT_V8R; PG8_WAIT_L(0); PG8_BAR; PG8_MMA(0, 0, At, B0); PG8_MMA(0, 1, At, B1); PG8_BAR; PG8_SCHED;
            PG8_LDA(At, 0, 1); PG8_STAGE(PG8_SB(0, 0), b2, voffB); PG8_STAGE(PG8_SB(0, 1), b2 + hstep, voffB); PG8_STAGE(PG8_SA(0, 0), a2, voffA);
            PG8_WAIT_V8R; PG8_WAIT_L(0); PG8_BAR; PG8_MMA(1, 0, At, B0); PG8_MMA(1, 1, At, B1); PG8_BAR; PG8_SCHED;
            PG8_LDB(B0, 1, 0); PG8_LDB(B1, 1, 1); PG8_SCHED; PG8_LDA(At, 1, 0); PG8_STAGE(PG8_SA(0, 1), a2 + hstep, voffA);
            PG8_WAIT_V8R; PG8_WAIT_L(0); PG8_BAR; PG8_MMA(0, 0, At, B0); PG8_MMA(0, 1, At, B1); PG8_BAR; PG8_SCHED;
            PG8_LDA(At, 1, 1); PG8_STAGE(PG8_SB(1, 0), b3, voffB); PG8_STAGE(PG8_SB(1, 1), b3 + hstep, voffB); PG8_STAGE(PG8_SA(1, 0), a3, voffA);
            PG8_WAIT_V(8); PG8_WAIT_L(0); PG8_BAR; PG8_MMA(1, 0, At, B0); PG8_MMA(1, 1, At, B1); PG8_BAR; PG8_SCHED;
            PG8_STAGE(PG8_SA(1, 1), a3 + hstep, voffA);
#undef PG8_WAIT_V8R
#else
            PG8_LDB(B0, 0, 0); PG8_SCHED; PG8_LDA(At, 0, 0);
            PG8_WAIT_L(8); PG8_BAR; PG8_WAIT_L(0); PG8_MMA(0, 0, At, B0); PG8_BAR; PG8_SCHED;
            PG8_LDB(B1, 0, 1); PG8_STAGE(PG8_SB(0, 0), b2, voffB);
            PG8_BAR; PG8_WAIT_L(0); PG8_MMA(0, 1, At, B1); PG8_BAR;
            PG8_LDA(At, 0, 1); PG8_STAGE(PG8_SA(0, 0), a2, voffA);
            PG8_BAR; PG8_WAIT_L(0); PG8_MMA(1, 0, At, B0); PG8_BAR; PG8_SCHED;
            PG8_STAGE(PG8_SB(0, 1), b2 + hstep, voffB);
            { const int relaxed = __builtin_amdgcn_readfirstlane((t == 0 && ui > 0) ? 1 : 0);
              asm volatile("s_cmp_lg_u32 %0, 0\n\ts_cbranch_scc1 .Lpg8rlx%=\n\ts_waitcnt vmcnt(6)\n\ts_branch .Lpg8end%=\n.Lpg8rlx%=:\n\ts_waitcnt vmcnt(%1)\n.Lpg8end%=:" :: "s"(relaxed), "n"(6 + Epi::NSTORES) : "memory", "scc"); }
            PG8_BAR; PG8_MMA(1, 1, At, B1); PG8_BAR;
            PG8_LDB(B0, 1, 0); PG8_SCHED; PG8_LDA(At, 1, 0); PG8_STAGE(PG8_SA(0, 1), a2 + hstep, voffA);
            PG8_WAIT_L(8); PG8_BAR; PG8_WAIT_L(0); PG8_MMA(0, 0, At, B0); PG8_BAR; PG8_SCHED;
            PG8_LDB(B1, 1, 1); PG8_STAGE(PG8_SB(1, 0), b3, voffB);
            PG8_BAR; PG8_WAIT_L(0); PG8_MMA(0, 1, At, B1); PG8_BAR;
            PG8_LDA(At, 1, 1); PG8_STAGE(PG8_SA(1, 0), a3, voffA);
            PG8_BAR; PG8_WAIT_L(0); PG8_MMA(1, 0, At, B0); PG8_BAR; PG8_SCHED;
            PG8_STAGE(PG8_SB(1, 1), b3 + hstep, voffB);
            PG8_WAIT_V(6); PG8_BAR; PG8_MMA(1, 1, At, B1); PG8_BAR;
            PG8_STAGE(PG8_SA(1, 1), a3 + hstep, voffA);
#endif
        }
        PG8_STAMP();
#if ALIGN_EPI
        if (wr == 0) PG8_BAR;
#endif
        if constexpr (!Epi::AFTER_DRAIN) { E(acc, cur, wr, wc, fr, fq, (const PG8_LAS float*)(lds + RS_LDS_OFF + (ui & 1) * 1024), lds + EPI_LDS_OFF + wid * EPI_LDS_WAVE); S.done(cur); }
        PG8_STAMP();
        if (!has_next) break;
#pragma unroll
        for (int a = 0; a < 2; ++a)
#pragma unroll
            for (int b = 0; b < 2; ++b)
#pragma unroll
                for (int m = 0; m < 4; ++m)
#pragma unroll
                    for (int n = 0; n < 2; ++n) acc[a][b][m][n] = (f32x4){0.f, 0.f, 0.f, 0.f};
        cur = nxt; cA = nA; cB = nB; ++ui;
#if ALIGN_EPI
        if (wr == 1) PG8_BAR;
#endif
    }
    PG8_WAIT_V(0);
#if !ALIGN_EPI
    if (wr == 0) PG8_BAR;
#endif
    PG8_BAR;
    if constexpr (Epi::AFTER_DRAIN) { E.fused(acc, cur, wr, wc, fr, fq, lds, wid, lane); S.done(cur); }
    PG8_STAMP();
    if (STAMP && wid == 0) { stamps[lane] = lane < nts ? (((unsigned long long)(unsigned)ts_hi << 32) | (unsigned)ts_lo) : 0ull;
        if (lane == 62) stamps[62] = rt_entry; if (lane == 63) stamps[63] = (unsigned long long)wall_clock64(); }
#undef PG8_STAMP
#undef PG8_SA
#undef PG8_SB
#undef PG8_STAGE
#undef PG8_LDA
#undef PG8_LDB
#undef PG8_MMA
#undef PG8_WAIT_V
#undef PG8_WAIT_L
#undef PG8_BAR
#undef PG8_SCHED
#undef PG8_STAGE_RS
}
}

#define LAS PG8_LAS
typedef unsigned short u16;
typedef unsigned char uchar;
using pg8::bf16x8; using pg8::f32x4; using pg8::u32x4; using pg8::cvt_pk_bf16;
typedef float f32x16 __attribute__((ext_vector_type(16)));
typedef unsigned u32x2 __attribute__((ext_vector_type(2)));
typedef int i32x4 __attribute__((ext_vector_type(4)));

constexpr int T_ = 65536, DM = 1024, SEQ = 2048, NB = 32, DFF = 2816, NTHR = 512;
constexpr int LDS_ST_OFF = 155648;
constexpr int LDS_BYTES = LDS_ST_OFF + 16;
constexpr size_t SZ_ABIN = 2ull * 2560 * 1024 * 2, SZ_ABOUT = 2ull * 1024 * 1024 * 2, SZ_CDIN = 2ull * 2048 * 1024 * 2, SZ_CDOUT = 2ull * 1024 * 1024 * 2,
                 SZ_GU = 4ull * 5632 * 1024 * 2, SZ_DOWN = 4ull * 1024 * 2816 * 2, SZ_G = 2ull * 2 * 512 * 4096 * 2;
constexpr size_t WS_ABIN = 0, WS_ABOUT = WS_ABIN + SZ_ABIN, WS_CDIN = WS_ABOUT + SZ_ABOUT, WS_CDOUT = WS_CDIN + SZ_CDIN, WS_GU = WS_CDOUT + SZ_CDOUT, WS_DOWN = WS_GU + SZ_GU,
                 WS_G = WS_DOWN + SZ_DOWN,
                 WS_H = WS_G + SZ_G,
                 WS_B = WS_H + (size_t)T_ * 1024 * 2,
                 WS_C = WS_B + (size_t)T_ * 2560 * 2,
                 WS_D = WS_C + (size_t)1536 * 32 * 2048 * 2,
                 WS_E = WS_D + (size_t)T_ * 1024 * 2,
                 WS_BAR = WS_E + (size_t)T_ * 1024 * 2,
                 WS_RSTD = WS_BAR + 16384,
                 WS_END = WS_RSTD + (size_t)T_ * 4;
static_assert(WS_END <= (1ull << 30), "workspace map exceeds 1 GiB");
static_assert((size_t)T_ * DFF * 2 <= WS_D - WS_B, "act does not fit B + C");

__device__ __forceinline__ float bflo(unsigned w) { return __uint_as_float(w << 16); }
__device__ __forceinline__ float bfhi(unsigned w) { return __uint_as_float(w & 0xffff0000u); }
__device__ __forceinline__ float bf2f(u16 v) { return __uint_as_float(((unsigned)v) << 16); }
__device__ __forceinline__ u16 f2bf(float f) { return (u16)(cvt_pk_bf16(f, 0.f) & 0xffffu); }
__device__ __forceinline__ float wave_sum(float v) {
#pragma unroll
    for (int o = 32; o >= 1; o >>= 1) v += __shfl_xor(v, o, 64);
    return v;
}

__device__ void wt_job(LAS uchar* lds, const float* __restrict__ W, int ldw, int K, int N, u16* __restrict__ out, int ldo, int mode, const float* __restrict__ gain, int& rot) {
    LAS float* tile = (LAS float*)lds;
    const int tid = opaque_tid(); const int nkq = K / 256, nnt = N / 64, nsteps = nkq * nnt;
    const int G = (int)gridDim.x; const int first = ((int)blockIdx.x + G - (rot % G)) % G; rot += nsteps;
    for (int ti = first; ti < nsteps; ti += G) {
        const int kq = ti % nkq, nt = ti / nkq; const int k0 = kq * 256, n0 = nt * 64;
        int sc0 = n0; if (mode == 1) { const int pn = n0 >> 8, r = n0 & 255; sc0 = (r < 128) ? (pn * 128 + r) : (DFF + pn * 128 + (r - 128)); }
        float4 v[8];
#pragma unroll
        for (int i = 0; i < 8; ++i) { const int idx = tid + i * 512; const int kk = idx >> 4, c4 = (idx & 15) * 4;
            v[i] = *(const float4*)(W + (size_t)(k0 + kk) * ldw + sc0 + c4); }
#pragma unroll
        for (int i = 0; i < 8; ++i) { const int idx = tid + i * 512; const int kk = idx >> 4, c4 = (idx & 15) * 4;
            const float gk = gain ? gain[k0 + kk] : 1.0f;
            tile[kk * 65 + c4 + 0] = v[i].x * gk; tile[kk * 65 + c4 + 1] = v[i].y * gk; tile[kk * 65 + c4 + 2] = v[i].z * gk; tile[kk * 65 + c4 + 3] = v[i].w * gk; }
        __syncthreads();
#pragma unroll
        for (int q = 0; q < 4; ++q) { const int nn = tid >> 3, kc = q * 64 + (tid & 7) * 8;
          float f0 = tile[(kc + 0) * 65 + nn], f1 = tile[(kc + 1) * 65 + nn], f2 = tile[(kc + 2) * 65 + nn], f3 = tile[(kc + 3) * 65 + nn];
          float f4 = tile[(kc + 4) * 65 + nn], f5 = tile[(kc + 5) * 65 + nn], f6 = tile[(kc + 6) * 65 + nn], f7 = tile[(kc + 7) * 65 + nn];
          u32x4 w; w.x = cvt_pk_bf16(f0, f1); w.y = cvt_pk_bf16(f2, f3); w.z = cvt_pk_bf16(f4, f5); w.w = cvt_pk_bf16(f6, f7);
          *(u32x4*)(out + (size_t)(n0 + nn) * ldo + k0 + kc) = w; }
        __syncthreads();
    }
}
__device__ void fold_job(const float* __restrict__ cw, const float* __restrict__ scale, const float* __restrict__ Wout, u16* __restrict__ out) {
    for (int idx = blockIdx.x * NTHR + opaque_tid(); idx < 512 * 256; idx += gridDim.x * NTHR) {
        const int k = idx >> 8, n0 = (idx & 255) * 4; const int g = k >> 7;
        const float* cwr = cw + (size_t)k * 128; const float* sc = scale + g * 128; const float* wr = Wout + (size_t)(g * 128) * 1024 + n0;
        float a0 = 0.f, a1 = 0.f, a2 = 0.f, a3 = 0.f;
#pragma unroll 16
        for (int c2 = 0; c2 < 128; ++c2) { const float cf = cwr[c2] * sc[c2]; const float4 w0 = *(const float4*)(wr + (size_t)c2 * 1024);
            a0 += cf * w0.x; a1 += cf * w0.y; a2 += cf * w0.z; a3 += cf * w0.w; }
        out[(size_t)(n0 + 0) * 1024 + k] = f2bf(a0); out[(size_t)(n0 + 1) * 1024 + k] = f2bf(a1); out[(size_t)(n0 + 2) * 1024 + k] = f2bf(a2); out[(size_t)(n0 + 3) * 1024 + k] = f2bf(a3);
    }
}
__device__ __forceinline__ void filter_job(LAS uchar* lds, const float* __restrict__ w1a, const float* __restrict__ b1a, const float* __restrict__ freqa, const float* __restrict__ w2a,
                           const float* __restrict__ b2a, const float* __restrict__ w3a, const float* __restrict__ decaya, u16* __restrict__ Gall) {
    LAS float* h2 = (LAS float*)lds;
    LAS float* zf = h2 + 64 * 64;
    LAS float* h1 = zf + 64 * 33;
    LAS float* w3s = h2 + 64 * 64;
    const int tid = opaque_tid(), lane = tid & 63, wave = __builtin_amdgcn_readfirstlane(tid >> 6);
    for (int item = blockIdx.x; item < 256; item += gridDim.x) {
        const int j = item >> 7, tg = (item >> 2) & 31, cq = item & 3, t0 = tg * 64;
        const float* w1 = w1a + j * 33 * 64; const float* b1 = b1a + j * 64; const float* freq = freqa + j * 128; const float* w2 = w2a + j * 4096; const float* b2 = b2a + j * 64;
        const float* w3 = w3a + (size_t)j * 64 * 2048; const float* decay = decaya + j * 2048; u16* Gj = Gall + (size_t)j * 2 * 512 * 4096;
        float4 wpre[16];
#pragma unroll
        for (int i = 0; i < 16; ++i) { const int idx = tid + i * NTHR; wpre[i] = *(const float4*)(w3 + (size_t)(idx >> 7) * 2048 + cq * 512 + (idx & 127) * 4); }
        for (int idx = tid; idx < 64 * 33; idx += NTHR) { const int tt = idx / 33, f = idx - tt * 33; const float t = (float)(t0 + tt);
            float val;
            if (f == 0) val = t / 2047.0f;
            else { const int fi = (f - 1) & 15; const float band = 1e-4f + (float)fi * ((15.0f - 1e-4f) / 15.0f); const float w = 6.283185307179586f * t / 2048.0f; const float fw = w * band;
                   val = (f <= 16) ? cosf(fw) : -sinf(fw); }
            zf[idx] = val; }
        __syncthreads();
        for (int idx = tid; idx < 4096; idx += NTHR) { const int tt = idx >> 6, k = idx & 63; float acc = 0.f;
            for (int f = 0; f < 33; ++f) acc += zf[tt * 33 + f] * w1[f * 64 + k];
            h1[tt * 64 + k] = sinf(freq[k] * (acc + b1[k])); }
        __syncthreads();
        for (int idx = tid; idx < 4096; idx += NTHR) { const int tt = idx >> 6, k = idx & 63; float acc = 0.f;
            for (int k2 = 0; k2 < 64; ++k2) acc += h1[tt * 64 + k2] * w2[k2 * 64 + k];
            h2[k * 64 + tt] = sinf(freq[64 + k] * (acc + b2[k])); }
        __syncthreads();
#pragma unroll
        for (int i = 0; i < 16; ++i) { const int idx = tid + i * NTHR; f32x4 wv; wv.x = wpre[i].x; wv.y = wpre[i].y; wv.z = wpre[i].z; wv.w = wpre[i].w; *(LAS f32x4*)(w3s + (idx >> 7) * 512 + (idx & 127) * 4) = wv; }
        __syncthreads();
        { const int t = t0 + lane; const float t01 = (float)t / 2047.0f;
          for (int ci = 0; ci < 64; ci += 4) { const int cl = wave * 64 + ci, col = cq * 512 + cl; float a0 = 0.f, a1 = 0.f, a2 = 0.f, a3 = 0.f;
#pragma unroll 16
              for (int k = 0; k < 64; ++k) { const f32x4 w = *(const LAS f32x4*)(w3s + k * 512 + cl); const float hv = h2[k * 64 + lane]; a0 += hv * w.x; a1 += hv * w.y; a2 += hv * w.z; a3 += hv * w.w; }
              const float4 dc = *(const float4*)(decay + col);
              a0 *= expf(-t01 * fabsf(dc.x)); a1 *= expf(-t01 * fabsf(dc.y)); a2 *= expf(-t01 * fabsf(dc.z)); a3 *= expf(-t01 * fabsf(dc.w));
              const int dir = col >> 10, o = (col >> 9) & 1, c = col & 511; u16* g = Gj + (size_t)(o * 512 + c) * 4096;
              if (dir == 0) { g[2048 - t] = f2bf(a0); g[4096 + 2048 - t] = f2bf(a1); g[8192 + 2048 - t] = f2bf(a2); g[12288 + 2048 - t] = f2bf(a3);
                              if (t == 0) { g[0] = 0; g[4096] = 0; g[8192] = 0; g[12288] = 0; } }
              else if (t <= 2046) { g[2049 + t] = f2bf(a0); g[4096 + 2049 + t] = f2bf(a1); g[8192 + 2049 + t] = f2bf(a2); g[12288 + 2049 + t] = f2bf(a3); } } }
        __syncthreads();
    }
}

__device__ __forceinline__ void unpack8(const u32x4 v, float (&f)[8]) { f[0] = bflo(v.x); f[1] = bfhi(v.x); f[2] = bflo(v.y); f[3] = bfhi(v.y); f[4] = bflo(v.z); f[5] = bfhi(v.z); f[6] = bflo(v.w); f[7] = bfhi(v.w); }
__device__ __forceinline__ float4 ntload4(const float* p) { const f32x4 v = __builtin_nontemporal_load((const f32x4*)p); float4 r; r.x = v.x; r.y = v.y; r.z = v.z; r.w = v.w; return r; }
__device__ __forceinline__ void ntstore4(float* p, float a, float b, float c, float d) { f32x4 w; w.x = a; w.y = b; w.z = c; w.w = d; __builtin_nontemporal_store(w, (f32x4*)p); }
__device__ __forceinline__ void resid_pass(const float* __restrict__ xin_f, u16* __restrict__ xb, const u16* __restrict__ mix, const float* __restrict__ gpost, float* __restrict__ rstd_out, float* __restrict__ out_f) {
    const int tid = opaque_tid(); const int lane = tid & 63, wave = tid >> 6;
    const int stride = gridDim.x * 8;
    constexpr int NR = 4;
    for (int row0 = blockIdx.x * 8 + wave; row0 < T_; row0 += NR * stride) {
        float x[NR][16];
        if (xin_f) {
#pragma unroll
            for (int k = 0; k < NR; ++k) { const int row = min(row0 + k * stride, T_ - 1);
#pragma unroll
                for (int c = 0; c < 2; ++c) { const float4 a0 = ntload4(xin_f + (size_t)row * 1024 + c * 512 + lane * 8), a1 = ntload4(xin_f + (size_t)row * 1024 + c * 512 + lane * 8 + 4);
                    x[k][c * 8 + 0] = a0.x; x[k][c * 8 + 1] = a0.y; x[k][c * 8 + 2] = a0.z; x[k][c * 8 + 3] = a0.w; x[k][c * 8 + 4] = a1.x; x[k][c * 8 + 5] = a1.y; x[k][c * 8 + 6] = a1.z; x[k][c * 8 + 7] = a1.w; } }
        } else {
            u32x4 xr[NR][2], mr[NR][2];
#pragma unroll
            for (int k = 0; k < NR; ++k) { const int row = min(row0 + k * stride, T_ - 1);
#pragma unroll
                for (int c = 0; c < 2; ++c) { xr[k][c] = *(const u32x4*)(xb + (size_t)row * 1024 + c * 512 + lane * 8); mr[k][c] = __builtin_nontemporal_load((const u32x4*)(mix + (size_t)row * 1024 + c * 512 + lane * 8)); } }
            float g[16];
#pragma unroll
            for (int c = 0; c < 2; ++c) { const float4 a0 = *(const float4*)(gpost + c * 512 + lane * 8), a1 = *(const float4*)(gpost + c * 512 + lane * 8 + 4);
                g[c * 8 + 0] = a0.x; g[c * 8 + 1] = a0.y; g[c * 8 + 2] = a0.z; g[c * 8 + 3] = a0.w; g[c * 8 + 4] = a1.x; g[c * 8 + 5] = a1.y; g[c * 8 + 6] = a1.z; g[c * 8 + 7] = a1.w; }
#pragma unroll
            for (int k = 0; k < NR; ++k) { float m[16]; float ss = 0.f;
#pragma unroll
                for (int c = 0; c < 2; ++c) { float t8[8]; unpack8(mr[k][c], t8);
#pragma unroll
                    for (int e = 0; e < 8; ++e) { m[c * 8 + e] = t8[e]; ss += t8[e] * t8[e]; } }
                ss = wave_sum(ss); const float rstd = rsqrtf(ss * (1.0f / 1024.0f) + 1e-6f);
#pragma unroll
                for (int c = 0; c < 2; ++c) { float t8[8]; unpack8(xr[k][c], t8);
#pragma unroll
                    for (int e = 0; e < 8; ++e) x[k][c * 8 + e] = t8[e] + m[c * 8 + e] * rstd * g[c * 8 + e]; } }
        }
#pragma unroll
        for (int k = 0; k < NR; ++k) { const int row = row0 + k * stride;
            if (row < T_) {
                if (out_f) {
#pragma unroll
                    for (int c = 0; c < 2; ++c) { ntstore4(out_f + (size_t)row * 1024 + c * 512 + lane * 8, x[k][c * 8 + 0], x[k][c * 8 + 1], x[k][c * 8 + 2], x[k][c * 8 + 3]);
                        ntstore4(out_f + (size_t)row * 1024 + c * 512 + lane * 8 + 4, x[k][c * 8 + 4], x[k][c * 8 + 5], x[k][c * 8 + 6], x[k][c * 8 + 7]); }
                } else {
                    float ss = 0.f;
#pragma unroll
                    for (int e = 0; e < 16; ++e) ss += x[k][e] * x[k][e];
                    ss = wave_sum(ss);
                    if (lane == 0) rstd_out[row] = rsqrtf(ss * (1.0f / 1024.0f) + 1e-6f);
#pragma unroll
                    for (int c = 0; c < 2; ++c) { u32x4 w; w.x = cvt_pk_bf16(x[k][c * 8 + 0], x[k][c * 8 + 1]); w.y = cvt_pk_bf16(x[k][c * 8 + 2], x[k][c * 8 + 3]); w.z = cvt_pk_bf16(x[k][c * 8 + 4], x[k][c * 8 + 5]); w.w = cvt_pk_bf16(x[k][c * 8 + 6], x[k][c * 8 + 7]);
                        *(u32x4*)(xb + (size_t)row * 1024 + c * 512 + lane * 8) = w; }
                }
            }
        }
    }
}

constexpr int TRS = 66;
__device__ __forceinline__ void tr_tile8(LAS u16* tiles  , const u16* __restrict__ src, size_t lds_src, size_t src_ts, u16* __restrict__ dst, size_t ldd, size_t dst_ts) {
    const int tid = opaque_tid(), r = tid >> 3, ch = (tid & 7) * 8;
    u32x4 v[8];
#pragma unroll
    for (int k = 0; k < 8; ++k) v[k] = *(const u32x4*)(src + k * src_ts + (size_t)r * lds_src + ch);
#pragma unroll
    for (int k = 0; k < 8; ++k) { LAS u16* tile = tiles + k * 64 * TRS;
        tile[(ch + 0) * TRS + r] = (u16)(v[k].x & 0xffffu); tile[(ch + 1) * TRS + r] = (u16)(v[k].x >> 16);
        tile[(ch + 2) * TRS + r] = (u16)(v[k].y & 0xffffu); tile[(ch + 3) * TRS + r] = (u16)(v[k].y >> 16);
        tile[(ch + 4) * TRS + r] = (u16)(v[k].z & 0xffffu); tile[(ch + 5) * TRS + r] = (u16)(v[k].z >> 16);
        tile[(ch + 6) * TRS + r] = (u16)(v[k].w & 0xffffu); tile[(ch + 7) * TRS + r] = (u16)(v[k].w >> 16); }
    __syncthreads();
#pragma unroll
    for (int k = 0; k < 8; ++k) { const LAS unsigned* p = (const LAS unsigned*)(tiles + k * 64 * TRS + r * TRS + ch);
        u32x4 o; o.x = p[0]; o.y = p[1]; o.z = p[2]; o.w = p[3];
        *(u32x4*)(dst + k * dst_ts + (size_t)r * ldd + ch) = o; }
    __syncthreads();
}
__device__ void transpose_fwd_phase(LAS uchar* lds, const u16* __restrict__ proj, u16* __restrict__ pT) {
    LAS u16* tiles = (LAS u16*)lds;
    for (int it = blockIdx.x; it < NB * 32 * 3; it += gridDim.x) {
        const int c8 = it % 3, st = (it / 3) & 31, b = it / 96;
        tr_tile8(tiles, proj + (size_t)(b * SEQ + st * 64) * 2560 + 1024 + c8 * 512, 2560, 64, pT + ((size_t)(c8 * 512) * NB + b) * SEQ + st * 64, (size_t)NB * SEQ, (size_t)64 * NB * SEQ);
    }
}
__device__ void transpose_back_phase(LAS uchar* lds, const u16* __restrict__ yT, u16* __restrict__ ycat) {
    LAS u16* tiles = (LAS u16*)lds;
    for (int it = blockIdx.x; it < NB * 32; it += gridDim.x) {
        const int st = it & 31, b = it >> 5;
        tr_tile8(tiles, yT + (size_t)b * SEQ + st * 64, (size_t)NB * SEQ, (size_t)64 * NB * SEQ, ycat + (size_t)(b * SEQ + st * 64) * 1024 + 512, 1024, 64);
    }
}
__device__ void gating_phase(LAS uchar* lds, const u16* __restrict__ proj  , const float* __restrict__ ln_g  ,
                             const float* __restrict__ w_s  , const float* __restrict__ b_s  , u16* __restrict__ ycat  ) {
    LAS u16* vT = (LAS u16*)lds;
    LAS u16* wsb = vT + 128 * 136;
    LAS float* stats = (LAS float*)(wsb + 128 * 136);
    const int tid = opaque_tid(), lane = tid & 63, wave = tid >> 6, fr = lane & 15, fq = lane >> 4;
    for (int item = blockIdx.x; item < T_ / 128; item += gridDim.x) {
        const int tok0 = item * 128;
        { u32x4 vv[16];
#pragma unroll
          for (int tt = 0; tt < 16; ++tt) vv[tt] = *(const u32x4*)(proj + (size_t)(tok0 + wave * 16 + tt) * 1024 + 512 + lane * 8);
#pragma unroll
          for (int tt = 0; tt < 16; ++tt) { const int q = wave * 16 + tt; const u32x4 v = vv[tt];
            const float f0 = bflo(v.x), f1 = bfhi(v.x), f2 = bflo(v.y), f3 = bfhi(v.y), f4 = bflo(v.z), f5 = bfhi(v.z), f6 = bflo(v.w), f7 = bfhi(v.w);
            const float mean = wave_sum(f0 + f1 + f2 + f3 + f4 + f5 + f6 + f7) * (1.0f / 512.0f);
            const float d0 = f0 - mean, d1 = f1 - mean, d2 = f2 - mean, d3 = f3 - mean, d4 = f4 - mean, d5 = f5 - mean, d6 = f6 - mean, d7 = f7 - mean;
            const float var = wave_sum(d0 * d0 + d1 * d1 + d2 * d2 + d3 * d3 + d4 * d4 + d5 * d5 + d6 * d6 + d7 * d7) * (1.0f / 512.0f);
            if (lane == 0) { stats[q * 2] = mean; stats[q * 2 + 1] = rsqrtf(var + 1e-5f); } } }
        __syncthreads();
        u32x4 vreg[4]; float4 wreg[8];
#define GATE_LOAD(g) do { _Pragma("unroll") for (int i = 0; i < 4; ++i) { const int idx = tid + i * NTHR; vreg[i] = *(const u32x4*)(proj + (size_t)(tok0 + (idx >> 4)) * 1024 + 512 + (g) * 128 + (idx & 15) * 8); } \
                          _Pragma("unroll") for (int i = 0; i < 8; ++i) { const int idx = tid + i * NTHR; wreg[i] = *(const float4*)(w_s + (size_t)((g) * 128 + (idx >> 5)) * 128 + (idx & 31) * 4); } } while (0)
        GATE_LOAD(0);
#pragma unroll
        for (int g = 0; g < 4; ++g) {
#pragma unroll
            for (int i = 0; i < 4; ++i) { const int idx = tid + i * NTHR; const int q = idx >> 4, c0 = (idx & 15) * 8;
                const u32x4 v = vreg[i];
                const float mean = stats[q * 2], rstd = stats[q * 2 + 1];
                const float4 g0 = *(const float4*)(ln_g + g * 128 + c0), g1 = *(const float4*)(ln_g + g * 128 + c0 + 4);
                vT[(c0 + 0) * 136 + q] = f2bf((bflo(v.x) - mean) * rstd * g0.x); vT[(c0 + 1) * 136 + q] = f2bf((bfhi(v.x) - mean) * rstd * g0.y);
                vT[(c0 + 2) * 136 + q] = f2bf((bflo(v.y) - mean) * rstd * g0.z); vT[(c0 + 3) * 136 + q] = f2bf((bfhi(v.y) - mean) * rstd * g0.w);
                vT[(c0 + 4) * 136 + q] = f2bf((bflo(v.z) - mean) * rstd * g1.x); vT[(c0 + 5) * 136 + q] = f2bf((bfhi(v.z) - mean) * rstd * g1.y);
                vT[(c0 + 6) * 136 + q] = f2bf((bflo(v.w) - mean) * rstd * g1.z); vT[(c0 + 7) * 136 + q] = f2bf((bfhi(v.w) - mean) * rstd * g1.w); }
#pragma unroll
            for (int i = 0; i < 8; ++i) { const int idx = tid + i * NTHR; const int p = idx >> 5, q0 = (idx & 31) * 4;
                const float4 w = wreg[i];
                u32x2 o; o.x = cvt_pk_bf16(w.x, w.y); o.y = cvt_pk_bf16(w.z, w.w);
                *(LAS u32x2*)(wsb + p * 136 + q0) = o; }
            __syncthreads();
            if (g < 3) GATE_LOAD(g + 1);
            const int p = 16 * wave + fr; const size_t tok = (size_t)(tok0 + p); const float bias = b_s[g * 128 + p];
            u32x2 uu[8];
#pragma unroll
            for (int mi = 0; mi < 8; ++mi) uu[mi] = *(const u32x2*)(proj + tok * 1024 + g * 128 + 16 * mi + 4 * fq);
            f32x4 acc[8];
#pragma unroll
            for (int mi = 0; mi < 8; ++mi) acc[mi] = (f32x4){0.f, 0.f, 0.f, 0.f};
#pragma unroll
            for (int kk = 0; kk < 4; ++kk) {
                const bf16x8 bfrag = *(const LAS bf16x8*)(wsb + (16 * wave + fr) * 136 + 32 * kk + 8 * fq);
#pragma unroll
                for (int mi = 0; mi < 8; ++mi) { const bf16x8 afrag = *(const LAS bf16x8*)(vT + (16 * mi + fr) * 136 + 32 * kk + 8 * fq);
                    acc[mi] = __builtin_amdgcn_mfma_f32_16x16x32_bf16(afrag, bfrag, acc[mi], 0, 0, 0); }
            }
#pragma unroll
            for (int mi = 0; mi < 8; ++mi) { const int c = 16 * mi + 4 * fq;
                u32x2 o; o.x = cvt_pk_bf16(bflo(uu[mi].x) * (acc[mi][0] + bias), bfhi(uu[mi].x) * (acc[mi][1] + bias)); o.y = cvt_pk_bf16(bflo(uu[mi].y) * (acc[mi][2] + bias), bfhi(uu[mi].y) * (acc[mi][3] + bias));
                *(u32x2*)(ycat + tok * 1024 + g * 128 + c) = o; }
            __syncthreads();
        }
#undef GATE_LOAD
    }
}

constexpr int HZ_ROW = 4112;
constexpr int HZ_KR0 = NB * HZ_ROW;
constexpr int HZ_KRC = 8208;
static_assert(HZ_KR0 + 2 * HZ_KRC <= LDS_ST_OFF, "hyena LDS");

__device__ __forceinline__ void hy_load_kr(LAS uchar* lds, const u16* __restrict__ g) {
    const int tid = opaque_tid();
    const u32x4 w = *(const u32x4*)(g + tid * 8);
    const unsigned nxt = (tid < 511) ? (unsigned)g[tid * 8 + 8] : 0u;
    *(LAS u32x4*)(lds + HZ_KR0 + tid * 16) = w;
    u32x4 s; s.x = (w.x >> 16) | (w.y << 16); s.y = (w.y >> 16) | (w.z << 16); s.z = (w.z >> 16) | (w.w << 16); s.w = (w.w >> 16) | (nxt << 16);
    *(LAS u32x4*)(lds + HZ_KR0 + HZ_KRC + tid * 16) = s;
}
__device__ __forceinline__ void conv3_8(const u16* __restrict__ p, int s0, float w0, float w1, float w2, float (&o)[8]) {
    const u32x4 v = *(const u32x4*)(p + s0);
    const float prev = (s0 > 0) ? bf2f(p[s0 - 1]) : 0.f, next = (s0 + 8 < SEQ) ? bf2f(p[s0 + 8]) : 0.f;
    const float x0 = bflo(v.x), x1 = bfhi(v.x), x2 = bflo(v.y), x3 = bfhi(v.y), x4 = bflo(v.z), x5 = bfhi(v.z), x6 = bflo(v.w), x7 = bfhi(v.w);
    o[0] = w0 * prev + w1 * x0 + w2 * x1; o[1] = w0 * x0 + w1 * x1 + w2 * x2; o[2] = w0 * x1 + w1 * x2 + w2 * x3; o[3] = w0 * x2 + w1 * x3 + w2 * x4;
    o[4] = w0 * x3 + w1 * x4 + w2 * x5; o[5] = w0 * x4 + w1 * x5 + w2 * x6; o[6] = w0 * x5 + w1 * x6 + w2 * x7; o[7] = w0 * x6 + w1 * x7 + w2 * next;
}
__device__ void hyena_phase(LAS uchar* lds, const u16* __restrict__ pT  , const u16* __restrict__ G  , const float* __restrict__ conv_w  ,
                            const float* __restrict__ skip  , u16* __restrict__ yT  ) {
    const int tid = opaque_tid(), lane = tid & 63, wave = __builtin_amdgcn_readfirstlane(tid >> 6), r = lane & 31, h = lane >> 5;
    const int tbase = 256 * wave;
    const int e0 = 8 * h - r + 2048 - tbase, par = e0 & 1;
    const LAS uchar* abase = lds + HZ_KR0 + par * HZ_KRC + (e0 - par) * 2;
    const LAS uchar* bbase = lds + r * HZ_ROW + 16 * h;
    for (int c = blockIdx.x; c < 512; c += gridDim.x) {
        {
            const u16* src = pT + (size_t)c * NB * SEQ; const float w0 = conv_w[c], w1 = conv_w[1536 + c], w2 = conv_w[3072 + c];
#pragma unroll
            for (int it = 0; it < 16; ++it) { const int idx = tid + it * NTHR; const int b = idx >> 8, s0 = (idx & 255) * 8; float o[8];
                conv3_8(src + (size_t)b * SEQ, s0, w0, w1, w2, o);
                u32x4 w; w.x = cvt_pk_bf16(o[0], o[1]); w.y = cvt_pk_bf16(o[2], o[3]); w.z = cvt_pk_bf16(o[4], o[5]); w.w = cvt_pk_bf16(o[6], o[7]);
                *(LAS u32x4*)(lds + b * HZ_ROW + s0 * 2) = w; }
            hy_load_kr(lds, G + (size_t)c * 4096);
        }
        __syncthreads();
#pragma unroll 1
        for (int o = 0; o < 2; ++o) {
            f32x16 acc[8];
#pragma unroll
            for (int i = 0; i < 8; ++i)
#pragma unroll
                for (int k = 0; k < 16; ++k) acc[i][k] = 0.f;
#pragma unroll 1
            for (int p = 0; p < 2; ++p) {
                bf16x8 W[8];
#pragma unroll
                for (int k = 1; k < 8; ++k) { const LAS unsigned* ap = (const LAS unsigned*)(abase + (16 * p - 32 * k) * 2);
                    i32x4 av; av.x = (int)ap[0]; av.y = (int)ap[1]; av.z = (int)ap[2]; av.w = (int)ap[3]; W[8 - k] = __builtin_bit_cast(bf16x8, av); }
#pragma unroll 1
                for (int J = 0; J < 8; ++J) {
                    const LAS uchar* aj = abase + (16 * p + 256 * J) * 2;
                    const LAS uchar* bj = bbase + (16 * p + 256 * J) * 2;
#pragma unroll
                    for (int jj = 0; jj < 8; ++jj) {
                        const LAS unsigned* ap = (const LAS unsigned*)(aj + 64 * jj);
                        i32x4 av; av.x = (int)ap[0]; av.y = (int)ap[1]; av.z = (int)ap[2]; av.w = (int)ap[3]; W[jj] = __builtin_bit_cast(bf16x8, av);
                        const bf16x8 bb = *(const LAS bf16x8*)(bj + 64 * jj);
#pragma unroll
                        for (int i = 0; i < 8; ++i) acc[i] = __builtin_amdgcn_mfma_f32_32x32x16_bf16(W[(jj - i) & 7], bb, acc[i], 0, 0, 0);
                    }
                }
            }
            { const int cc = 512 * (o + 1) + c; const float w0 = conv_w[cc], w1 = conv_w[1536 + cc], w2 = conv_w[3072 + cc]; const float sk = skip[o * 512 + c];
              const u16* p0 = pT + ((size_t)cc * NB + r) * SEQ + tbase + 4 * h;
              const LAS uchar* z0 = lds + r * HZ_ROW + (tbase + 4 * h) * 2;
              const int tl = tbase + 4 * h;
#pragma unroll
              for (int i = 0; i < 8; ++i) {
                  if ((i & 3) == 0) __builtin_amdgcn_sched_barrier(0);
#pragma unroll
                  for (int q = 0; q < 4; ++q) { const int off = 32 * i + 8 * q;
                      const u32x2 zz = *(const LAS u32x2*)(z0 + off * 2);
                      const u32x2 gv = *(const u32x2*)(p0 + off);
                      const float um = bf2f(p0[off - 1]), up = bf2f(p0[off + 4]);
                      const float gm = (tl + off > 0) ? um : 0.f, gp = (tl + off + 4 < SEQ) ? up : 0.f;
                      const float g0 = bflo(gv.x), g1 = bfhi(gv.x), g2 = bflo(gv.y), g3 = bfhi(gv.y);
                      acc[i][4 * q + 0] = (w0 * gm + w1 * g0 + w2 * g1) * (acc[i][4 * q + 0] + sk * bflo(zz.x));
                      acc[i][4 * q + 1] = (w0 * g0 + w1 * g1 + w2 * g2) * (acc[i][4 * q + 1] + sk * bfhi(zz.x));
                      acc[i][4 * q + 2] = (w0 * g1 + w1 * g2 + w2 * g3) * (acc[i][4 * q + 2] + sk * bflo(zz.y));
                      acc[i][4 * q + 3] = (w0 * g2 + w1 * g3 + w2 * gp) * (acc[i][4 * q + 3] + sk * bfhi(zz.y)); } } }
            __syncthreads();
#pragma unroll
            for (int i = 0; i < 8; ++i)
#pragma unroll
                for (int q = 0; q < 4; ++q) {
                    u32x2 w; w.x = cvt_pk_bf16(acc[i][4 * q + 0], acc[i][4 * q + 1]); w.y = cvt_pk_bf16(acc[i][4 * q + 2], acc[i][4 * q + 3]);
                    *(LAS u32x2*)(lds + r * HZ_ROW + (tbase + 4 * h) * 2 + (32 * i + 8 * q) * 2) = w; }
            if (o == 0) hy_load_kr(lds, G + (size_t)(512 + c) * 4096);
            __syncthreads();
        }
#pragma unroll 8
        for (int idx = tid; idx < NB * 256; idx += NTHR) { const int b = idx >> 8, s0 = (idx & 255) * 8;
            *(u32x4*)(yT + ((size_t)c * NB + b) * SEQ + s0) = *(const LAS u32x4*)(lds + b * HZ_ROW + s0 * 2); }
        __syncthreads();
    }
}

__device__ __forceinline__ u32x4 pack8(const float (&o)[8]) { u32x4 w; w.x = cvt_pk_bf16(o[0], o[1]); w.y = cvt_pk_bf16(o[2], o[3]); w.z = cvt_pk_bf16(o[4], o[5]); w.w = cvt_pk_bf16(o[6], o[7]); return w; }
template <int W> __device__ __forceinline__ void pool_unit(const u16* __restrict__ seq  , int t0, u16* __restrict__ out  ) {
    constexpr int LEFT = W / 2, RIGHT = W - LEFT - 1, NR = 8 + W - 1;
    u32x4 rows[NR];
#pragma unroll
    for (int k = 0; k < NR; ++k) { const int p = t0 - LEFT + k; const int pc = min(max(p, 0), SEQ - 1);
        const u32x4 v = *(const u32x4*)(seq + (size_t)pc * 2048); const bool ok = (p >= 0 && p < SEQ);
        rows[k].x = ok ? v.x : 0u; rows[k].y = ok ? v.y : 0u; rows[k].z = ok ? v.z : 0u; rows[k].w = ok ? v.w : 0u; }
    float sm[8];
#pragma unroll
    for (int c = 0; c < 8; ++c) sm[c] = 0.f;
#pragma unroll
    for (int k = 0; k < W; ++k) { float f[8]; unpack8(rows[k], f);
#pragma unroll
        for (int c = 0; c < 8; ++c) sm[c] += f[c]; }
#pragma unroll
    for (int i = 0; i < 8; ++i) { const int t = t0 + i; const int lo = max(t - LEFT, 0), hi = min(t + RIGHT, SEQ - 1); const float inv = 1.0f / (float)(hi - lo + 1);
        float ctr[8], o[8]; unpack8(rows[i + LEFT], ctr);
#pragma unroll
        for (int c = 0; c < 8; ++c) o[c] = sm[c] * inv - ctr[c];
        *(u32x4*)(out + (size_t)t * 1024) = pack8(o);
        if (i < 7) { float fa[8], fs[8]; unpack8(rows[i + W], fa); unpack8(rows[i], fs);
#pragma unroll
            for (int c = 0; c < 8; ++c) sm[c] += fa[c] - fs[c]; } }
}
__device__ __forceinline__ void dconv_unit(const u16* __restrict__ seq  , int t0, const float* __restrict__ dconv  , u16* __restrict__ out  ) {
    u32x4 cr[10], hr[10], br[8];
#pragma unroll
    for (int k = 0; k < 10; ++k) { const int p = t0 - 1 + k; const int pc = min(max(p, 0), SEQ - 1);
        const u32x4 v = *(const u32x4*)(seq + (size_t)pc * 2048 + 1024); hr[k] = *(const u32x4*)(seq + (size_t)pc * 2048 + 1536); const bool ok = (p >= 0 && p < SEQ);
        cr[k].x = ok ? v.x : 0u; cr[k].y = ok ? v.y : 0u; cr[k].z = ok ? v.z : 0u; cr[k].w = ok ? v.w : 0u; }
#pragma unroll
    for (int i = 0; i < 8; ++i) br[i] = *(const u32x4*)(seq + (size_t)(t0 + i) * 2048 + 512);
    float w0[8], w1[8], w2[8];
    { const float4 a0 = *(const float4*)(dconv), a1 = *(const float4*)(dconv + 4), b0 = *(const float4*)(dconv + 512), b1 = *(const float4*)(dconv + 516), c0 = *(const float4*)(dconv + 1024), c1 = *(const float4*)(dconv + 1028);
      w0[0] = a0.x; w0[1] = a0.y; w0[2] = a0.z; w0[3] = a0.w; w0[4] = a1.x; w0[5] = a1.y; w0[6] = a1.z; w0[7] = a1.w;
      w1[0] = b0.x; w1[1] = b0.y; w1[2] = b0.z; w1[3] = b0.w; w1[4] = b1.x; w1[5] = b1.y; w1[6] = b1.z; w1[7] = b1.w;
      w2[0] = c0.x; w2[1] = c0.y; w2[2] = c0.z; w2[3] = c0.w; w2[4] = c1.x; w2[5] = c1.y; w2[6] = c1.z; w2[7] = c1.w; }
    float pm[8], pc_[8], pn[8];
    { float c[8], h[8]; unpack8(cr[0], c); unpack8(hr[0], h);
#pragma unroll
      for (int k = 0; k < 8; ++k) pm[k] = c[k] * h[k];
      unpack8(cr[1], c); unpack8(hr[1], h);
#pragma unroll
      for (int k = 0; k < 8; ++k) pc_[k] = c[k] * h[k]; }
#pragma unroll
    for (int i = 0; i < 8; ++i) { float c[8], h[8], bb[8], o[8]; unpack8(cr[i + 2], c); unpack8(hr[i + 2], h); unpack8(br[i], bb);
#pragma unroll
        for (int k = 0; k < 8; ++k) { pn[k] = c[k] * h[k]; o[k] = bb[k] * (w0[k] * pm[k] + w1[k] * pc_[k] + w2[k] * pn[k]); pm[k] = pc_[k]; pc_[k] = pn[k]; }
        *(u32x4*)(out + (size_t)(t0 + i) * 1024) = pack8(o); }
}
__device__ void stencil_phase(const u16* __restrict__ proj  , const float* __restrict__ dconv  , u16* __restrict__ ycat  ) {
    const int tid = opaque_tid(), lane = tid & 63, wave = __builtin_amdgcn_readfirstlane(tid >> 6);
    const int chl = (lane & 15) * 8, run = lane >> 4;
    for (int wu = blockIdx.x * 8 + wave; wu < (T_ / 32) * 8; wu += gridDim.x * 8) {
        const int rq = wu >> 3, kind = wu & 7; const int tok0 = rq * 32 + run * 8; const int t0 = tok0 & (SEQ - 1); const size_t s0 = (size_t)(tok0 - t0);
        if (kind < 4) { const int ch0 = kind * 128 + chl; const u16* seq = proj + s0 * 2048 + ch0; u16* out = ycat + s0 * 1024 + ch0;
            if (kind == 0) pool_unit<2>(seq, t0, out); else if (kind == 1) pool_unit<4>(seq, t0, out); else if (kind == 2) pool_unit<8>(seq, t0, out); else pool_unit<16>(seq, t0, out);
        } else { const int ch0 = (kind - 4) * 128 + chl; dconv_unit(proj + s0 * 2048 + ch0, t0, dconv + ch0, ycat + s0 * 1024 + 512 + ch0); }
    }
}


#define XB_TMO      128
#define XB_XCNT(j)  (256  + 64 * (j))
#define XB_XSUB(j)  (1280 + 64 * (j))
#define XB_XGEN(j)  (2304 + 64 * (j))
#define XB_TOP      3328
#define XB_TOPGEN   3392
#define XCD_BAR_WORDS 3456
#define XB_SPIN_CAP (1u << 20)
__device__ __forceinline__ unsigned xb_ld(unsigned* p)              { return __hip_atomic_load(p, __ATOMIC_RELAXED, __HIP_MEMORY_SCOPE_AGENT); }
__device__ __forceinline__ unsigned xb_add(unsigned* p, unsigned v) { return __hip_atomic_fetch_add(p, v, __ATOMIC_RELAXED, __HIP_MEMORY_SCOPE_AGENT); }
__device__ __forceinline__ unsigned xb_xcc_id() { return (unsigned)__builtin_amdgcn_s_getreg((3 << 11) | 20) & 0xFu; }
#define XB_SPIN(cond, bar) do { unsigned _sp = 0; while (cond) { __builtin_amdgcn_s_sleep(1); \
    if ((++_sp & 255u) == 0u) { if (xb_ld(&(bar)[XB_TMO])) break; if (_sp > XB_SPIN_CAP) { atomicAdd(&(bar)[XB_TMO], 1u); break; } } } } while (0)
struct XcdBarrier { unsigned* bar; unsigned x; volatile LAS unsigned* st; };
__device__ __forceinline__ XcdBarrier xcd_barrier_post(unsigned* bar, volatile LAS unsigned* st) {
    XcdBarrier b; b.bar = bar; b.x = xb_xcc_id(); b.st = st;
    if (threadIdx.x == 0) (void)xb_add(&bar[XB_XCNT(b.x)], 1u);
    return b;
}
__device__ __forceinline__ void xcd_barrier_complete(unsigned* bar, unsigned x, unsigned& nloc, unsigned& nx) {
    const unsigned G = gridDim.x * gridDim.y * gridDim.z;
    unsigned sum, cnt, mine, sp = 0u;
    for (;;) {
        sum = 0u; cnt = 0u; mine = 0u;
#pragma unroll
        for (unsigned j = 0; j < 16; ++j) { const unsigned c = xb_ld(&bar[XB_XCNT(j)]); sum += c; cnt += (c > 0u) ? 1u : 0u; mine = (j == x) ? c : mine; }
        if (sum == G) break;
        __builtin_amdgcn_s_sleep(1);
        if ((++sp & 255u) == 0u) { if (xb_ld(&bar[XB_TMO])) break; if (sp > XB_SPIN_CAP) { atomicAdd(&bar[XB_TMO], 1u); break; } }
    }
    nloc = mine > 0u ? mine : 1u; nx = cnt > 0u ? cnt : 1u;
}
__device__ __forceinline__ void xcd_barrier(const XcdBarrier& b) {
    asm volatile("s_waitcnt vmcnt(0)" ::: "memory");
    __syncthreads();
    if (threadIdx.x == 0) {
        unsigned* bar = b.bar;
        __builtin_amdgcn_s_waitcnt(0);
        unsigned nloc = b.st[0], nx = b.st[1];
        if (nloc == 0u) { xcd_barrier_complete(bar, b.x, nloc, nx); b.st[0] = nloc; b.st[1] = nx; }
        const unsigned old = xb_add(&bar[XB_XSUB(b.x)], 1u);
        const unsigned gen = old / nloc;
        if (old + 1u == (gen + 1u) * nloc) {
            __builtin_amdgcn_fence(__ATOMIC_RELEASE, "agent");
            asm volatile("s_waitcnt vmcnt(0)" ::: "memory");
            const unsigned og = xb_add(&bar[XB_TOP], 1u);
            const unsigned tg = og / nx;
            if (og + 1u == (tg + 1u) * nx) xb_add(&bar[XB_TOPGEN], 1u);
            else XB_SPIN(xb_ld(&bar[XB_TOPGEN]) == tg, bar);
            __builtin_amdgcn_fence(__ATOMIC_ACQUIRE, "agent");
            xb_add(&bar[XB_XGEN(b.x)], 1u);
            asm volatile("s_waitcnt vmcnt(0)" ::: "memory");
        } else {
            XB_SPIN(xb_ld(&bar[XB_XGEN(b.x)]) == gen, bar);
            __builtin_amdgcn_fence(__ATOMIC_ACQUIRE, "agent");
            asm volatile("s_waitcnt vmcnt(0)" ::: "memory");
        }
    }
    __syncthreads();
}

constexpr int NPH = 1 + 2 * 8 + 2 * 7;
struct Args { const float* in[23]; float* out; uchar* ws; int lo, hi; };

__global__ void __launch_bounds__(NTHR, 2) fwd_kernel(Args a) {
    extern __shared__ __attribute__((aligned(16))) uchar lds_raw[];
    LAS uchar* lds = (LAS uchar*)lds_raw;
    cg::grid_group grid = cg::this_grid();
    const int lo = a.lo, hi = a.hi; int ph = 0;
    volatile LAS unsigned* xst = (volatile LAS unsigned*)(lds + LDS_ST_OFF);
    if (threadIdx.x == 0) { xst[0] = 0u; xst[1] = 0u; }
    __syncthreads();
    XcdBarrier xb = xcd_barrier_post((unsigned*)(a.ws + WS_BAR), xst);
#define PH_BEGIN if (ph >= lo && ph < hi) {
#define PH_END } if (ph >= lo && ph + 1 < hi) { if (lo < 0) grid.sync();   xcd_barrier(xb); if (DBL(11) == 2) { xcd_barrier(xb); xcd_barrier(xb); } } ++ph;
    uchar* ws = a.ws;
    u16* Wabin = (u16*)(ws + WS_ABIN); u16* Wabout = (u16*)(ws + WS_ABOUT); u16* Wcdin = (u16*)(ws + WS_CDIN); u16* Wcdout = (u16*)(ws + WS_CDOUT);
    u16* Wgu = (u16*)(ws + WS_GU); u16* Wdown = (u16*)(ws + WS_DOWN); u16* Gf = (u16*)(ws + WS_G);
    u16* H = (u16*)(ws + WS_H); u16* PROJ = (u16*)(ws + WS_B); u16* YT = (u16*)(ws + WS_B + (size_t)T_ * 1024 * 2);     u16* ACT = (u16*)(ws + WS_B); u16* PT = (u16*)(ws + WS_C);
    u16* YCAT = (u16*)(ws + WS_D); u16* MIX = (u16*)(ws + WS_E); float* RSTD = (float*)(ws + WS_RSTD);
    const float* x_in = a.in[0]; const float* norm_g = a.in[1]; float* X = a.out;

    PH_BEGIN
      for (int rep = 0; rep < DBL(0); ++rep) {
        int rot = 0;
        if ((blockIdx.x & 1) == 0) filter_job(lds, a.in[10], a.in[11], a.in[12], a.in[13], a.in[14], a.in[15], a.in[16], Gf);
        for (int j = 0; j < 2; ++j) {
            wt_job(lds, a.in[4] + (size_t)j * 1024 * 2560, 2560, 1024, 2560, Wabin + (size_t)j * 2560 * 1024, 1024, 0, norm_g + (size_t)(2 * j) * 4 * 1024, rot);
            wt_job(lds, a.in[5] + (size_t)j * 1024 * 1024, 1024, 1024, 1024, Wabout + (size_t)j * 1024 * 1024, 1024, 0, nullptr, rot);
            wt_job(lds, a.in[18] + (size_t)j * 1024 * 2048, 2048, 1024, 2048, Wcdin + (size_t)j * 2048 * 1024, 1024, 0, norm_g + (size_t)(2 * j + 1) * 4 * 1024, rot);
            wt_job(lds, a.in[19] + (size_t)j * 1024 * 1024 + 512 * 1024, 1024, 512, 1024, Wcdout + (size_t)j * 1024 * 1024 + 512, 1024, 0, nullptr, rot);
            fold_job(a.in[20] + (size_t)j * 4 * 128 * 128, a.in[21] + j * 512, a.in[19] + (size_t)j * 1024 * 1024, Wcdout + (size_t)j * 1024 * 1024);
        }
        for (int i = 0; i < 4; ++i) {
            wt_job(lds, a.in[2] + (size_t)i * 1024 * 5632, 5632, 1024, 5632, Wgu + (size_t)i * 5632 * 1024, 1024, 1, norm_g + (size_t)(i * 4 + 2) * 1024, rot);
            wt_job(lds, a.in[3] + (size_t)i * 2816 * 1024, 1024, 2816, 1024, Wdown + (size_t)i * 1024 * 2816, 2816, 0, nullptr, rot);
        }
      }
        resid_pass(x_in, H, nullptr, nullptr, RSTD, nullptr);
        if ((blockIdx.x & 1) != 0) filter_job(lds, a.in[10], a.in[11], a.in[12], a.in[13], a.in[14], a.in[15], a.in[16], Gf);
    PH_END

#pragma unroll 1
    for (int i = 0; i < 4; ++i) {
        const int j = i >> 1; const bool even = (i & 1) == 0;
        const float* g4 = norm_g + (size_t)i * 4 * 1024;
        PH_BEGIN
            { const int N = even ? 1024 : 2048;
              pg8::Gemm g{H, even ? Wabin + (size_t)j * 2560 * 1024 : Wcdin + (size_t)j * 2048 * 1024, T_, N, 1024};
              pg8::StaticOrder S; S.init(T_, N, (int)gridDim.x, (int)blockIdx.x);
              pg8::EpiBf16G E{PROJ, N, even ? 4 : 0, RSTD};
#ifndef SKIP_G1
              for (int rep = 0; rep < DBL(6); ++rep) pg8::gemm_phase<pg8::EpiBf16G, pg8::StaticOrder, false>(lds, g, S, E, nullptr);
#endif
            }
            if (even) {
              pg8::Gemm g{H, Wabin + (size_t)j * 2560 * 1024 + (size_t)1024 * 1024, T_, 1536, 1024};
              pg8::StaticOrder S; S.init(T_, 1536, (int)gridDim.x, (int)blockIdx.x);
              pg8::EpiPT E{PT, RSTD};
              pg8::gemm_phase<pg8::EpiPT, pg8::StaticOrder, false>(lds, g, S, E, nullptr);
            }
        PH_END
        if (even) {
            PH_BEGIN
                for (int rep = 0; rep < DBL(1); ++rep) gating_phase(lds, PROJ, a.in[6] + j * 512, a.in[7] + (size_t)j * 4 * 128 * 128, a.in[8] + j * 512, YCAT);
                for (int rep = 0; rep < DBL(3); ++rep) hyena_phase(lds, PT, Gf + (size_t)j * 2 * 512 * 4096, a.in[9] + (size_t)j * 3 * 1536, a.in[17] + j * 1024, YT);
            PH_END
            PH_BEGIN
                for (int rep = 0; rep < DBL(4); ++rep) transpose_back_phase(lds, YT, YCAT);
            PH_END
        } else {
            PH_BEGIN
                for (int rep = 0; rep < DBL(5); ++rep) stencil_phase(PROJ, a.in[22] + (size_t)j * 3 * 512, YCAT);
            PH_END
        }
        PH_BEGIN
            pg8::Gemm g{YCAT, even ? Wabout + (size_t)j * 1024 * 1024 : Wcdout + (size_t)j * 1024 * 1024, T_, 1024, 1024};
            pg8::StaticOrder S; S.init(T_, 1024, (int)gridDim.x, (int)blockIdx.x);
            pg8::EpiBf16G E{MIX, 1024, 0, nullptr};

#ifndef SKIP_G2
            for (int rep = 0; rep < DBL(7); ++rep) pg8::gemm_phase<pg8::EpiBf16G, pg8::StaticOrder, false>(lds, g, S, E, nullptr);
#endif
        PH_END
        PH_BEGIN
            if (DBL(10) == 2) resid_pass(nullptr, (u16*)(ws + WS_C), MIX, g4 + 1024, (float*)(ws + WS_B), nullptr);
            resid_pass(nullptr, H, MIX, g4 + 1024, RSTD, nullptr);
        PH_END
        PH_BEGIN
            pg8::Gemm g{H, Wgu + (size_t)i * 5632 * 1024, T_, 5632, 1024};
            pg8::StaticOrder S; S.init(T_, 5632, (int)gridDim.x, (int)blockIdx.x);
            pg8::EpiSwiGLU E{ACT, DFF, RSTD};

#ifndef SKIP_G3
            for (int rep = 0; rep < DBL(8); ++rep) pg8::gemm_phase<pg8::EpiSwiGLU, pg8::StaticOrder, false>(lds, g, S, E, nullptr);
#endif
        PH_END
        PH_BEGIN
            pg8::Gemm g{ACT, Wdown + (size_t)i * 1024 * 2816, T_, 1024, DFF};
            pg8::StaticOrder S; S.init(T_, 1024, (int)gridDim.x, (int)blockIdx.x);
            pg8::EpiBf16G E{MIX, 1024, 0, nullptr};

#ifndef SKIP_G4
            for (int rep = 0; rep < DBL(9); ++rep) pg8::gemm_phase<pg8::EpiBf16G, pg8::StaticOrder, false>(lds, g, S, E, nullptr);
#endif
        PH_END
        PH_BEGIN
            if (DBL(10) == 2) resid_pass(nullptr, (u16*)(ws + WS_C), MIX, g4 + 3072, (float*)(ws + WS_B), nullptr);
            resid_pass(nullptr, H, MIX, g4 + 3072, RSTD, (i == 3) ? X : nullptr);
        PH_END
    }
#undef PH_BEGIN
#undef PH_END
}

extern "C" void kernel_launch(void* const* d_in, const int* in_sizes, int n_in, void* d_out, int out_size, void* d_ws, size_t ws_size, hipStream_t stream) {
    static int grid = 0;
    if (grid == 0) {
        if (n_in != 23 || out_size != T_ * DM || ws_size < WS_END) { fprintf(stderr, "kernel_launch: unexpected problem (n_in %d out %d ws %zu)\n", n_in, out_size, ws_size); grid = -1; return; }
        int dev = 0, cus = 0, per_cu = 0;
        (void)hipGetDevice(&dev); (void)hipDeviceGetAttribute(&cus, hipDeviceAttributeMultiprocessorCount, dev);
        if (hipFuncSetAttribute((const void*)fwd_kernel, hipFuncAttributeMaxDynamicSharedMemorySize, LDS_BYTES) != hipSuccess) { fprintf(stderr, "kernel_launch: hipFuncSetAttribute failed\n"); grid = -1; return; }
        if (hipOccupancyMaxActiveBlocksPerMultiprocessor(&per_cu, (const void*)fwd_kernel, NTHR, LDS_BYTES) != hipSuccess || per_cu < 1) { fprintf(stderr, "kernel_launch: occupancy query gave %d\n", per_cu); per_cu = 1; }
        (void)hipGetLastError();
        grid = cus * per_cu;
        fprintf(stderr, "kernel_launch: grid %d (cus %d x %d)\n", grid, cus, per_cu);
    }
    if (grid < 0) return;
    Args a{};
    for (int i = 0; i < 23; ++i) a.in[i] = (const float*)d_in[i];
    a.out = (float*)d_out; a.ws = (uchar*)d_ws;
#if ONE_LAUNCH
    (void)hipMemsetAsync((char*)d_ws + WS_BAR, 0, XCD_BAR_WORDS * 4, stream);
    a.lo = 0; a.hi = NPH;
    void* args[] = {&a};
    hipError_t e = hipLaunchCooperativeKernel((const void*)fwd_kernel, dim3(grid), dim3(NTHR), args, LDS_BYTES, stream);
    if (e != hipSuccess) fprintf(stderr, "kernel_launch: cooperative launch failed: %s (grid %d)\n", hipGetErrorString(e), grid);
#else
    for (int p = 0; p < NPH; ++p) { a.lo = p; a.hi = p + 1;
        hipLaunchKernelGGL(fwd_kernel, dim3(grid), dim3(NTHR), LDS_BYTES, stream, a); }
#endif
}
```
